# Optimizing an MI355X kernel written in HIP

```python
import math
import jax
import jax.numpy as jnp
from jax import lax
import numpy as np

D_MODEL = 1024
BATCH = 32
SEQ = 2048
DEPTH = 2

GRID_W = 64
CTX_LEN = 256
CONV_K = 3
RMS_EPS = 1e-6

GDN_HEADS = 4
GDN_DK = 128
GDN_DV = 128
GDN_CHUNK = 64

SSD_HEADS = 8
SSD_HEADDIM = 64
SSD_GROUPS = 2
SSD_STATE = 128
SSD_CHUNK = 128

S5_WIDTH = D_MODEL
S5_GROUP = 16
S5_GROUPS = S5_WIDTH // S5_GROUP
S5_STATE = 64

N_EXPERTS = 32
TOP_K = 4
D_EXPERT = D_MODEL
SWIGLU_LIMIT = 7.0
SWIGLU_ALPHA = 1.702

GDN_V_WIDTH = GDN_HEADS * GDN_DV
SSD_INNER = SSD_HEADS * SSD_HEADDIM
GDN_CONV_CH = 2 * GDN_HEADS * GDN_DK + GDN_V_WIDTH
SSD_CONV_CH = SSD_INNER + 2 * SSD_GROUPS * SSD_STATE
IN0_SIZES = (GDN_CONV_CH, SSD_CONV_CH, GDN_V_WIDTH, SSD_INNER, 2 * GDN_HEADS, 2 * GDN_HEADS, 2 * SSD_HEADS)
IN0_WIDTH = sum(IN0_SIZES)
MIX0_WIDTH = GDN_V_WIDTH + SSD_INNER

kernel_name = 'hybrid_gdn_ssd_s5_moe_diffusion'


def rmsnorm(t, w):
    tf = t.astype(jnp.float32)
    tf = tf * lax.rsqrt(jnp.mean(tf * tf, axis=-1, keepdims=True) + RMS_EPS)
    return (tf * w.astype(jnp.float32)).astype(t.dtype)


def l2norm(t):
    tf = t.astype(jnp.float32)
    return tf * lax.rsqrt(jnp.sum(tf * tf, axis=-1, keepdims=True) + RMS_EPS)


def modulate(t, shift, scale):
    return (t * (1.0 + scale) + shift).astype(t.dtype)


def grid_dwconv(t, w, n_rows, n_cols):
    b, l, ch = t.shape
    img = t.reshape(b, n_rows, n_cols, ch)
    out = lax.conv_general_dilated(img, w.astype(t.dtype)[:, :, None, :], window_strides=(1, 1), padding='SAME',
                                   dimension_numbers=('NHWC', 'HWIO', 'NHWC'), feature_group_count=ch)
    return out.reshape(b, l, ch)


def gated_delta_chunked(q, k, v, g, beta, s0):
    f32 = jnp.float32
    b, l, h, dk = q.shape
    c = GDN_CHUNK
    n = l // c

    def chunks(t):
        return t.astype(f32).reshape(b, n, c, h, -1).transpose(1, 0, 3, 2, 4)

    qc = chunks(q) * (dk ** -0.5)
    kc, vc = chunks(k), chunks(v)
    gc = jnp.cumsum(g.astype(f32).reshape(b, n, c, h).transpose(1, 0, 3, 2), axis=-1)
    bc = beta.astype(f32).reshape(b, n, c, h).transpose(1, 0, 3, 2)
    causal = jnp.tril(jnp.ones((c, c), bool))
    strict = jnp.tril(jnp.ones((c, c), bool), -1)
    seg = gc[..., :, None] - gc[..., None, :]
    decay = jnp.where(causal, jnp.exp(jnp.where(causal, seg, 0.0)), 0.0)
    kb = kc * bc[..., None]
    m = jnp.where(strict, jnp.einsum('nbhid,nbhjd->nbhij', kb, kc) * decay, 0.0)
    tri = jnp.eye(c, dtype=f32) + m
    u = lax.linalg.triangular_solve(tri, vc * bc[..., None], left_side=True, lower=True, unit_diagonal=True)
    w = lax.linalg.triangular_solve(tri, kb * jnp.exp(gc)[..., None], left_side=True, lower=True, unit_diagonal=True)
    qk = jnp.einsum('nbhid,nbhjd->nbhij', qc, kc) * decay
    q_dec = qc * jnp.exp(gc)[..., None]
    k_dec = kc * jnp.exp(gc[..., -1:] - gc)[..., None]
    g_last = jnp.exp(gc[..., -1])

    def step(s, inp):
        u_i, w_i, qk_i, qd_i, kd_i, gl_i = inp
        v_new = u_i - w_i @ s
        o_i = qd_i @ s + qk_i @ v_new
        s = s * gl_i[..., None, None] + jnp.swapaxes(kd_i, -1, -2) @ v_new
        return s, o_i

    s_fin, o = lax.scan(step, s0.astype(f32), (u, w, qk, q_dec, k_dec, g_last))
    o = o.transpose(1, 0, 3, 2, 4).reshape(b, l, h, -1)
    return o, s_fin


def ssd_chunked(x, dt, da, bm, cm, s0):
    f32 = jnp.float32
    b, l, h, p = x.shape
    g, nst = bm.shape[2], bm.shape[3]
    r = h // g
    c = SSD_CHUNK
    n = l // c
    xc = (x.astype(f32) * dt.astype(f32)[..., None]).reshape(b, n, c, g, r, p)
    acs = jnp.cumsum(da.astype(f32).reshape(b, n, c, g, r), axis=2)
    bc = bm.astype(f32).reshape(b, n, c, g, nst)
    cc = cm.astype(f32).reshape(b, n, c, g, nst)
    causal = jnp.tril(jnp.ones((c, c), bool))[:, :, None, None]
    seg = acs[:, :, :, None] - acs[:, :, None, :]
    lmat = jnp.where(causal, jnp.exp(jnp.where(causal, seg, 0.0)), 0.0)
    scores = jnp.einsum('bnlgd,bnsgd->bnlsg', cc, bc)[..., None] * lmat
    y_diag = jnp.einsum('bnlsgr,bnsgrp->bnlgrp', scores, xc)
    decay_out = jnp.exp(acs[:, :, -1:] - acs)
    chunk_states = jnp.einsum('bnsgd,bnsgrp->bngrpd', bc, xc * decay_out[..., None])
    states = jnp.concatenate([s0.astype(f32).reshape(b, 1, g, r, p, nst), chunk_states], axis=1)
    cum = jnp.cumsum(jnp.pad(acs[:, :, -1], ((0, 0), (1, 0), (0, 0), (0, 0))), axis=1)
    tri = jnp.tril(jnp.ones((n + 1, n + 1), bool))[:, :, None, None]
    segc = cum[:, :, None] - cum[:, None, :]
    dec = jnp.where(tri, jnp.exp(jnp.where(tri, segc, 0.0)), 0.0)
    new = jnp.einsum('bzcgr,bcgrpd->bzgrpd', dec, states)
    y_off = jnp.einsum('bnlgd,bngrpd->bnlgrp', cc, new[:, :-1]) * jnp.exp(acs)[..., None]
    y = (y_diag + y_off).reshape(b, l, h, p)
    return y, new[:, -1].reshape(b, h, p, nst)


def bidirectional(scan_fn, ctx_dirs, lat_dirs, s0):
    flip = lambda t: jnp.flip(t, axis=1)
    y_ctx, y_lat = 0.0, 0.0
    for d in range(2):
        rev = d == 1
        cargs = tuple(flip(t) for t in ctx_dirs[d]) if rev else ctx_dirs[d]
        largs = tuple(flip(t) for t in lat_dirs[d]) if rev else lat_dirs[d]
        o_c, s_c = scan_fn(*cargs, s0)
        o_l, _ = scan_fn(*largs, s_c)
        y_ctx = y_ctx + (flip(o_c) if rev else o_c)
        y_lat = y_lat + (flip(o_l) if rev else o_l)
    return y_ctx, y_lat


def hybrid_mixer(h_ctx, h_lat, rows, w_in, gdn_conv_w, gdn_a_log, gdn_dt_bias, gdn_norm_w,
                 ssd_conv_w, ssd_conv_b, ssd_a_log, ssd_dt_bias, ssd_d, ssd_norm_w, w_out, need_ctx):
    f32 = jnp.float32
    splits = np.cumsum(IN0_SIZES)[:-1].tolist()

    def features(h, n_rows, n_cols):
        b, l, _ = h.shape
        conv_a, conv_b, z_a, z_b, a_raw, b_raw, dt_raw = jnp.split(h @ w_in, splits, axis=-1)
        conv_a = jax.nn.silu(grid_dwconv(conv_a, gdn_conv_w, n_rows, n_cols))
        conv_b = jax.nn.silu(grid_dwconv(conv_b, ssd_conv_w, n_rows, n_cols) + ssd_conv_b)
        q, k, v = jnp.split(conv_a, [GDN_HEADS * GDN_DK, 2 * GDN_HEADS * GDN_DK], axis=-1)
        q = l2norm(q.reshape(b, l, GDN_HEADS, GDN_DK))
        k = l2norm(k.reshape(b, l, GDN_HEADS, GDN_DK))
        v = v.reshape(b, l, GDN_HEADS, GDN_DV)
        g = -jnp.exp(gdn_a_log.astype(f32)) * jax.nn.softplus(a_raw.astype(f32).reshape(b, l, 2, GDN_HEADS) + gdn_dt_bias)
        beta = jax.nn.sigmoid(b_raw.astype(f32).reshape(b, l, 2, GDN_HEADS))
        xs, bm, cm = jnp.split(conv_b, [SSD_INNER, SSD_INNER + SSD_GROUPS * SSD_STATE], axis=-1)
        xs = xs.reshape(b, l, SSD_HEADS, SSD_HEADDIM)
        bm = bm.reshape(b, l, SSD_GROUPS, SSD_STATE)
        cm = cm.reshape(b, l, SSD_GROUPS, SSD_STATE)
        dt = jax.nn.softplus(dt_raw.astype(f32).reshape(b, l, 2, SSD_HEADS) + ssd_dt_bias)
        da = -jnp.exp(ssd_a_log.astype(f32)) * dt
        gdn_dirs = tuple((q, k, v, g[:, :, d], beta[:, :, d]) for d in range(2))
        ssd_dirs = tuple((xs, dt[:, :, d], da[:, :, d], bm, cm) for d in range(2))
        return gdn_dirs, ssd_dirs, xs, z_a, z_b

    b = h_lat.shape[0]
    gdn_c, ssd_c, xs_c, za_c, zb_c = features(h_ctx, 1, h_ctx.shape[1])
    gdn_l, ssd_l, xs_l, za_l, zb_l = features(h_lat, rows, GRID_W)
    o_c, o_l = bidirectional(gated_delta_chunked, gdn_c, gdn_l, jnp.zeros((b, GDN_HEADS, GDN_DK, GDN_DV), f32))
    y_c, y_l = bidirectional(ssd_chunked, ssd_c, ssd_l, jnp.zeros((b, SSD_HEADS, SSD_HEADDIM, SSD_STATE), f32))

    def merge(o, y, xs, z_a, z_b, dtype):
        bb, l = o.shape[0], o.shape[1]
        o = rmsnorm(o, gdn_norm_w) * jax.nn.silu(z_a.astype(f32)).reshape(bb, l, GDN_HEADS, GDN_DV)
        y = (y + ssd_d.astype(f32)[:, None] * xs).reshape(bb, l, SSD_INNER) * jax.nn.silu(z_b.astype(f32))
        y = rmsnorm(y.reshape(bb, l, SSD_GROUPS, -1), ssd_norm_w.reshape(SSD_GROUPS, -1))
        mixed = jnp.concatenate([o.reshape(bb, l, -1), y.reshape(bb, l, -1)], axis=-1)
        return (mixed.astype(dtype) @ w_out).astype(dtype)

    y_lat = merge(o_l, y_l, xs_l, za_l, zb_l, h_lat.dtype)
    y_ctx = merge(o_c, y_c, xs_c, za_c, zb_c, h_ctx.dtype) if need_ctx else None
    return y_ctx, y_lat


def s5_discretize(a_re, a_im, log_step, b_re, b_im):
    f32 = jnp.float32
    a_re, a_im = a_re.astype(f32), a_im.astype(f32)
    step = jnp.exp(log_step.astype(f32))[:, None]
    mag = jnp.exp(a_re * step)
    lam_re, lam_im = mag * jnp.cos(a_im * step), mag * jnp.sin(a_im * step)
    den = a_re * a_re + a_im * a_im
    f_re = ((lam_re - 1.0) * a_re + lam_im * a_im) / den
    f_im = (lam_im * a_re - (lam_re - 1.0) * a_im) / den
    b_re, b_im = b_re.astype(f32), b_im.astype(f32)
    bb_re = f_re[..., None] * b_re - f_im[..., None] * b_im
    bb_im = f_re[..., None] * b_im + f_im[..., None] * b_re
    return lam_re, lam_im, bb_re, bb_im


def s5_scan(lam_re, lam_im, bb_re, bb_im, u, h0_re, h0_im, reverse):
    bu_re = jnp.einsum('gph,blgh->blgp', bb_re, u)
    bu_im = jnp.einsum('gph,blgh->blgp', bb_im, u)
    first = -1 if reverse else 0
    bu_re = bu_re.at[:, first].add(lam_re * h0_re - lam_im * h0_im)
    bu_im = bu_im.at[:, first].add(lam_re * h0_im + lam_im * h0_re)
    l = u.shape[1]
    a_re = jnp.broadcast_to(lam_re, (1, l) + lam_re.shape)
    a_im = jnp.broadcast_to(lam_im, (1, l) + lam_im.shape)

    def combine(e1, e2):
        a1r, a1i, b1r, b1i = e1
        a2r, a2i, b2r, b2i = e2
        return (a2r * a1r - a2i * a1i, a2r * a1i + a2i * a1r,
                a2r * b1r - a2i * b1i + b2r, a2r * b1i + a2i * b1r + b2i)

    _, _, x_re, x_im = lax.associative_scan(combine, (a_re, a_im, bu_re, bu_im), reverse=reverse, axis=1)
    return x_re, x_im


def s5_readout(x_re, x_im, c_re, c_im):
    f32 = jnp.float32
    y = jnp.einsum('ghp,blgp->blgh', c_re.astype(f32), x_re) - jnp.einsum('ghp,blgp->blgh', c_im.astype(f32), x_im)
    return y.reshape(y.shape[0], y.shape[1], -1)


def s5_mixer(h_ctx, h_lat, w_in, a_re, a_im, log_step, b_re, b_im, c_re, c_im, d_skip, w_glu_a, w_glu_b, need_ctx):
    f32 = jnp.float32
    b = h_lat.shape[0]
    u_c = (h_ctx @ w_in).astype(f32)
    u_l = (h_lat @ w_in).astype(f32)
    ug_c = u_c.reshape(b, u_c.shape[1], S5_GROUPS, S5_GROUP)
    ug_l = u_l.reshape(b, u_l.shape[1], S5_GROUPS, S5_GROUP)
    y_l = d_skip.astype(f32) * u_l
    y_c = d_skip.astype(f32) * u_c if need_ctx else None
    zero = jnp.zeros((b, S5_GROUPS, S5_STATE), f32)
    for d in range(2):
        rev = d == 1
        lam_re, lam_im, bb_re, bb_im = s5_discretize(a_re[d], a_im[d], log_step[d], b_re[d], b_im[d])
        xc_re, xc_im = s5_scan(lam_re, lam_im, bb_re, bb_im, ug_c, zero, zero, rev)
        end = 0 if rev else -1
        xl_re, xl_im = s5_scan(lam_re, lam_im, bb_re, bb_im, ug_l, xc_re[:, end], xc_im[:, end], rev)
        y_l = y_l + s5_readout(xl_re, xl_im, c_re[d], c_im[d])
        if need_ctx:
            y_c = y_c + s5_readout(xc_re, xc_im, c_re[d], c_im[d])

    def glu(y, dtype):
        o = jax.nn.gelu(y).astype(dtype)
        return ((o @ w_glu_a) * jax.nn.sigmoid(o @ w_glu_b)).astype(dtype)

    y_lat = glu(y_l, h_lat.dtype)
    y_ctx = glu(y_c, h_ctx.dtype) if need_ctx else None
    return y_ctx, y_lat


def moe_ffn(h, router_w, router_b, w_gate, b_gate, w_up, b_up, w_down, b_down):
    f32 = jnp.float32
    t = h.reshape(-1, h.shape[-1])
    logits = (t @ router_w + router_b).astype(f32)
    top_val, top_idx = lax.top_k(logits, TOP_K)
    probs = jax.nn.softmax(top_val, axis=-1)
    gates = jnp.einsum('tk,tke->te', probs, jax.nn.one_hot(top_idx, N_EXPERTS, dtype=f32))
    out = jnp.zeros(t.shape, f32)
    for e in range(N_EXPERTS):
        gl = jnp.minimum(t @ w_gate[e] + b_gate[e], SWIGLU_LIMIT)
        lin = jnp.clip(t @ w_up[e] + b_up[e], -SWIGLU_LIMIT, SWIGLU_LIMIT)
        act = gl * jax.nn.sigmoid(SWIGLU_ALPHA * gl) * (lin + 1.0)
        out = out + gates[:, e:e + 1] * (act @ w_down[e] + b_down[e]).astype(f32)
    return out.reshape(h.shape).astype(h.dtype)


def setup_inputs(seed: int = 0) -> dict:
    key = jax.random.key(seed)
    keys = iter(jax.random.split(key, 48))
    f32 = jnp.float32

    def normal(shape, scale):
        return jax.random.normal(next(keys), shape, f32) * scale

    def uniform(shape, lo, hi):
        return jax.random.uniform(next(keys), shape, f32, lo, hi)

    def gain(shape):
        return 1.0 + normal(shape, 0.05)

    def dt_bias(shape):
        dt = jnp.exp(uniform(shape, math.log(1e-3), math.log(1e-1)))
        return jnp.log(jnp.expm1(dt))

    ne, no = (DEPTH + 1) // 2, DEPTH // 2
    d, e, f = D_MODEL, N_EXPERTS, D_EXPERT
    return {
        'x': normal((BATCH, SEQ, d), 1.0),
        'c': normal((BATCH, d), 1.0),
        'ctx': normal((BATCH, CTX_LEN, d), 1.0),
        'c_ctx': normal((d,), 1.0),
        'ada_w': normal((DEPTH, d, 6 * d), 0.5 * d ** -0.5),
        'ada_b': normal((DEPTH, 6 * d), 0.02),
        'mix_norm_pre': gain((DEPTH, d)),
        'mix_norm_post': gain((DEPTH, d)),
        'ffn_norm_pre': gain((DEPTH, d)),
        'ffn_norm_post': gain((DEPTH, d)),
        'router_w': normal((DEPTH, d, e), d ** -0.5),
        'router_b': normal((DEPTH, e), 0.01),
        'moe_w_gate': normal((DEPTH, e, d, f), d ** -0.5),
        'moe_b_gate': normal((DEPTH, e, f), 0.02),
        'moe_w_up': normal((DEPTH, e, d, f), d ** -0.5),
        'moe_b_up': normal((DEPTH, e, f), 0.02),
        'moe_w_down': normal((DEPTH, e, f, d), f ** -0.5),
        'moe_b_down': normal((DEPTH, e, d), 0.02),
        'hy_w_in': normal((ne, d, IN0_WIDTH), d ** -0.5),
        'gdn_conv_w': normal((ne, CONV_K, CONV_K, GDN_CONV_CH), 1.0 / CONV_K),
        'gdn_a_log': jnp.log(uniform((ne, 2, GDN_HEADS), 1.0, 16.0)),
        'gdn_dt_bias': dt_bias((ne, 2, GDN_HEADS)),
        'gdn_norm_w': gain((ne, GDN_DV)),
        'ssd_conv_w': normal((ne, CONV_K, CONV_K, SSD_CONV_CH), 1.0 / CONV_K),
        'ssd_conv_b': normal((ne, SSD_CONV_CH), 0.02),
        'ssd_a_log': jnp.log(uniform((ne, 2, SSD_HEADS), 1.0, 16.0)),
        'ssd_dt_bias': dt_bias((ne, 2, SSD_HEADS)),
        'ssd_d': gain((ne, SSD_HEADS)),
        'ssd_norm_w': gain((ne, SSD_INNER)),
        'hy_w_out': normal((ne, MIX0_WIDTH, d), MIX0_WIDTH ** -0.5),
        's5_w_in': normal((no, d, S5_WIDTH), d ** -0.5),
        's5_a_re': -0.5 + normal((no, 2, S5_GROUPS, S5_STATE), 0.01),
        's5_a_im': jnp.pi * jnp.arange(S5_STATE, dtype=f32) + normal((no, 2, S5_GROUPS, S5_STATE), 0.01),
        's5_log_step': uniform((no, 2, S5_GROUPS), math.log(1e-3), math.log(1e-1)),
        's5_b_re': normal((no, 2, S5_GROUPS, S5_STATE, S5_GROUP), (2 * S5_GROUP) ** -0.5),
        's5_b_im': normal((no, 2, S5_GROUPS, S5_STATE, S5_GROUP), (2 * S5_GROUP) ** -0.5),
        's5_c_re': normal((no, 2, S5_GROUPS, S5_GROUP, S5_STATE), (S5_STATE) ** -0.5),
        's5_c_im': normal((no, 2, S5_GROUPS, S5_GROUP, S5_STATE), (S5_STATE) ** -0.5),
        's5_d': normal((no, S5_WIDTH), 1.0),
        's5_w_glu_a': normal((no, S5_WIDTH, d), S5_WIDTH ** -0.5),
        's5_w_glu_b': normal((no, S5_WIDTH, d), S5_WIDTH ** -0.5),
    }


def reference(x, c, ctx, c_ctx, ada_w, ada_b, mix_norm_pre, mix_norm_post, ffn_norm_pre, ffn_norm_post,
              router_w, router_b, moe_w_gate, moe_b_gate, moe_w_up, moe_b_up, moe_w_down, moe_b_down,
              hy_w_in, gdn_conv_w, gdn_a_log, gdn_dt_bias, gdn_norm_w, ssd_conv_w, ssd_conv_b, ssd_a_log,
              ssd_dt_bias, ssd_d, ssd_norm_w, hy_w_out,
              s5_w_in, s5_a_re, s5_a_im, s5_log_step, s5_b_re, s5_b_im, s5_c_re, s5_c_im, s5_d,
              s5_w_glu_a, s5_w_glu_b):
    rows = x.shape[1] // GRID_W
    h_lat, h_ctx = x, ctx
    cond_lat = jax.nn.silu(c)
    cond_ctx = jax.nn.silu(c_ctx)
    for i in range(DEPTH):
        j = i // 2
        need_ctx = i < DEPTH - 1
        m_lat = jnp.split((cond_lat @ ada_w[i] + ada_b[i])[:, None, :], 6, axis=-1)
        m_ctx = jnp.split(cond_ctx @ ada_w[i] + ada_b[i], 6, axis=-1)
        a_lat = modulate(rmsnorm(h_lat, mix_norm_pre[i]), m_lat[0], m_lat[1])
        a_ctx = modulate(rmsnorm(h_ctx, mix_norm_pre[i]), m_ctx[0], m_ctx[1])
        if i % 2 == 0:
            y_ctx, y_lat = hybrid_mixer(a_ctx, a_lat, rows, hy_w_in[j], gdn_conv_w[j], gdn_a_log[j], gdn_dt_bias[j],
                                        gdn_norm_w[j], ssd_conv_w[j], ssd_conv_b[j], ssd_a_log[j], ssd_dt_bias[j],
                                        ssd_d[j], ssd_norm_w[j], hy_w_out[j], need_ctx)
        else:
            y_ctx, y_lat = s5_mixer(a_ctx, a_lat, s5_w_in[j], s5_a_re[j], s5_a_im[j], s5_log_step[j], s5_b_re[j],
                                    s5_b_im[j], s5_c_re[j], s5_c_im[j], s5_d[j], s5_w_glu_a[j], s5_w_glu_b[j], need_ctx)
        ffn = (router_w[i], router_b[i], moe_w_gate[i], moe_b_gate[i], moe_w_up[i], moe_b_up[i],
               moe_w_down[i], moe_b_down[i])
        h_lat = h_lat + m_lat[2] * rmsnorm(y_lat, mix_norm_post[i])
        f_lat = moe_ffn(modulate(rmsnorm(h_lat, ffn_norm_pre[i]), m_lat[3], m_lat[4]), *ffn)
        h_lat = h_lat + m_lat[5] * rmsnorm(f_lat, ffn_norm_post[i])
        if need_ctx:
            h_ctx = h_ctx + m_ctx[2] * rmsnorm(y_ctx, mix_norm_post[i])
            f_ctx = moe_ffn(modulate(rmsnorm(h_ctx, ffn_norm_pre[i]), m_ctx[3], m_ctx[4]), *ffn)
            h_ctx = h_ctx + m_ctx[5] * rmsnorm(f_ctx, ffn_norm_post[i])
    return h_lat
```

```cpp
#include <hip/hip_runtime.h>
#include <cstdio>
#include <cstdint>
#include <cstring>

#define LAS __attribute__((address_space(3)))
typedef unsigned short bf16_t;
typedef short bf16x8 __attribute__((ext_vector_type(8)));
typedef float f32x4 __attribute__((ext_vector_type(4)));
typedef float f32x2 __attribute__((ext_vector_type(2)));
typedef unsigned u32x4 __attribute__((ext_vector_type(4)));
typedef unsigned u32x2 __attribute__((ext_vector_type(2)));

constexpr int D = 1024, NBATCH = 32, SEQ = 2048, CTXL = 256;
constexpr int TL = NBATCH * SEQ, TC = NBATCH * CTXL, TT = TL + TC;
constexpr int NEXP = 32;
constexpr int INW = 3616, INWP = 3840;
constexpr float RMS_EPS = 1e-6f;
constexpr int NCH = 4;
constexpr int S5T = 32, S5ROWS = 2304, S5K = 768;

enum { IX = 0, IC, ICTX, ICCTX, IADAW, IADAB, IMNPRE, IMNPOST, IFNPRE, IFNPOST, IRW, IRB, IWG, IBG, IWU, IBU, IWD, IBD, IHYIN, IGCW, IGALOG, IGDTB, IGNW,
       ISCW, ISCB, ISALOG, ISDTB, ISD, ISNW, IHYOUT, IS5IN, IS5ARE, IS5AIM, IS5LS, IS5BRE, IS5BIM, IS5CRE, IS5CIM, IS5D, IGLUA, IGLUB, NIN };

constexpr size_t MiB = 1u << 20;
constexpr size_t WS_CTL = 0, CTL_ZERO_BYTES = 65536;
constexpr size_t WS_R2 = 1 * MiB;
constexpr size_t WS_Z = 145 * MiB;
constexpr size_t WS_H = 145 * MiB;
constexpr size_t WS_Y = 305 * MiB;
constexpr size_t WS_UL = 145 * MiB;
constexpr size_t WS_YMIX1 = 145 * MiB;
constexpr size_t WS_XS = 289 * MiB;
constexpr size_t WS_GATE = 361 * MiB;
constexpr size_t WS_S5S = 361 * MiB;
constexpr size_t WS_GPOST = 370 * MiB;
constexpr size_t WS_CONVA = 384 * MiB;
constexpr size_t WS_OGDN = 384 * MiB;
constexpr size_t WS_YMIX = 384 * MiB;
constexpr size_t WS_MP = 505 * MiB;
constexpr size_t WS_E = 553 * MiB;
constexpr size_t WS_OSSD = 528 * MiB;
constexpr size_t WS_CONVB = 600 * MiB;
constexpr size_t WS_A1 = 625 * MiB;
constexpr size_t WS_Q = 744 * MiB, WS_K = 816 * MiB, WS_V = 888 * MiB;
constexpr size_t WS_WMOE = 768 * MiB;
constexpr size_t WS_A2Q = 864 * MiB;
constexpr float W8_SCALE = 32.0f, H8_SCALE = 4.0f;

constexpr size_t WS_BM = 960 * MiB, WS_CM = 996 * MiB;
constexpr size_t WS_HCTX = 1032 * MiB;
constexpr size_t WS_MOD = 1064 * MiB;
constexpr size_t WS_WIN = 1066 * MiB;
constexpr size_t WS_WOUT = 1074 * MiB;
constexpr size_t WS_RB = 1076 * MiB;
constexpr size_t WS_WS5IN = 1077 * MiB;
constexpr size_t WS_WGLU = 1079 * MiB;
constexpr size_t WS_KT = 1083 * MiB;
constexpr size_t WS_LP = 1087 * MiB;
constexpr size_t WS_BB = 1090 * MiB;
constexpr size_t WS_LOGITS = 1091 * MiB;
constexpr size_t WS_RE = 1100 * MiB;
constexpr size_t WS_TOK = 1104 * MiB;
constexpr size_t WS_HBL = 936 * MiB;
constexpr size_t WS_HBC = 1113 * MiB;
constexpr size_t WS_END = 1129 * MiB;
constexpr int CW_BAR = 4096, CW_CNT = 8192;

constexpr int LDS_BYTES = 147456, LDS_X = 131072  , LDS_MISC = LDS_BYTES - 1024;

__device__ __forceinline__ float bflo(unsigned w) { return __uint_as_float(w << 16); }
__device__ __forceinline__ float bfhi(unsigned w) { return __uint_as_float(w & 0xffff0000u); }
__device__ __forceinline__ float bf1(bf16_t b) { return __uint_as_float(((unsigned)b) << 16); }
typedef __bf16 bf16n2 __attribute__((ext_vector_type(2)));
__device__ __forceinline__ unsigned cvt_pk_bf16(float lo, float hi) { bf16n2 v; v.x = (__bf16)lo; v.y = (__bf16)hi; return __builtin_bit_cast(unsigned, v); }
__device__ __forceinline__ bf16_t f2bf(float f) { return (bf16_t)(cvt_pk_bf16(f, 0.f) & 0xffffu); }
__device__ __forceinline__ unsigned pack4_fp8(float a, float b, float c, float d) { int w = 0; w = __builtin_amdgcn_cvt_pk_fp8_f32(a, b, w, false); w = __builtin_amdgcn_cvt_pk_fp8_f32(c, d, w, true); return (unsigned)w; }
template <int CTRL, int RM = 0xF, int BM = 0xF> __device__ __forceinline__ float dppmov(float old, float src) { return __builtin_bit_cast(float, __builtin_amdgcn_update_dpp(__builtin_bit_cast(int, old), __builtin_bit_cast(int, src), CTRL, RM, BM, false)); }
__device__ __forceinline__ float wave_sum(float v) {
    v += dppmov<0xB1>(v, v); v += dppmov<0x4E>(v, v); v += dppmov<0x141>(v, v); v += dppmov<0x140>(v, v);
    const int b = __builtin_bit_cast(int, v);
    return (__builtin_bit_cast(float, __builtin_amdgcn_readlane(b, 0)) + __builtin_bit_cast(float, __builtin_amdgcn_readlane(b, 16))) + (__builtin_bit_cast(float, __builtin_amdgcn_readlane(b, 32)) + __builtin_bit_cast(float, __builtin_amdgcn_readlane(b, 48)));
}
__device__ __forceinline__ float siluf(float x) { return x * __builtin_amdgcn_rcpf(1.0f + __expf(-x)); }
__device__ __forceinline__ float sigmoidf_(float x) { return __builtin_amdgcn_rcpf(1.0f + __expf(-x)); }
__device__ __forceinline__ float softplusf_(float x) { return x > 20.f ? x : log1pf(expf(x)); }
#define PFMA(r, a, b) asm("v_fmac_f32 %0, %1, %2" : "+v"(r) : "v"(a), "v"(b))
#define LDS_WAIT() asm volatile("s_waitcnt lgkmcnt(0)" ::: "memory")
#define VM_WAIT() asm volatile("s_waitcnt vmcnt(0)" ::: "memory")
#define LDS_BAR() do { asm volatile("s_waitcnt lgkmcnt(0)" ::: "memory"); __builtin_amdgcn_s_barrier(); asm volatile("" ::: "memory"); } while (0)

__device__ __forceinline__ void ld_row_f32(const float* p, int lane, float (&v)[16]) {
#pragma unroll
    for (int j = 0; j < 2; ++j) { const f32x4 a = *(const f32x4*)(p + 8 * lane + 512 * j), b = *(const f32x4*)(p + 8 * lane + 512 * j + 4);
        v[8 * j + 0] = a.x; v[8 * j + 1] = a.y; v[8 * j + 2] = a.z; v[8 * j + 3] = a.w; v[8 * j + 4] = b.x; v[8 * j + 5] = b.y; v[8 * j + 6] = b.z; v[8 * j + 7] = b.w; }
}
__device__ __forceinline__ void st_row_f32(float* p, int lane, const float (&v)[16]) {
#pragma unroll
    for (int j = 0; j < 2; ++j) { *(f32x4*)(p + 8 * lane + 512 * j) = (f32x4){v[8 * j], v[8 * j + 1], v[8 * j + 2], v[8 * j + 3]}; *(f32x4*)(p + 8 * lane + 512 * j + 4) = (f32x4){v[8 * j + 4], v[8 * j + 5], v[8 * j + 6], v[8 * j + 7]}; }
}
__device__ __forceinline__ void unpack8(const u32x4 w, float* v) { v[0] = bflo(w.x); v[1] = bfhi(w.x); v[2] = bflo(w.y); v[3] = bfhi(w.y); v[4] = bflo(w.z); v[5] = bfhi(w.z); v[6] = bflo(w.w); v[7] = bfhi(w.w); }
__device__ __forceinline__ u32x4 pack8(const float* v) { u32x4 w; w.x = cvt_pk_bf16(v[0], v[1]); w.y = cvt_pk_bf16(v[2], v[3]); w.z = cvt_pk_bf16(v[4], v[5]); w.w = cvt_pk_bf16(v[6], v[7]); return w; }
__device__ __forceinline__ size_t blk_off(int r, int c) { return (size_t)(r >> 8) * (256 * 1024) + (size_t)(c >> 6) * (256 * 64) + (size_t)(r & 255) * 64 + (c & 63); }
__device__ __forceinline__ int inproj_row(int n) { const int c = n & 255; return (n & ~255) + 128 * ((c >> 5) & 1) + 32 * (c >> 6) + (c & 31); }
__device__ __forceinline__ size_t blk_off8(int r, int c) { return (size_t)(r >> 8) * (256 * 1024) + (size_t)(c >> 7) * (256 * 128) + (size_t)(r & 255) * 128 + (c & 127); }
__device__ __forceinline__ void ld_row_bf16(const bf16_t* p, int lane, float (&v)[16]) {
#pragma unroll
    for (int j = 0; j < 2; ++j) { const u32x4 w = *(const u32x4*)(p + 8 * lane + 512 * j); unpack8(w, &v[8 * j]); }
}
__device__ __forceinline__ void ld_row_fp8(const unsigned char* p, int lane, float (&v)[16]) {
#pragma unroll
    for (int j = 0; j < 2; ++j) { const u32x2 w = *(const u32x2*)(p + 8 * lane + 512 * j);
        const f32x2 a = __builtin_amdgcn_cvt_pk_f32_fp8((int)w.x, false), b = __builtin_amdgcn_cvt_pk_f32_fp8((int)w.x, true), c = __builtin_amdgcn_cvt_pk_f32_fp8((int)w.y, false), d = __builtin_amdgcn_cvt_pk_f32_fp8((int)w.y, true);
        v[8 * j] = a.x; v[8 * j + 1] = a.y; v[8 * j + 2] = b.x; v[8 * j + 3] = b.y; v[8 * j + 4] = c.x; v[8 * j + 5] = c.y; v[8 * j + 6] = d.x; v[8 * j + 7] = d.y; }
}
__device__ __forceinline__ void st_row_bf16(bf16_t* p, int lane, const float (&v)[16]) {
#pragma unroll
    for (int j = 0; j < 2; ++j) *(u32x4*)(p + 8 * lane + 512 * j) = pack8(&v[8 * j]);
}

__device__ __forceinline__ int lane_id(int z) { return (int)__builtin_amdgcn_mbcnt_hi(~0u, __builtin_amdgcn_mbcnt_lo(~0u, (unsigned)z)); }
#define XB_TMO      128
#define XB_XCNT(j)  (256  + 64 * (j))
#define XB_XSUB(j)  (1280 + 64 * (j))
#define XB_XGEN(j)  (2304 + 64 * (j))
#define XB_TOP      3328
#define XB_TOPGEN   3392
#define XCD_BAR_WORDS 3456
#define XB_SPIN_CAP (1u << 22)
__device__ __forceinline__ unsigned xb_ld(unsigned* p)              { return __hip_atomic_load(p, __ATOMIC_RELAXED, __HIP_MEMORY_SCOPE_AGENT); }
__device__ __forceinline__ unsigned xb_add(unsigned* p, unsigned v) { return __hip_atomic_fetch_add(p, v, __ATOMIC_RELAXED, __HIP_MEMORY_SCOPE_AGENT); }
__device__ __forceinline__ unsigned xb_xcc_id() { return (unsigned)__builtin_amdgcn_s_getreg((3 << 11) | 20) & 0xFu; }
#define XB_SPIN(cond, bar) do { unsigned _sp = 0; while (cond) { __builtin_amdgcn_s_sleep(1); \
    if ((++_sp & 255u) == 0u) { if (xb_ld(&(bar)[XB_TMO])) break; if (_sp > XB_SPIN_CAP) { atomicAdd(&(bar)[XB_TMO], 1u); break; } } } } while (0)
struct XcdBarrier { unsigned* bar; unsigned x; volatile LAS unsigned* st; };
__device__ __forceinline__ XcdBarrier xcd_barrier_post(unsigned* bar, volatile LAS unsigned* st) {
    XcdBarrier b; b.bar = bar; b.x = xb_xcc_id(); b.st = st;
    if (threadIdx.x == 0) (void)xb_add(&bar[XB_XCNT(b.x)], 1u);
    return b;
}
__device__ __forceinline__ void xcd_barrier_complete(unsigned* bar, unsigned x, unsigned& nloc, unsigned& nx) {
    const unsigned G = gridDim.x * gridDim.y * gridDim.z;
    unsigned sum, cnt, mine, sp = 0u;
    for (;;) {
        sum = 0u; cnt = 0u; mine = 0u;
#pragma unroll
        for (unsigned j = 0; j < 16; ++j) { const unsigned c = xb_ld(&bar[XB_XCNT(j)]); sum += c; cnt += (c > 0u) ? 1u : 0u; mine = (j == x) ? c : mine; }
        if (sum == G) break;
        __builtin_amdgcn_s_sleep(1);
        if ((++sp & 255u) == 0u) { if (xb_ld(&bar[XB_TMO])) break; if (sp > XB_SPIN_CAP) { atomicAdd(&bar[XB_TMO], 1u); break; } }
    }
    nloc = mine > 0u ? mine : 1u; nx = cnt > 0u ? cnt : 1u;
}
template <class PLT> __device__ __forceinline__ void xcd_barrier(const PLT& P, volatile LAS unsigned* st) {
    asm volatile("s_waitcnt vmcnt(0)" ::: "memory");
    __syncthreads();
    if (P.w0 == 0 && lane_id(P.z) == 0) {
        XcdBarrier b; b.bar = (unsigned*)(P.ws() + WS_CTL) + CW_BAR; b.x = xb_xcc_id(); b.st = st;
        unsigned* bar = b.bar;
        __builtin_amdgcn_s_waitcnt(0);
        unsigned nloc = b.st[0], nx = b.st[1];
        if (nloc == 0u) { xcd_barrier_complete(bar, b.x, nloc, nx); b.st[0] = nloc; b.st[1] = nx; }
        const unsigned old = xb_add(&bar[XB_XSUB(b.x)], 1u);
        const unsigned gen = old / nloc;
        if (old + 1u == (gen + 1u) * nloc) {
            __builtin_amdgcn_fence(__ATOMIC_RELEASE, "agent");
            asm volatile("s_waitcnt vmcnt(0)" ::: "memory");
            const unsigned og = xb_add(&bar[XB_TOP], 1u);
            const unsigned tg = og / nx;
            if (og + 1u == (tg + 1u) * nx) xb_add(&bar[XB_TOPGEN], 1u);
            else XB_SPIN(xb_ld(&bar[XB_TOPGEN]) == tg, bar);
            __builtin_amdgcn_fence(__ATOMIC_ACQUIRE, "agent");
            xb_add(&bar[XB_XGEN(b.x)], 1u);
            asm volatile("s_waitcnt vmcnt(0)" ::: "memory");
        } else {
            XB_SPIN(xb_ld(&bar[XB_XGEN(b.x)]) == gen, bar);
            __builtin_amdgcn_fence(__ATOMIC_ACQUIRE, "agent");
            asm volatile("s_waitcnt vmcnt(0)" ::: "memory");
        }
    }
    __syncthreads();
}

namespace pg8 {
constexpr int BM = 256, BK = 64, HALF = 128, HTB = HALF * BK * 2, STAGE_BYTES = 8 * HTB, NXCD = 8, WGM = 8;
__device__ __forceinline__ int lds_byte(int r, int c) { const int st = (r >> 4) * 2 + (c >> 5), rr = r & 15, cc = c & 31, ob = rr * 64 + cc * 2; return st * 1024 + (ob ^ (((ob >> 9) & 1) << 5)); }
__device__ __forceinline__ void stage_rc(int b, int& R, int& C) { const int st = b / 1024, sb = b % 1024, swz = sb ^ (((sb >> 9) & 1) << 5); R = (st >> 1) * 16 + swz / 64; C = (st & 1) * 32 + (swz % 64) / 2; }
__device__ __forceinline__ int perm32(int rho) { const int n = rho >> 4, i = rho & 15; return 8 * (i >> 2) + 4 * n + (i & 3); }

struct Unit { const char* A; const char* B; const int* gat; int nvalid; int r0, c0, e; };

struct TileOrder {
    int nM, nN, nwg, G, c;
    __device__ void init(int nM_, int nN_, int G_, int c_) { nM = nM_; nN = nN_; nwg = nM * nN; G = G_; c = c_; }
    __device__ bool next(int i, int& pm, int& pn) const {
        const long L = (long)i * G + c; if (L >= nwg) return false;
        int wgid = (int)L; { const int q = nwg / NXCD, r = nwg % NXCD, xcd = wgid % NXCD, off = wgid / NXCD; wgid = (xcd < r ? xcd * (q + 1) : r * (q + 1) + (xcd - r) * q) + off; }
        const int nig = WGM * nN, gid = wgid / nig, fm = gid * WGM, gsz = (nM - fm) < WGM ? (nM - fm) : WGM;
        pm = fm + ((wgid % nig) % gsz); pn = (wgid % nig) / gsz; return true;
    }
};

typedef int v8i32 __attribute__((ext_vector_type(8)));
template <class Epi, class Sched, bool GATHER, bool FP8 = false>
__device__ __forceinline__ void gemm_phase(LAS unsigned char* lds, const int K, const int lda, const int ldb, const Sched& S, const Epi& E, const int tid, const int kstepb = BK * 2) {
    constexpr int ES = FP8 ? 1 : 2;
    const int wid = __builtin_amdgcn_readfirstlane(tid >> 6), lane = tid & 63, wr = wid >> 2, wc = wid & 3, fr = lane & 15, fq = lane >> 4;
    const int nt = K / (FP8 ? 2 * BK : BK);
    unsigned cvA[2][2], nvA[2][2], voffB[2]; int stR[2], stC[2];
#pragma unroll
    for (int i = 0; i < 2; ++i) { int R, C; stage_rc(tid * 16 + i * 8192, R, C); stR[i] = R; stC[i] = C; const int Rb = Epi::PERM ? ((R & ~31) + perm32(R & 31)) : R;
        voffB[i] = (unsigned)(Rb * ldb * ES + C * 2);
#pragma unroll
        for (int h = 0; h < 2; ++h) { cvA[h][i] = (unsigned)((R + HALF * h) * lda * ES + C * 2); nvA[h][i] = cvA[h][i]; } }
    const size_t kstep = (size_t)kstepb;
    const size_t hstepB = (size_t)HALF * ldb * ES;
    const unsigned ldsw = (unsigned)wid * 1024u;
    const int aoff0 = lds_byte(wr * 64 + fr, fq * 8), aoff1 = aoff0 + 1024;
    const int boff0 = lds_byte(wc * 32 + fr, fq * 8), boff1 = boff0 + 1024;
    LAS unsigned char* pA = lds + aoff0; LAS unsigned char* pB = lds + 4 * HTB + boff0;
    asm volatile("" : "+v"(pA), "+v"(pB));
#define PG8_SA(b, h) (((b) * 2 + (h)) * HTB)
#define PG8_SB(b, h) ((4 + (b) * 2 + (h)) * HTB)
#define PG8_STAGE(bufoff, gbase, v0, v1) do { \
        __builtin_amdgcn_global_load_lds((const unsigned*)((const char*)(gbase) + (v0)), (LAS unsigned*)(lds + (bufoff) + ldsw), 16, 0, 0); \
        __builtin_amdgcn_global_load_lds((const unsigned*)((const char*)(gbase) + (v1)), (LAS unsigned*)(lds + (bufoff) + ldsw + 8192), 16, 0, 0); } while (0)
#define PG8_LD32(addr0, addr1) __builtin_bit_cast(v8i32, __builtin_shufflevector(*(const LAS u32x4*)(addr0), *(const LAS u32x4*)(addr1), 0, 1, 2, 3, 4, 5, 6, 7))
#define PG8_LDA(dst, b, h) do { _Pragma("unroll") for (int m = 0; m < 4; ++m) { if constexpr (FP8) dst##8[m] = PG8_LD32(pA + PG8_SA(b, h) + m * 2048, pA + PG8_SA(b, h) + (aoff1 - aoff0) + m * 2048); \
        else { _Pragma("unroll") for (int k = 0; k < 2; ++k) dst[m][k] = *(const LAS bf16x8*)(pA + PG8_SA(b, h) + (k ? aoff1 - aoff0 : 0) + m * 2048); } } } while (0)
#define PG8_LDB(dst, b, h) do { _Pragma("unroll") for (int n = 0; n < 2; ++n) { if constexpr (FP8) dst##8[n] = PG8_LD32(pB + (PG8_SB(b, h) - 4 * HTB) + n * 2048, pB + (PG8_SB(b, h) - 4 * HTB) + (boff1 - boff0) + n * 2048); \
        else { _Pragma("unroll") for (int k = 0; k < 2; ++k) dst[n][k] = *(const LAS bf16x8*)(pB + (PG8_SB(b, h) - 4 * HTB) + (k ? boff1 - boff0 : 0) + n * 2048); } } } while (0)
#define PG8_CAT(x0, x1) __builtin_shufflevector(__builtin_bit_cast(u32x4, x0), __builtin_bit_cast(u32x4, x1), 0, 1, 2, 3, 4, 5, 6, 7)
#define PG8_MMA(ai, bj, At, Bt) do { __builtin_amdgcn_s_setprio(1); _Pragma("unroll") for (int m = 0; m < 4; ++m) _Pragma("unroll") for (int n = 0; n < 2; ++n) { \
        if constexpr (FP8) asm volatile("v_mfma_f32_16x16x128_f8f6f4 %0, %1, %2, %0" : "+v"(acc[ai][bj][m][n]) : "v"(Bt##8[n]), "v"(At##8[m]));   \
        else { _Pragma("unroll") for (int k = 0; k < 2; ++k) acc[ai][bj][m][n] = __builtin_amdgcn_mfma_f32_16x16x32_bf16(Bt[n][k], At[m][k], acc[ai][bj][m][n], 0, 0, 0); } } __builtin_amdgcn_s_setprio(0); } while (0)
#define PG8_WAIT_V(n) asm volatile("s_waitcnt vmcnt(" #n ")" ::: "memory")
#define PG8_WAIT_L(n) asm volatile("s_waitcnt lgkmcnt(" #n ")" ::: "memory")
#define PG8_BAR __builtin_amdgcn_s_barrier()
#define PG8_SCHED __builtin_amdgcn_sched_barrier(0)
#define PG8_GATHER(u, dst) do { _Pragma("unroll") for (int h = 0; h < 2; ++h) _Pragma("unroll") for (int i = 0; i < 2; ++i) { const int rr = h * HALF + stR[i]; \
        const int tok = (rr < (u).nvalid) ? (u).gat[rr] : 0; dst[h][i] = kstepb == BK * 2 ? (unsigned)(tok * lda * ES + stC[i] * 2) : (unsigned)((tok >> 8) * (256 * 1024) + (tok & 255) * 128 + stC[i] * 2); } } while (0)
    Unit cur, nxt; int ui = 0;
    if (!S.next(0, cur)) return;
    f32x4 acc[2][2][4][2];
#pragma unroll
    for (int a = 0; a < 2; ++a)
#pragma unroll
        for (int b = 0; b < 2; ++b)
#pragma unroll
            for (int m = 0; m < 4; ++m)
#pragma unroll
                for (int n = 0; n < 2; ++n) acc[a][b][m][n] = (f32x4){0.f, 0.f, 0.f, 0.f};
    bf16x8 At[4][2], B0[2][2], B1[2][2]; v8i32 At8[4], B08[2], B18[2];
    if constexpr (GATHER) { PG8_GATHER(cur, cvA); }
    const char* cA = cur.A; const char* cB = cur.B;
    PG8_STAGE(PG8_SB(0, 0), cB, voffB[0], voffB[1]); PG8_STAGE(PG8_SB(0, 1), cB + hstepB, voffB[0], voffB[1]); PG8_STAGE(PG8_SA(0, 0), cA, cvA[0][0], cvA[0][1]); PG8_STAGE(PG8_SA(0, 1), cA, cvA[1][0], cvA[1][1]);
    if (wr == 1) PG8_BAR;
    PG8_WAIT_V(2); PG8_BAR;
    PG8_STAGE(PG8_SB(1, 0), cB + kstep, voffB[0], voffB[1]); PG8_STAGE(PG8_SA(1, 0), cA + kstep, cvA[0][0], cvA[0][1]); PG8_STAGE(PG8_SB(1, 1), cB + hstepB + kstep, voffB[0], voffB[1]);
    PG8_WAIT_V(6); PG8_BAR;
    for (;;) {
        const bool has_next = S.next(ui + 1, nxt);
        if constexpr (GATHER) { if (has_next) { PG8_GATHER(nxt, nvA); } else {
#pragma unroll
            for (int h = 0; h < 2; ++h)
#pragma unroll
                for (int i = 0; i < 2; ++i) nvA[h][i] = cvA[h][i]; } }
        const char* nA = has_next ? nxt.A : cA; const char* nB = has_next ? nxt.B : cB;
#pragma unroll 1
        for (int t = 0; t < nt; t += 2) {
            const bool last = (t == nt - 2);
            const char* a1 = cA + (size_t)(t + 1) * kstep;
            const char* a2 = last ? nA : cA + (size_t)(t + 2) * kstep; const char* b2 = last ? nB : cB + (size_t)(t + 2) * kstep;
            asm volatile("" : "+s"(a1), "+s"(a2), "+s"(b2));
            asm volatile("" : "+v"(voffB[0]), "+v"(voffB[1]), "+v"(cvA[0][0]), "+v"(cvA[0][1]), "+v"(cvA[1][0]), "+v"(cvA[1][1]));
            const char* a3 = a2 + kstep; const char* b3 = b2 + kstep;
            unsigned x00 = cvA[0][0], x01 = cvA[0][1], x10 = cvA[1][0], x11 = cvA[1][1];
            if constexpr (GATHER) { if (last) { x00 = nvA[0][0]; x01 = nvA[0][1]; x10 = nvA[1][0]; x11 = nvA[1][1]; } }
            PG8_LDB(B0, 0, 0); PG8_LDB(B1, 0, 1); PG8_SCHED; PG8_LDA(At, 0, 0); PG8_STAGE(PG8_SA(1, 1), a1, cvA[1][0], cvA[1][1]);
            PG8_WAIT_V(8); PG8_WAIT_L(0); PG8_BAR; PG8_MMA(0, 0, At, B0); PG8_MMA(0, 1, At, B1); PG8_BAR; PG8_SCHED;
            PG8_LDA(At, 0, 1); PG8_STAGE(PG8_SB(0, 0), b2, voffB[0], voffB[1]); PG8_STAGE(PG8_SB(0, 1), b2 + hstepB, voffB[0], voffB[1]); PG8_STAGE(PG8_SA(0, 0), a2, x00, x01);
            PG8_WAIT_V(8); PG8_WAIT_L(0); PG8_BAR; PG8_MMA(1, 0, At, B0); PG8_MMA(1, 1, At, B1); PG8_BAR; PG8_SCHED;
            PG8_LDB(B0, 1, 0); PG8_LDB(B1, 1, 1); PG8_SCHED; PG8_LDA(At, 1, 0); PG8_STAGE(PG8_SA(0, 1), a2, x10, x11);
            PG8_WAIT_V(8); PG8_WAIT_L(0); PG8_BAR; PG8_MMA(0, 0, At, B0); PG8_MMA(0, 1, At, B1); PG8_BAR; PG8_SCHED;
            PG8_LDA(At, 1, 1); PG8_STAGE(PG8_SB(1, 0), b3, voffB[0], voffB[1]); PG8_STAGE(PG8_SB(1, 1), b3 + hstepB, voffB[0], voffB[1]); PG8_STAGE(PG8_SA(1, 0), a3, x00, x01);
            PG8_WAIT_V(8); PG8_WAIT_L(0); PG8_BAR; PG8_MMA(1, 0, At, B0); PG8_MMA(1, 1, At, B1); PG8_BAR; PG8_SCHED;
        }
        if constexpr (FP8) asm volatile("s_nop 15\n\ts_nop 15\n\ts_nop 7" ::: "memory");
        if (wr == 0) PG8_BAR;
        { Unit eu = cur; asm volatile("" : "+s"(eu.r0), "+s"(eu.c0), "+s"(eu.e));
          E(acc, eu, wr, wc, fr, fq); }
        if (!has_next) break;
#pragma unroll
        for (int a = 0; a < 2; ++a)
#pragma unroll
            for (int b = 0; b < 2; ++b)
#pragma unroll
                for (int m = 0; m < 4; ++m)
#pragma unroll
                    for (int n = 0; n < 2; ++n) acc[a][b][m][n] = (f32x4){0.f, 0.f, 0.f, 0.f};
        cur = nxt; cA = nA; cB = nB; ++ui;
        if constexpr (GATHER) {
#pragma unroll
            for (int h = 0; h < 2; ++h)
#pragma unroll
                for (int i = 0; i < 2; ++i) cvA[h][i] = nvA[h][i]; }
        if (wr == 1) PG8_BAR;
    }
    PG8_WAIT_V(0);
    PG8_BAR;
#undef PG8_SA
#undef PG8_SB
#undef PG8_STAGE
#undef PG8_LDA
#undef PG8_LD32
#undef PG8_LDB
#undef PG8_MMA
#undef PG8_CAT
#undef PG8_WAIT_V
#undef PG8_WAIT_L
#undef PG8_BAR
#undef PG8_SCHED
#undef PG8_GATHER
}
}
using pg8::Unit;

struct Params { const float* in[NIN]; float* out; unsigned char* ws; };
constexpr int LDS_PARAMS = LDS_BYTES - 1024 + 256;
__device__ __forceinline__ int opaque0() { int z; asm volatile("s_mov_b32 %0, 0" : "=s"(z)); return z; }
struct PL {
    LAS unsigned char* lds; int z; int w0;
    __device__ __forceinline__ unsigned long long word(int i) const { const LAS unsigned* w = (const LAS unsigned*)(lds + LDS_PARAMS) + 2 * i;
        const unsigned lo = __builtin_amdgcn_readfirstlane(w[0]), hi = __builtin_amdgcn_readfirstlane(w[1]); return ((unsigned long long)hi << 32) | lo; }
    __device__ __forceinline__ const float* in(int i) const { return (const float*)(__attribute__((address_space(1))) const float*)word(i); }
    __device__ __forceinline__ float* out() const { return (float*)(__attribute__((address_space(1))) float*)word(NIN); }
    __device__ __forceinline__ unsigned char* ws() const { return (unsigned char*)(__attribute__((address_space(1))) unsigned char*)word(NIN + 1); }
};

struct EpiBf16 {
    static constexpr bool PERM = true;
    bf16_t* O; int ldc; const float* bias; int bias_estride; float ascale = 1.0f;
    __device__ __forceinline__ void operator()(const f32x4 (&acc)[2][2][4][2], const Unit& u, int wr, int wc, int fr, int fq) const {
        const int row0 = u.r0 + wr * 64 + fr, col0 = u.c0 * 256 + wc * 32 + 8 * fq;
        f32x4 bv[2][2];
#pragma unroll
        for (int bj = 0; bj < 2; ++bj)
#pragma unroll
            for (int n = 0; n < 2; ++n) bv[bj][n] = bias ? *(const f32x4*)(bias + (size_t)u.e * bias_estride + col0 + bj * 128 + 4 * n) : (f32x4){0.f, 0.f, 0.f, 0.f};
#pragma unroll
        for (int ai = 0; ai < 2; ++ai)
#pragma unroll
            for (int m = 0; m < 4; ++m) { bf16_t* rowp = O + (size_t)(row0 + ai * 128 + m * 16) * ldc + col0;
#pragma unroll
                for (int bj = 0; bj < 2; ++bj) { const f32x4 v0 = acc[ai][bj][m][0] * ascale + bv[bj][0], v1 = acc[ai][bj][m][1] * ascale + bv[bj][1];
                    u32x4 w; w.x = cvt_pk_bf16(v0[0], v0[1]); w.y = cvt_pk_bf16(v0[2], v0[3]); w.z = cvt_pk_bf16(v1[0], v1[1]); w.w = cvt_pk_bf16(v1[2], v1[3]);
                    *(u32x4*)(rowp + bj * 128) = w; } }
    }
};
struct EpiFp8 {
    static constexpr bool PERM = true;
    unsigned char* O; int ldc; const float* bias; int bias_estride; float ascale;
    __device__ __forceinline__ void operator()(const f32x4 (&acc)[2][2][4][2], const Unit& u, int wr, int wc, int fr, int fq) const {
        const int row0 = u.r0 + wr * 64 + fr, col0 = u.c0 * 256 + wc * 32 + 8 * fq;
        f32x4 bv[2][2];
#pragma unroll
        for (int bj = 0; bj < 2; ++bj)
#pragma unroll
            for (int n = 0; n < 2; ++n) bv[bj][n] = *(const f32x4*)(bias + (size_t)u.e * bias_estride + col0 + bj * 128 + 4 * n);
#pragma unroll
        for (int ai = 0; ai < 2; ++ai)
#pragma unroll
            for (int m = 0; m < 4; ++m) { unsigned char* rowp = O + (size_t)(row0 + ai * 128 + m * 16) * ldc + col0;
#pragma unroll
                for (int bj = 0; bj < 2; ++bj) { const f32x4 v0 = acc[ai][bj][m][0] * ascale + bv[bj][0], v1 = acc[ai][bj][m][1] * ascale + bv[bj][1];
                    u32x2 q; q.x = pack4_fp8(v0[0], v0[1], v0[2], v0[3]); q.y = pack4_fp8(v1[0], v1[1], v1[2], v1[3]); *(u32x2*)(rowp + bj * 128) = q; } }
    }
};
__device__ __forceinline__ void epi_cols32(const f32x4 (&acc)[2][2][4][2], float* dst, const float* bias, int r0, int wr, int wc, int fr, int fq, float ascale) {
    if (wc != 0) return;
    const int row0 = r0 + wr * 64 + fr, c = 8 * fq;
    f32x4 b0 = (f32x4){0.f, 0.f, 0.f, 0.f}, b1 = b0;
    if (bias) { b0 = *(const f32x4*)(bias + c); b1 = *(const f32x4*)(bias + c + 4); }
#pragma unroll
    for (int ai = 0; ai < 2; ++ai)
#pragma unroll
        for (int m = 0; m < 4; ++m) { float* p = dst + (size_t)(row0 + ai * 128 + m * 16) * 32 + c;
            *(f32x4*)p = acc[ai][0][m][0] * ascale + b0; *(f32x4*)(p + 4) = acc[ai][0][m][1] * ascale + b1; }
}
struct EpiInProj {
    static constexpr bool PERM = true;
    bf16_t *ca, *cb, *z; float* gate;
    __device__ __forceinline__ void operator()(const f32x4 (&acc)[2][2][4][2], const Unit& u, int wr, int wc, int fr, int fq) const {
        if (u.c0 == 14) { epi_cols32(acc, gate, nullptr, u.r0, wr, wc, fr, fq, 1.0f); return; }
        bf16_t* O; int ldc, c0;
        if (u.c0 < 6) { O = ca; ldc = 1536; c0 = u.c0; } else if (u.c0 < 10) { O = cb; ldc = 1024; c0 = u.c0 - 6; } else { O = z; ldc = 1024; c0 = u.c0 - 10; }
        const bool odd = (fr & 1) != 0;
        const int col = c0 * 256 + wc * 64 + (odd ? 32 : 0) + 8 * fq, rowb = u.r0 + wr * 64 + (fr & ~1);
#pragma unroll
        for (int ai = 0; ai < 2; ++ai)
#pragma unroll
            for (int m = 0; m < 4; ++m) { unsigned p0[4], p1[4], s0[4], s1[4];
#pragma unroll
                for (int n = 0; n < 2; ++n) { p0[2 * n] = cvt_pk_bf16(acc[ai][0][m][n][0], acc[ai][0][m][n][1]); p0[2 * n + 1] = cvt_pk_bf16(acc[ai][0][m][n][2], acc[ai][0][m][n][3]);
                    p1[2 * n] = cvt_pk_bf16(acc[ai][1][m][n][0], acc[ai][1][m][n][1]); p1[2 * n + 1] = cvt_pk_bf16(acc[ai][1][m][n][2], acc[ai][1][m][n][3]); }
#pragma unroll
                for (int i = 0; i < 4; ++i) { const unsigned x = odd ? p0[i] : p1[i]; const unsigned rcv = (unsigned)__builtin_amdgcn_update_dpp(0, (int)x, 0xB1, 0xF, 0xF, false);
                    s0[i] = odd ? rcv : p0[i]; s1[i] = odd ? p1[i] : rcv; }
                bf16_t* rp = O + (size_t)(rowb + ai * 128 + m * 16) * ldc + col;
                *(u32x4*)rp = (u32x4){s0[0], s0[1], s0[2], s0[3]}; *(u32x4*)(rp + ldc) = (u32x4){s1[0], s1[1], s1[2], s1[3]}; }
    }
};
struct EpiSwiGLU {
    static constexpr bool PERM = true;
    unsigned char* H; const float* bg; const float* bu;
    __device__ __forceinline__ void operator()(const f32x4 (&acc)[2][2][4][2], const Unit& u, int wr, int wc, int fr, int fq) const {
        const int row0 = u.r0 + wr * 64 + fr, colf = u.c0 * 128 + wc * 32 + 8 * fq;
        f32x4 gv[2], uv[2];
#pragma unroll
        for (int n = 0; n < 2; ++n) { gv[n] = *(const f32x4*)(bg + (size_t)u.e * 1024 + colf + 4 * n); uv[n] = (*(const f32x4*)(bu + (size_t)u.e * 1024 + colf + 4 * n) + 1.0f) * H8_SCALE; }
#pragma unroll
        for (int ai = 0; ai < 2; ++ai)
#pragma unroll
            for (int m = 0; m < 4; ++m) { float o[8];
#pragma unroll
                for (int n = 0; n < 2; ++n) { const f32x4 g = acc[ai][0][m][n] * (1.0f / W8_SCALE) + gv[n], l = acc[ai][1][m][n] * (H8_SCALE / W8_SCALE) + uv[n];
#pragma unroll
                    for (int j = 0; j < 4; ++j) { const float gl = fminf(g[j], 7.0f), lp = fminf(fmaxf(l[j], -6.0f * H8_SCALE), 8.0f * H8_SCALE);
                        o[4 * n + j] = gl * __builtin_amdgcn_rcpf(1.0f + __builtin_amdgcn_exp2f(gl * (-1.702f * 1.4426950408889634f))) * lp; } }
                u32x2 q; q.x = pack4_fp8(o[0], o[1], o[2], o[3]); q.y = pack4_fp8(o[4], o[5], o[6], o[7]);
                *(u32x2*)(H + blk_off8(row0 + ai * 128 + m * 16, colf)) = q; }
    }
};
struct EpiGLU {
    static constexpr bool PERM = true;
    bf16_t* O;
    __device__ __forceinline__ void operator()(const f32x4 (&acc)[2][2][4][2], const Unit& u, int wr, int wc, int fr, int fq) const {
        const int row0 = u.r0 + wr * 64 + fr, colf = u.c0 * 128 + wc * 32 + 8 * fq;
#pragma unroll
        for (int ai = 0; ai < 2; ++ai)
#pragma unroll
            for (int m = 0; m < 4; ++m) { float o[8];
#pragma unroll
                for (int n = 0; n < 2; ++n) { const f32x4 a = acc[ai][0][m][n], b = acc[ai][1][m][n];
#pragma unroll
                    for (int j = 0; j < 4; ++j) o[4 * n + j] = a[j] * (1.0f / W8_SCALE) * sigmoidf_(b[j] * (1.0f / W8_SCALE)); }
                *(u32x4*)(O + (size_t)(row0 + ai * 128 + m * 16) * 1024 + colf) = pack8(o); }
    }
};
__device__ __forceinline__ void s5_rowmap(int r, int& crow, int& t) {
    if (r < TL) { const int b = r >> 11, l = r & 2047; crow = b * 64 + (l >> 5); t = l & 31; }
    else { const int rc = r - TL, b = rc >> 8, l = rc & 255; crow = 2048 + b * 8 + (l >> 5); t = l & 31; }
}
struct EpiS5U {
    static constexpr bool PERM = true;
    bf16_t* UL;
    __device__ __forceinline__ void operator()(const f32x4 (&acc)[2][2][4][2], const Unit& u, int wr, int wc, int fr, int fq) const {
        const int row0 = u.r0 + wr * 64 + fr, col0 = u.c0 * 256 + wc * 32 + 8 * fq;
#pragma unroll
        for (int ai = 0; ai < 2; ++ai)
#pragma unroll
            for (int m = 0; m < 4; ++m) { int crow, t; s5_rowmap(row0 + ai * 128 + m * 16, crow, t);
#pragma unroll
                for (int bj = 0; bj < 2; ++bj) { const int c = col0 + bj * 128, g = c >> 4; const f32x4 v0 = acc[ai][bj][m][0] * (1.0f / W8_SCALE), v1 = acc[ai][bj][m][1] * (1.0f / W8_SCALE);
                    u32x4 w; w.x = cvt_pk_bf16(v0[0], v0[1]); w.y = cvt_pk_bf16(v0[2], v0[3]); w.z = cvt_pk_bf16(v1[0], v1[1]); w.w = cvt_pk_bf16(v1[2], v1[3]);
                    *(u32x4*)(UL + ((size_t)g * S5ROWS + crow) * S5K + t * 16 + (c & 15)) = w; } }
    }
};
struct EpiS5S {
    static constexpr bool PERM = false;
    float* S;
    __device__ __forceinline__ void operator()(const f32x4 (&acc)[2][2][4][2], const Unit& u, int wr, int wc, int fr, int fq) const {
        const int row0 = u.r0 + wr * 64 + fr, col0 = wc * 32 + 4 * fq;
#pragma unroll
        for (int ai = 0; ai < 2; ++ai)
#pragma unroll
            for (int m = 0; m < 4; ++m) { float* rowp = S + ((size_t)u.e * S5ROWS + row0 + ai * 128 + m * 16) * 256 + col0;
#pragma unroll
                for (int bj = 0; bj < 2; ++bj)
#pragma unroll
                    for (int n = 0; n < 2; ++n) *(f32x4*)(rowp + bj * 128 + n * 16) = acc[ai][bj][m][n]; }
    }
};
__device__ __forceinline__ float gelu_tanh(float x) { const float u = 0.7978845608f * (x + 0.044715f * x * x * x); return x * sigmoidf_(2.0f * u); }
struct EpiS5Y {
    static constexpr bool PERM = true;
    unsigned char* OG;
    __device__ __forceinline__ void operator()(const f32x4 (&acc)[2][2][4][2], const Unit& u, int wr, int wc, int fr, int fq) const {
        const int row0 = u.r0 + wr * 64 + fr, n0 = u.c0 * 256 + wc * 32 + 8 * fq;
#pragma unroll
        for (int ai = 0; ai < 2; ++ai)
#pragma unroll
            for (int m = 0; m < 4; ++m) { const int crow = row0 + ai * 128 + m * 16;
#pragma unroll
                for (int bj = 0; bj < 2; ++bj) { const int n = n0 + bj * 128, t = n >> 4, h0 = n & 15; float o[8];
#pragma unroll
                    for (int j = 0; j < 4; ++j) { o[j] = gelu_tanh(acc[ai][bj][m][0][j]); o[4 + j] = gelu_tanh(acc[ai][bj][m][1][j]); }
                    u32x2 q; q.x = pack4_fp8(o[0], o[1], o[2], o[3]); q.y = pack4_fp8(o[4], o[5], o[6], o[7]);
                    *(u32x2*)(OG + ((size_t)crow * 32 + t) * 1024 + u.e * 16 + h0) = q; } }
    }
};

struct DenseSched {
    pg8::TileOrder T; const char* A; const char* B; size_t astep, bstep;
    __device__ void init(const void* A_, const void* B_, int nM, int nN, int lda, int ldb, int z, int es = 2) { T.init(nM, nN, (int)gridDim.x + z, (int)blockIdx.x + z); A = (const char*)A_; B = (const char*)B_; astep = (size_t)256 * lda * es; bstep = (size_t)256 * ldb * es; }
    __device__ __forceinline__ bool next(int i, Unit& u) const { int pm, pn; if (!T.next(i, pm, pn)) return false;
        u.A = A + pm * astep; u.B = B + pn * bstep; u.gat = nullptr; u.nvalid = 256; u.r0 = pm * 256; u.c0 = pn; u.e = 0; return true; }
};
struct GroupSched {
    const char* A; const char* B; size_t agstep, bgstep, astep, bstep; int nG, nM, nN, G, c;
    __device__ __forceinline__ bool next(int i, Unit& u) const { const long L = (long)i * G + c; if (L >= (long)nG * nM * nN) return false;
        const int per = nM * nN, g = (int)(L / per), rem = (int)(L % per), pm = rem / nN, pn = rem % nN;
        u.A = A + g * agstep + pm * astep; u.B = B + g * bgstep + pn * bstep; u.gat = nullptr; u.nvalid = 256; u.r0 = pm * 256; u.c0 = pn; u.e = g; return true; }
};
struct MoeSched {
    const LAS int* tp; const LAS int* cnt; const LAS int* te  ; int NC, ntiles; bool gather;
    const char* A; const char* B; size_t bestep  ; const int* tok; int CT, G, c; int rowbytes  ; int xrot  ;
    __device__ __forceinline__ bool next(int i, Unit& u) const {
        int rt, ct;
        if (G == 256) { const int xcd = ((c & 7) + 8 - xrot) & 7, j = c >> 3, RPS = 32 / NC; rt = (i * 8 + xcd) * RPS + j / NC; ct = j % NC; }
        else { const long L = (long)i * G + c; rt = (int)(L / NC); ct = (int)(L % NC); }
        if (rt >= ntiles) return false;
        const int e = __builtin_amdgcn_readfirstlane(te[rt]), lt = rt - __builtin_amdgcn_readfirstlane(tp[e]);
        u.e = e; u.r0 = rt * 256; u.c0 = ct; u.nvalid = cnt[e] - lt * 256; u.gat = tok + (size_t)e * CT + lt * 256;
        u.A = gather ? A : A + (size_t)rt * 256 * rowbytes; u.B = B + (size_t)e * bestep + (size_t)ct * 256 * rowbytes; return true;
    }
};

#define TID (P.w0 * 64 + lane_id(P.z))
#define BID ((int)blockIdx.x + P.z)
#define GDIM ((int)gridDim.x + P.z)
#define wave_id() __builtin_amdgcn_readfirstlane(TID >> 6)
__device__ __forceinline__ bf16_t* hbrow(unsigned char* ws, int r) { return r < TL ? (bf16_t*)(ws + WS_HBL) + (size_t)r * D : (bf16_t*)(ws + WS_HBC) + (size_t)(r - TL) * D; }
__device__ __forceinline__ const float* xrow(const float* x, const float* ctx, int r) { return r < TL ? x + (size_t)r * D : ctx + (size_t)(r - TL) * D; }
__device__ __forceinline__ const float* modp(const unsigned char* ws, int layer, int r, int which) { const int mb = r < TL ? (r >> 11) : 32; return (const float*)(ws + WS_MOD) + ((size_t)(layer * 33 + mb) * 6 + which) * D; }

__device__ __forceinline__ void phase_mod(const PL& P, LAS unsigned char* lds) {
    LAS float* sT = (LAS float*)lds; LAS float* red = (LAS float*)(lds + 17 * 1024 * 4);
    const int tid = TID, lane = tid & 63, wave = wave_id();
    float* MOD = (float*)(P.ws() + WS_MOD); const float* cc = P.in(IC); const float* cctx = P.in(ICCTX); const float* adaw = P.in(IADAW); const float* adab = P.in(IADAB);
    for (int rg = 0; rg < 2; ++rg) {
        const int r0 = rg * 17, nr = rg == 0 ? 17 : 16;
        __syncthreads();
        for (int i = tid; i < nr * 1024; i += 512) { const int r = r0 + (i >> 10), k = i & 1023; const float x = r < 32 ? cc[r * 1024 + k] : cctx[k]; sT[i] = x / (1.0f + expf(-x)); }
        __syncthreads();
        for (int cb = BID; cb < 256; cb += GDIM) {
            const int col0 = cb * 48, layer = col0 / 6144, cl0 = col0 % 6144;
            const float* W = adaw + (size_t)layer * 1024 * 6144 + cl0;
            float acc[17];
#pragma unroll
            for (int r = 0; r < 17; ++r) acc[r] = 0.f;
            if (lane < 48) {
#pragma unroll 1
                for (int k = wave * 128; k < wave * 128 + 128; k += 16) {
                    float wk[16];
#pragma unroll
                    for (int q = 0; q < 16; ++q) wk[q] = W[(size_t)(k + q) * 6144 + lane];
#pragma unroll
                    for (int q = 0; q < 16; q += 4)
#pragma unroll
                        for (int r = 0; r < 17; ++r) { if (r < nr) { const f32x4 s4 = *(const LAS f32x4*)(sT + r * 1024 + k + q); PFMA(acc[r], s4.x, wk[q]); PFMA(acc[r], s4.y, wk[q + 1]); PFMA(acc[r], s4.z, wk[q + 2]); PFMA(acc[r], s4.w, wk[q + 3]); }
                            if (r == 16) asm volatile("" ::: "memory"); }
                }
#pragma unroll
                for (int r = 0; r < 17; ++r) red[(wave * 17 + r) * 48 + lane] = acc[r];
            }
            __syncthreads();
            for (int o = tid; o < nr * 48; o += 512) { const int r = o / 48, c = o % 48; float s = 0.f;
#pragma unroll
                for (int w = 0; w < 8; ++w) s += red[(w * 17 + r) * 48 + c];
                MOD[(size_t)(layer * 33 + r0 + r) * 6144 + cl0 + c] = s + adab[layer * 6144 + cl0 + c]; }
            __syncthreads();
        }
    }
}

__device__ __forceinline__ void cvt_item(const float* W, int K, int N, bf16_t* WT, int drow0, LAS float* scr, int kb, int nb, int lane, bool blk = false) {
    const int k0 = 64 * kb, n0 = 32 * nb;
#pragma unroll 8
    for (int i = 0; i < 32; ++i) { const int kk = 2 * i + (lane >> 5); scr[kk * 33 + (lane & 31)] = W[(size_t)(k0 + kk) * N + n0 + (lane & 31)]; }
    LDS_WAIT(); asm volatile("" ::: "memory");
    const int c = lane & 7;
#pragma unroll
    for (int j = 0; j < 4; ++j) { const int n = (lane >> 3) + 8 * j; const LAS float* s = scr + (8 * c) * 33 + n;
        u32x4 o; o.x = cvt_pk_bf16(s[0 * 33], s[1 * 33]); o.y = cvt_pk_bf16(s[2 * 33], s[3 * 33]); o.z = cvt_pk_bf16(s[4 * 33], s[5 * 33]); o.w = cvt_pk_bf16(s[6 * 33], s[7 * 33]);
        *(u32x4*)(WT + (blk ? blk_off(inproj_row(drow0 + n), k0 + 8 * c) : (size_t)(drow0 + n) * K + k0 + 8 * c)) = o; }
    LDS_WAIT(); asm volatile("" ::: "memory");
}
__device__ __forceinline__ void cvt_item8(const float* W, int K, int N, unsigned char* WT, int drow0, LAS float* scr, int kb, int nb, int lane) {
    const int k0 = 64 * kb, n0 = 32 * nb;
#pragma unroll 8
    for (int i = 0; i < 32; ++i) { const int kk = 2 * i + (lane >> 5); scr[kk * 33 + (lane & 31)] = W[(size_t)(k0 + kk) * N + n0 + (lane & 31)]; }
    LDS_WAIT(); asm volatile("" ::: "memory");
    const int n = lane >> 1, kh = (lane & 1) * 32; const LAS float* sp = scr + kh * 33 + n; unsigned w[8];
#pragma unroll
    for (int q = 0; q < 8; ++q) w[q] = pack4_fp8(sp[(4 * q) * 33] * W8_SCALE, sp[(4 * q + 1) * 33] * W8_SCALE, sp[(4 * q + 2) * 33] * W8_SCALE, sp[(4 * q + 3) * 33] * W8_SCALE);
    unsigned char* dst = WT + (size_t)(drow0 + n) * K + k0 + kh;
    *(u32x4*)dst = (u32x4){w[0], w[1], w[2], w[3]}; *(u32x4*)(dst + 16) = (u32x4){w[4], w[5], w[6], w[7]};
    LDS_WAIT(); asm volatile("" ::: "memory");
}
__device__ __forceinline__ void cvt_matrix_item(const float* W, int N, bf16_t* WT, int mode, LAS float* scr, int item, int lane, bool f8 = false, bool blk = false) {
    const int nblk = N / 32, kb = item / nblk, nb = item % nblk, n0 = nb * 32;
    const int drow0 = mode == 0 ? n0 : ((n0 >> 7) * 256 + (n0 & 127) + (mode == 2 ? 128 : 0));
    if (f8) cvt_item8(W, 1024, N, (unsigned char*)WT, drow0, scr, kb, nb, lane); else cvt_item(W, 1024, N, WT, drow0, scr, kb, nb, lane, blk);
}
__device__ __forceinline__ void phase_cvt_dense(const PL& P, LAS unsigned char* lds) {
    const int lane = TID & 63, wave = wave_id(), gw = BID * 8 + wave, NGW = GDIM * 8;
    LAS float* scr = (LAS float*)(lds + wave * 16384);
    constexpr int I_IN = 16 * 113, I_SQ = 16 * 32, I_R = 16;
    constexpr int NIT = I_IN + 4 * I_SQ + 2 * I_R;
    unsigned char* ws = P.ws(); const float* w_in = P.in(IHYIN); const float* w_out = P.in(IHYOUT); const float* w_s5 = P.in(IS5IN); const float* w_ga = P.in(IGLUA); const float* w_gb = P.in(IGLUB); const float* w_r = P.in(IRW);
    for (int it = gw; it < NIT; it += NGW) { int r = it;
        if (r < I_IN) { cvt_matrix_item(w_in, INW, (bf16_t*)(ws + WS_WIN), 0, scr, r, lane, false, true); continue; } r -= I_IN;
        if (r < I_SQ) { cvt_matrix_item(w_out, 1024, (bf16_t*)(ws + WS_WOUT), 0, scr, r, lane, true); continue; } r -= I_SQ;
        if (r < I_SQ) { cvt_matrix_item(w_s5, 1024, (bf16_t*)(ws + WS_WS5IN), 0, scr, r, lane, true); continue; } r -= I_SQ;
        if (r < I_SQ) { cvt_matrix_item(w_ga, 1024, (bf16_t*)(ws + WS_WGLU), 1, scr, r, lane, true); continue; } r -= I_SQ;
        if (r < I_SQ) { cvt_matrix_item(w_gb, 1024, (bf16_t*)(ws + WS_WGLU), 2, scr, r, lane, true); continue; } r -= I_SQ;
        const int l = r / I_R; r -= l * I_R;
        cvt_matrix_item(w_r + (size_t)l * 1024 * 32, 32, (bf16_t*)(ws + WS_RB) + (size_t)l * 256 * 1024, 0, scr, r, lane);
    }
    const int gt = BID * 512 + TID, NT = GDIM * 512; const u32x4 z = (u32x4){0u, 0u, 0u, 0u};
    for (int i = gt; i < (INWP - INW) * 128; i += NT) *(u32x4*)((bf16_t*)(ws + WS_WIN) + blk_off(inproj_row(INW + (i >> 7)), (i & 127) * 8)) = z;
    for (int i = gt; i < 2 * 224 * 128; i += NT) { const int l = i / (224 * 128), j = i % (224 * 128); *((u32x4*)((bf16_t*)(ws + WS_RB) + ((size_t)l * 256 + 32) * 1024) + j) = z; }
}
struct CvtJob { const float* W; unsigned char* WT; int drow0, k0, n0; };
__device__ __forceinline__ void cvt_load128(const CvtJob& j, float (&v)[32], int tid) {
#pragma unroll
    for (int u = 0; u < 8; ++u) { const int idx = tid + 512 * u, n = idx & 127, kq = idx >> 7; const float* src = j.W + (size_t)(j.k0 + 4 * kq) * 1024 + j.n0 + n;
#pragma unroll
        for (int r = 0; r < 4; ++r) v[4 * u + r] = src[(size_t)r * 1024]; }
}
__device__ __forceinline__ void cvt_store128(const CvtJob& j, const float (&v)[32], LAS unsigned* T32, int tid) {
#pragma unroll
    for (int u = 0; u < 8; ++u) { const int idx = tid + 512 * u, n = idx & 127, kq = idx >> 7;
        T32[n * 33 + kq] = pack4_fp8(v[4 * u] * W8_SCALE, v[4 * u + 1] * W8_SCALE, v[4 * u + 2] * W8_SCALE, v[4 * u + 3] * W8_SCALE); }
    LDS_BAR();
#pragma unroll
    for (int u = 0; u < 2; ++u) { const int idx = tid + 512 * u, n = idx >> 3, q = (idx & 7) * 4; const LAS unsigned* sp = T32 + n * 33 + q;
        u32x4 w; w.x = sp[0]; w.y = sp[1]; w.z = sp[2]; w.w = sp[3];
        *(u32x4*)(j.WT + blk_off8(j.drow0 + n, j.k0 + 4 * q)) = w; }
    LDS_BAR();
}
__device__ __forceinline__ CvtJob cvt_moe_job(int it, int layer, const float* wg, const float* wu, const float* wd, unsigned char* WGU, unsigned char* WDN) {
    const int mat = it >> 6, r = it & 63, e = mat / 3, w = mat % 3, kb = r >> 3, nb = r & 7; const size_t eo = ((size_t)layer * 32 + e) * 1024 * 1024; CvtJob j;
    j.W = (w == 0 ? wg : (w == 1 ? wu : wd)) + eo; j.WT = w == 2 ? WDN + (size_t)e * 1024 * 1024 : WGU + (size_t)e * 2048 * 1024; j.drow0 = w == 2 ? nb * 128 : nb * 256 + (w == 1 ? 128 : 0); j.k0 = kb * 128; j.n0 = nb * 128; return j;
}
__device__ __forceinline__ void phase_cvt_moe(const PL& P, LAS unsigned char* lds, int layer) {
    const int tid = TID;
    LAS unsigned* T = (LAS unsigned*)lds;
    unsigned char* WGU = P.ws() + WS_WMOE; unsigned char* WDN = WGU + (size_t)32 * 2048 * 1024; const float* wg = P.in(IWG); const float* wu = P.in(IWU); const float* wd = P.in(IWD);
    __syncthreads();
    int it = BID;
    if (it < 96 * 64) {
        float v[32], vn[32]; CvtJob cur = cvt_moe_job(it, layer, wg, wu, wd, WGU, WDN); cvt_load128(cur, v, tid);
        for (;;) { const int nx = it + GDIM; const bool has = nx < 96 * 64; CvtJob nj = cur; if (has) { nj = cvt_moe_job(nx, layer, wg, wu, wd, WGU, WDN); cvt_load128(nj, vn, tid); }
            cvt_store128(cur, v, T, tid);
            if (!has) break;
#pragma unroll
            for (int u = 0; u < 32; ++u) v[u] = vn[u];
            cur = nj; it = nx; }
    }
}

__device__ __forceinline__ void phase_s5_tables(const PL& P, LAS unsigned char* lds) {
    LAS float* ar = (LAS float*)lds; LAS float* ai = ar + 64; LAS float* fre = ai + 64; LAS float* fim = fre + 64;
    LAS float* Bb = fim + 64;
    LAS float* Cc = Bb + 2048;
    LAS float* lj = Cc + 2048;
    const int tid = TID;
    float* LP = (float*)(P.ws() + WS_LP); float* BB = (float*)(P.ws() + WS_BB); float* KT = (float*)(P.ws() + WS_KT);
    const float* i_ls = P.in(IS5LS); const float* i_are = P.in(IS5ARE); const float* i_aim = P.in(IS5AIM); const float* i_bre = P.in(IS5BRE); const float* i_bim = P.in(IS5BIM); const float* i_cre = P.in(IS5CRE); const float* i_cim = P.in(IS5CIM);
    for (int it = BID; it < 128; it += GDIM) { const int d = it >> 6, g = it & 63, dg = d * 64 + g;
        __syncthreads();
        if (tid < 64) { const float step = expf(i_ls[dg]), are = i_are[dg * 64 + tid], aim = i_aim[dg * 64 + tid];
            const float a_r = are * step, a_i = aim * step, mag = expf(a_r); float sn, cs; sincosf(a_i, &sn, &cs); const float lr = mag * cs, li = mag * sn, den = are * are + aim * aim;
            ar[tid] = a_r; ai[tid] = a_i; fre[tid] = ((lr - 1.0f) * are + li * aim) / den; fim[tid] = (li * are - (lr - 1.0f) * aim) / den; }
        __syncthreads();
        for (int i = tid; i < 1024; i += 512) { const int p = i >> 4; const float br = i_bre[(size_t)dg * 1024 + i], bi = i_bim[(size_t)dg * 1024 + i];
            const float re = fre[p] * br - fim[p] * bi, im = fre[p] * bi + fim[p] * br; Bb[2 * i] = re; Bb[2 * i + 1] = im; BB[((size_t)dg * 1024 + i) * 2] = re; BB[((size_t)dg * 1024 + i) * 2 + 1] = im;
            Cc[2 * i] = i_cre[(size_t)dg * 1024 + i]; Cc[2 * i + 1] = i_cim[(size_t)dg * 1024 + i]; }
        __syncthreads();
        if (tid < 64) {
            for (int j = 0; j <= 32; ++j) { const float m = expf(ar[tid] * (float)j); float sn, cs; sincosf(ai[tid] * (float)j, &sn, &cs);
                LP[(((size_t)dg * 33 + j) * 64 + tid) * 2] = m * cs; LP[(((size_t)dg * 33 + j) * 64 + tid) * 2 + 1] = m * sn; }
            { const float m = expf(ar[tid]); float sn, cs; sincosf(ai[tid], &sn, &cs); lj[2 * tid] = m * cs; lj[2 * tid + 1] = m * sn; }
        }
        __syncthreads();
        if (tid < 256) { const int h = tid >> 4, h2 = tid & 15; float acc[32];
#pragma unroll
            for (int j = 0; j < 32; ++j) acc[j] = 0.f;
            for (int p = 0; p < 64; ++p) { const float cr = Cc[2 * (h * 64 + p)], ci = Cc[2 * (h * 64 + p) + 1], br = Bb[2 * (p * 16 + h2)], bi = Bb[2 * (p * 16 + h2) + 1], lr = lj[2 * p], li = lj[2 * p + 1];
                float zr = cr * br - ci * bi, zi = cr * bi + ci * br;
#pragma unroll
                for (int j = 0; j < 32; ++j) { acc[j] += zr; const float nr = zr * lr - zi * li, ni = zr * li + zi * lr; zr = nr; zi = ni; } }
#pragma unroll
            for (int j = 0; j < 32; ++j) KT[(((size_t)g * 2 + d) * 32 + j) * 256 + tid] = acc[j]; }
    }
}
__device__ __forceinline__ void phase_s5_mats(const PL& P) {
    unsigned char* ws = P.ws(); const float* i_d = P.in(IS5D); const float* i_cre = P.in(IS5CRE); const float* i_cim = P.in(IS5CIM);
    const float* LP = (const float*)(ws + WS_LP); const float* BB = (const float*)(ws + WS_BB); const float* KT = (const float*)(ws + WS_KT);
    bf16_t* MPm = (bf16_t*)(ws + WS_MP); bf16_t* Em = (bf16_t*)(ws + WS_E);
    const int gt = BID * 512 + TID, NT = GDIM * 512;
    for (int idx = gt; idx < 64 * 512 * 96; idx += NT) { const int k8 = idx % 96, n = (idx / 96) & 511, g = idx / (96 * 512), t = n >> 4, h = n & 15; float v[8];
        if (k8 < 64) { const int s = k8 >> 1, h0 = (k8 & 1) * 8;
#pragma unroll
            for (int i = 0; i < 8; ++i) v[i] = 0.f;
            if (s <= t) { const float* kp = KT + (((size_t)g * 2 + 0) * 32 + (t - s)) * 256 + h * 16 + h0;
#pragma unroll
                for (int i = 0; i < 8; ++i) v[i] += kp[i]; }
            if (s >= t) { const float* kp = KT + (((size_t)g * 2 + 1) * 32 + (s - t)) * 256 + h * 16 + h0;
#pragma unroll
                for (int i = 0; i < 8; ++i) v[i] += kp[i]; }
            if (s == t && (h >> 3) == (k8 & 1)) v[h & 7] += i_d[g * 16 + h];
        } else { const int q = (k8 - 64) * 8, seg = q >> 6, p0 = q & 63, d = seg >> 1, im = seg & 1, e = d == 0 ? t + 1 : 32 - t, dg = d * 64 + g;
#pragma unroll
            for (int i = 0; i < 8; ++i) { const int p = p0 + i; const float cr = i_cre[(size_t)dg * 1024 + h * 64 + p], ci = i_cim[(size_t)dg * 1024 + h * 64 + p];
                const float lr = LP[(((size_t)dg * 33 + e) * 64 + p) * 2], li = LP[(((size_t)dg * 33 + e) * 64 + p) * 2 + 1];
                v[i] = im ? -(cr * li + ci * lr) : (cr * lr - ci * li); } }
        *(u32x4*)(MPm + ((size_t)g * 512 + n) * S5K + k8 * 8) = pack8(v); }
    for (int idx = gt; idx < 64 * 256 * 64; idx += NT) { const int k8 = idx & 63, n = (idx >> 6) & 255, g = idx >> 14, seg = n >> 6, p = n & 63, d = seg >> 1, im = seg & 1, s = k8 >> 1, h0 = (k8 & 1) * 8, e = d == 0 ? 31 - s : s, dg = d * 64 + g;
        const float lr = LP[(((size_t)dg * 33 + e) * 64 + p) * 2], li = LP[(((size_t)dg * 33 + e) * 64 + p) * 2 + 1]; float v[8];
#pragma unroll
        for (int i = 0; i < 8; ++i) { const float br = BB[((size_t)dg * 1024 + p * 16 + h0 + i) * 2], bi = BB[((size_t)dg * 1024 + p * 16 + h0 + i) * 2 + 1]; v[i] = im ? (lr * bi + li * br) : (lr * br - li * bi); }
        *(u32x4*)(Em + ((size_t)g * 256 + n) * 512 + k8 * 8) = pack8(v); }
}

__device__ __forceinline__ void norm_mod_row(const float (&x)[16], const float* w, const float* shift, const float* scale, bf16_t* dst, int lane, unsigned char* dst8 = nullptr) {
    float ss = 0.f;
#pragma unroll
    for (int i = 0; i < 16; ++i) ss += x[i] * x[i];
    const float rs = rsqrtf(wave_sum(ss) * (1.0f / 1024.0f) + RMS_EPS);
    float wv[16], sh[16], sc[16], o[16]; ld_row_f32(w, lane, wv); ld_row_f32(shift, lane, sh); ld_row_f32(scale, lane, sc);
#pragma unroll
    for (int i = 0; i < 16; ++i) o[i] = x[i] * rs * wv[i] * (1.0f + sc[i]) + sh[i];
    if (dst) st_row_bf16(dst, lane, o);
    if (dst8) {
#pragma unroll
        for (int j = 0; j < 2; ++j) { u32x2 q; q.x = pack4_fp8(o[8 * j], o[8 * j + 1], o[8 * j + 2], o[8 * j + 3]); q.y = pack4_fp8(o[8 * j + 4], o[8 * j + 5], o[8 * j + 6], o[8 * j + 7]); *(u32x2*)(dst8 + 8 * lane + 512 * j) = q; } }
}
__device__ __forceinline__ void norm_mod_pre(const float (&x)[16], const float (&wv)[16], const float (&sh)[16], const float (&sc)[16], bf16_t* dst, int lane, unsigned char* dst8) {
    float ss = 0.f;
#pragma unroll
    for (int i = 0; i < 16; ++i) ss += x[i] * x[i];
    const float rs = rsqrtf(wave_sum(ss) * (1.0f / 1024.0f) + RMS_EPS); float o[16];
#pragma unroll
    for (int i = 0; i < 16; ++i) o[i] = x[i] * rs * wv[i] * (1.0f + sc[i]) + sh[i];
    if (dst) st_row_bf16(dst, lane, o);
    if (dst8) {
#pragma unroll
        for (int j = 0; j < 2; ++j) { u32x2 q; q.x = pack4_fp8(o[8 * j], o[8 * j + 1], o[8 * j + 2], o[8 * j + 3]); q.y = pack4_fp8(o[8 * j + 4], o[8 * j + 5], o[8 * j + 6], o[8 * j + 7]); *(u32x2*)(dst8 + 8 * lane + 512 * j) = q; } }
}
__device__ __forceinline__ void norm_mod_blk(const float (&x)[16], const float (&wv)[16], const float (&sh)[16], const float (&sc)[16], bf16_t* base, int r, int lane) {
    float ss = 0.f;
#pragma unroll
    for (int i = 0; i < 16; ++i) ss += x[i] * x[i];
    const float rs = rsqrtf(wave_sum(ss) * (1.0f / 1024.0f) + RMS_EPS); float o[16];
#pragma unroll
    for (int i = 0; i < 16; ++i) o[i] = x[i] * rs * wv[i] * (1.0f + sc[i]) + sh[i];
#pragma unroll
    for (int j = 0; j < 2; ++j) *(u32x4*)(base + blk_off(r, 8 * lane + 512 * j)) = pack8(&o[8 * j]);
}
__device__ __forceinline__ void phase_pre0(const PL& P) {
    const int lane = TID & 63, gw = BID * 8 + wave_id(), NGW = GDIM * 8;
    unsigned char* ws = P.ws(); const float* xin = P.in(IX); const float* cin = P.in(ICTX); const float* nw = P.in(IMNPRE);
    bf16_t* A0 = (bf16_t*)(ws + WS_R2);
    float wv[16]; ld_row_f32(nw, lane, wv);
    for (int r = gw; r < TT; r += 2 * NGW) { const int r2 = r + NGW; const bool has2 = r2 < TT;
        float xa[16], sha[16], sca[16], xb[16], shb[16], scb[16];
        ld_row_f32(xrow(xin, cin, r), lane, xa); ld_row_f32(modp(ws, 0, r, 0), lane, sha); ld_row_f32(modp(ws, 0, r, 1), lane, sca);
        if (has2) { ld_row_f32(xrow(xin, cin, r2), lane, xb); ld_row_f32(modp(ws, 0, r2, 0), lane, shb); ld_row_f32(modp(ws, 0, r2, 1), lane, scb); }
        norm_mod_blk(xa, wv, sha, sca, A0, r, lane);
        if (has2) norm_mod_blk(xb, wv, shb, scb, A0, r2, lane); }
}

template <int I0, int NI>
__device__ __forceinline__ void conv_finish(float (&acc)[NI][8], int r, int lane, const LAS float* cbias, float gc0, float gc1, unsigned char* ws) {
    static_assert(NI == 1, "one chunk per pass");
#pragma unroll
    for (int j = 0; j < 8; ++j) { float a = acc[0][j]; if (I0 >= 3) a += cbias[8 * (lane + 64 * (I0 - 3)) + j]; acc[0][j] = siluf(a); }
    if (I0 < 2) { float ss = 0.f;
#pragma unroll
        for (int j = 0; j < 8; ++j) ss += acc[0][j] * acc[0][j];
        ss += __shfl_xor(ss, 1); ss += __shfl_xor(ss, 2); ss += __shfl_xor(ss, 4); ss += __shfl_xor(ss, 8);
        const float sc = rsqrtf(ss + RMS_EPS);
#pragma unroll
        for (int j = 0; j < 8; ++j) acc[0][j] *= sc; }
    if (I0 < 4) { bf16_t* dst = (bf16_t*)(ws + (I0 == 0 ? WS_Q : (I0 == 1 ? WS_K : (I0 == 2 ? WS_V : WS_XS)))); __builtin_nontemporal_store(pack8(acc[0]), (u32x4*)(dst + (size_t)r * 512 + 8 * lane)); }
    else {
        bf16_t* BMm = (bf16_t*)(ws + WS_BM); bf16_t* CMm = (bf16_t*)(ws + WS_CM);
        const float* GATE = (const float*)(ws + WS_GATE); float* G = (float*)(ws + WS_GPOST); float* BETA = G + (size_t)TT * 8; float* DT = BETA + (size_t)TT * 8; float* DA = DT + (size_t)TT * 16;
        if (lane < 32) __builtin_nontemporal_store(pack8(acc[0]), (u32x4*)(BMm + (size_t)r * 256 + 8 * lane)); else __builtin_nontemporal_store(pack8(acc[0]), (u32x4*)(CMm + (size_t)r * 256 + 8 * (lane - 32)));
        if (lane < 32) { const float raw = GATE[(size_t)r * 32 + lane];
            if (lane < 8) { G[(size_t)r * 8 + lane] = gc0 * softplusf_(raw + gc1); }
            else if (lane < 16) { BETA[(size_t)r * 8 + lane - 8] = 1.0f / (1.0f + expf(-raw)); }
            else { const int j = lane - 16; const float dt = softplusf_(raw + gc1); DT[(size_t)r * 16 + j] = dt; DA[(size_t)r * 16 + j] = gc0 * dt; } }
    }
}
template <int I>
__device__ __forceinline__ void conv_step1(float (&Am)[1][8], float (&Az)[1][8], float (&Ap)[1][8], const u32x4 (&x)[3], const float (&wr)[9][8], int cn, int c0, int rowbase, int lane,
                                           const LAS float* cbias, float gc0, float gc1, unsigned char* ws) {
#pragma unroll
    for (int d = 0; d < 3; ++d) { float xv[8]; unpack8(x[d], xv);
#pragma unroll
        for (int j = 0; j < 8; ++j) { Am[0][j] += xv[j] * wr[d * 3 + 2][j]; Az[0][j] += xv[j] * wr[d * 3 + 1][j]; Ap[0][j] += xv[j] * wr[d * 3 + 0][j]; } }
    const int co = cn - 1;
    if (co >= c0 && co < c0 + 32) conv_finish<I, 1>(Am, rowbase + co, lane, cbias, gc0, gc1, ws);
#pragma unroll
    for (int j = 0; j < 8; ++j) Am[0][j] = 0.f;
}
template <int I>
__device__ __forceinline__ void conv_walk1(int c0, int rr, int nrows, int ncols, int rowbase, int lane, const bf16_t* CA, const bf16_t* CB, const LAS float* cw, const LAS float* cbias, float gc0, float gc1, unsigned char* ws) {
    const int ch = 8 * (lane + 64 * I), pitch = I < 3 ? 1536 : 1024; const bf16_t* src = I < 3 ? CA + ch : CB + ch - 1536;
    float wr[9][8];
#pragma unroll
    for (int tap = 0; tap < 9; ++tap) { const f32x4 w0 = *(const LAS f32x4*)(cw + tap * 2560 + ch), w1 = *(const LAS f32x4*)(cw + tap * 2560 + ch + 4); wr[tap][0] = w0.x; wr[tap][1] = w0.y; wr[tap][2] = w0.z; wr[tap][3] = w0.w; wr[tap][4] = w1.x; wr[tap][5] = w1.y; wr[tap][6] = w1.z; wr[tap][7] = w1.w; }
    const bool rup = rr - 1 >= 0, rdn = rr + 1 < nrows;
#define CONV_LDCOL(cn_, x_) do { const int cq_ = (cn_) < 0 ? 0 : ((cn_) >= ncols ? ncols - 1 : (cn_)); const bool cok_ = (cn_) >= 0 && (cn_) < ncols; \
        const u32x4 z_ = (u32x4){0u, 0u, 0u, 0u}; \
        const u32x4 a_ = *(const u32x4*)(src + (size_t)(rowbase + (rup ? -ncols : 0) + cq_) * pitch), b_ = *(const u32x4*)(src + (size_t)(rowbase + cq_) * pitch), c_ = *(const u32x4*)(src + (size_t)(rowbase + (rdn ? ncols : 0) + cq_) * pitch); \
        x_[0] = (cok_ && rup) ? a_ : z_; x_[1] = cok_ ? b_ : z_; x_[2] = (cok_ && rdn) ? c_ : z_; } while (0)
    float A0[1][8], A1[1][8], A2[1][8];
#pragma unroll
    for (int j = 0; j < 8; ++j) { A0[0][j] = 0.f; A1[0][j] = 0.f; A2[0][j] = 0.f; }
    u32x4 X0[3], X1[3], X2[3], X3[3];
    CONV_LDCOL(c0 - 1, X0); CONV_LDCOL(c0, X1); CONV_LDCOL(c0 + 1, X2); CONV_LDCOL(c0 + 2, X3);
#define CONV_ST(k_, Am_, Az_, Ap_, X_) do { conv_step1<I>(Am_, Az_, Ap_, X_, wr, cn + (k_), c0, rowbase, lane, cbias, gc0, gc1, ws); CONV_LDCOL(cn + (k_) + 4, X_); } while (0)
#pragma unroll 1
    for (int st = 0; st < 36; st += 12) { const int cn = c0 - 1 + st;
        CONV_ST(0, A0, A1, A2, X0); CONV_ST(1, A1, A2, A0, X1); CONV_ST(2, A2, A0, A1, X2); CONV_ST(3, A0, A1, A2, X3);
        CONV_ST(4, A1, A2, A0, X0); CONV_ST(5, A2, A0, A1, X1); CONV_ST(6, A0, A1, A2, X2); CONV_ST(7, A1, A2, A0, X3);
        CONV_ST(8, A2, A0, A1, X0); CONV_ST(9, A0, A1, A2, X1); CONV_ST(10, A1, A2, A0, X2); CONV_ST(11, A2, A0, A1, X3); }
#undef CONV_ST
#undef CONV_LDCOL
}
__device__ __forceinline__ void phase_conv2(const PL& P, LAS unsigned char* lds) {
    LAS float* cw = (LAS float*)lds;
    LAS float* cbias = cw + 9 * 2560;
    const int tid = TID, lane = tid & 63, gw = BID * 8 + wave_id(), NGW = GDIM * 8;
    unsigned char* ws = P.ws();
    { const float* gcw = P.in(IGCW); const float* scw = P.in(ISCW); const float* scb = P.in(ISCB);
    for (int i = tid; i < 9 * 2560; i += 512) { const int tap = i / 2560, c = i % 2560; cw[i] = c < 1536 ? gcw[tap * 1536 + c] : scw[tap * 1024 + c - 1536]; }
    for (int i = tid; i < 1024; i += 512) cbias[i] = scb[i]; }
    float gc0 = 0.f, gc1 = 0.f;
    if (lane < 8) { gc0 = -expf(P.in(IGALOG)[lane]); gc1 = P.in(IGDTB)[lane]; } else if (lane >= 16 && lane < 32) { gc0 = -expf(P.in(ISALOG)[lane - 16]); gc1 = P.in(ISDTB)[lane - 16]; }
    __syncthreads();
    const bf16_t* CA = (const bf16_t*)(ws + WS_CONVA); const bf16_t* CB = (const bf16_t*)(ws + WS_CONVB);
    for (int it2 = gw; it2 < 5 * 2304; it2 += NGW) { const int pass = it2 / 2304, item = it2 - pass * 2304;
        int rr, nrows, ncols, rowbase, c0;
        if (item < 2048) { const int b = item >> 6; rr = (item >> 1) & 31; c0 = (item & 1) * 32; nrows = 32; ncols = 64; rowbase = b * 2048 + rr * 64; }
        else { const int j = item - 2048, b = j >> 3; rr = 0; c0 = (j & 7) * 32; nrows = 1; ncols = 256; rowbase = TL + b * 256; }
        if (pass == 0) conv_walk1<0>(c0, rr, nrows, ncols, rowbase, lane, CA, CB, cw, cbias, gc0, gc1, ws);
        else if (pass == 1) conv_walk1<1>(c0, rr, nrows, ncols, rowbase, lane, CA, CB, cw, cbias, gc0, gc1, ws);
        else if (pass == 2) conv_walk1<2>(c0, rr, nrows, ncols, rowbase, lane, CA, CB, cw, cbias, gc0, gc1, ws);
        else if (pass == 3) conv_walk1<3>(c0, rr, nrows, ncols, rowbase, lane, CA, CB, cw, cbias, gc0, gc1, ws);
        else conv_walk1<4>(c0, rr, nrows, ncols, rowbase, lane, CA, CB, cw, cbias, gc0, gc1, ws);
    }
}

__device__ __forceinline__ int seq_row(int b, int d, int s) { if (s < 256) { const int l = d ? 255 - s : s; return TL + b * 256 + l; } const int l0 = s - 256, l = d ? 2047 - l0 : l0; return b * 2048 + l; }

#define NFMA(r, a, b) asm("v_fma_f32 %0, -%1, %2, %0" : "+v"(r) : "v"(a), "v"(b))
#define MFMA16(a, b, c) __builtin_amdgcn_mfma_f32_16x16x32_bf16((a), (b), (c), 0, 0, 0)
__device__ __forceinline__ bf16x8 fragl(const LAS bf16_t* M, int pitch, int row0, int k0, int lane) { return *(const LAS bf16x8*)(M + (row0 + (lane & 15)) * pitch + k0 + 8 * (lane >> 4)); }
typedef short s16x4 __attribute__((ext_vector_type(4)));
__device__ __forceinline__ bf16x8 fragt(const LAS bf16_t* M, int pitch, int r0, int c0, int lane) {
    const LAS bf16_t* p = M + (r0 + 8 * (lane >> 4) + ((lane & 15) >> 2)) * pitch + c0 + 4 * (lane & 3);
    const s16x4 lo = __builtin_amdgcn_ds_read_tr16_b64_v4i16((LAS s16x4*)p), hi = __builtin_amdgcn_ds_read_tr16_b64_v4i16((LAS s16x4*)(p + 4 * pitch));
    return (bf16x8){lo[0], lo[1], lo[2], lo[3], hi[0], hi[1], hi[2], hi[3]};
}
constexpr int GDN_NCHUNK = 36, GDN_NINST = 256 * GDN_NCHUNK;
constexpr size_t WS_GUT = WS_OGDN, WS_GWT = WS_R2, WS_GQK = 672 * MiB, WS_GEG = WS_GATE;

__device__ __forceinline__ void phase_gdn1m(const PL& P, LAS unsigned char* lds, size_t ut_off) {
    unsigned char* ws = P.ws();
    const bf16_t* Q = (const bf16_t*)(ws + WS_Q); const bf16_t* Kk = (const bf16_t*)(ws + WS_K); const bf16_t* V = (const bf16_t*)(ws + WS_V);
    const float* G = (const float*)(ws + WS_GPOST); const float* BETA = G + (size_t)TT * 8;
    bf16_t* UT = (bf16_t*)(ws + ut_off); bf16_t* WT = (bf16_t*)(ws + WS_GWT); bf16_t* QKo = (bf16_t*)(ws + WS_GQK);
    float* EG = (float*)(ws + WS_GEG); float* EGL = EG + (size_t)GDN_NINST * 64; float* GL = EGL + (size_t)GDN_NINST * 64;
    LAS bf16_t* Kl = (LAS bf16_t*)lds; LAS bf16_t* Ql = Kl + 64 * 136; LAS bf16_t* Vl = Ql + 64 * 136;
    LAS bf16_t* Mb = Vl + 64 * 136;
    LAS float* Md = (LAS float*)(Mb + 64 * 72);
    LAS bf16_t* Tb = (LAS bf16_t*)(Md + 4 * 16 * 20);
    LAS bf16_t* XT = Tb + 4 * 16 * 40;
    LAS bf16_t* YT = XT + 256 * 72;
    LAS float* gcs = (LAS float*)(YT + 256 * 40); LAS float* bet = gcs + 64; LAS float* betw = bet + 64;
    { const int t0 = TID; __syncthreads();
      for (int i = t0; i < (64 * 72 + 4 * 16 * 20 * 2 + 4 * 16 * 40 + 256 * 72 + 256 * 40) / 8; i += 512) *(LAS u32x4*)((LAS unsigned char*)Mb + i * 16) = (u32x4){0u, 0u, 0u, 0u};
      __syncthreads(); }
    u32x4 pf[6]; float pg = 0.f, pbeta = 0.f;
#define GDN1M_PREFETCH(id_) do { const int tid_ = TID + opaque0(), chain_ = (id_) / GDN_NCHUNK, c_ = (id_) % GDN_NCHUNK, d_ = chain_ & 1, h_ = (chain_ >> 1) & 3, b_ = chain_ >> 3; \
        _Pragma("unroll") for (int u_ = 0; u_ < 6; ++u_) { const int idx = tid_ + 512 * u_, wh = idx >> 10, rem = idx & 1023, i = rem >> 4, off = (rem & 15) * 8; const int row = seq_row(b_, d_, c_ * 64 + i); \
            const bf16_t* src = wh == 0 ? Kk : (wh == 1 ? Q : V); pf[u_] = *(const u32x4*)(src + (size_t)row * 512 + h_ * 128 + off); } \
        if (tid_ < 64) { const int row = seq_row(b_, d_, c_ * 64 + tid_); pg = G[(size_t)row * 8 + d_ * 4 + h_]; pbeta = BETA[(size_t)row * 8 + d_ * 4 + h_]; } } while (0)
    if (BID < GDN_NINST) GDN1M_PREFETCH(BID);
    for (int id = BID; id < GDN_NINST; id += GDIM) {
        const int tid = TID + opaque0(), lane = tid & 63, wave = __builtin_amdgcn_readfirstlane(tid >> 6), q4 = lane >> 4, l15 = lane & 15;
        LDS_BAR();
#pragma unroll
        for (int u_ = 0; u_ < 6; ++u_) { const int idx = tid + 512 * u_, wh = idx >> 10, rem = idx & 1023, i = rem >> 4, off = (rem & 15) * 8;
            LAS bf16_t* dst = wh == 0 ? Kl : (wh == 1 ? Ql : Vl); *(LAS u32x4*)(dst + i * 136 + off) = pf[u_]; }
        if (wave == 0) { float gc = pg; const float be = pbeta;
#pragma unroll
            for (int o = 1; o < 64; o <<= 1) { const float t = __shfl_up(gc, o); if (lane >= o) gc += t; }
            const float gl = __shfl(gc, 63);
            gcs[lane] = gc; bet[lane] = be; betw[lane] = be * expf(gc); EG[(size_t)id * 64 + lane] = expf(gc); EGL[(size_t)id * 64 + lane] = expf(gl - gc); if (lane == 0) GL[id] = expf(gl); }
        LDS_BAR();
        if (id + GDIM < GDN_NINST) GDN1M_PREFETCH(id + GDIM);
#pragma unroll 1
        for (int tl = wave; tl < 10; tl += 8) { const int it = tl < 1 ? 0 : (tl < 3 ? 1 : (tl < 6 ? 2 : 3)), jt = tl - (it * (it + 1)) / 2;
            const int i0 = it * 16, i = i0 + l15, j0 = jt * 16 + 4 * q4; const float gci = gcs[i], bi = bet[i]; f32x4 a = (f32x4){0.f, 0.f, 0.f, 0.f}, a2 = a;
#pragma unroll
            for (int k0 = 0; k0 < 128; k0 += 32) { const bf16x8 fj = fragl(Kl, 136, jt * 16, k0, lane); a = MFMA16(fj, fragl(Kl, 136, i0, k0, lane), a); a2 = MFMA16(fj, fragl(Ql, 136, i0, k0, lane), a2); }
            float mv[4], qv[4];
#pragma unroll
            for (int jj = 0; jj < 4; ++jj) { const int j = j0 + jj; const float ex = __expf(fminf(gci - gcs[j], 0.f)); const float dec = (j <= i) ? ex : 0.f; mv[jj] = (j < i) ? bi * a[jj] * dec : 0.f; qv[jj] = a2[jj] * 0.08838834764831845f * dec; }
            if (it == jt) *(LAS f32x4*)(Md + (it * 16 + l15) * 20 + 4 * q4) = (f32x4){mv[0], mv[1], mv[2], mv[3]};
            else { u32x2 w; w.x = cvt_pk_bf16(-mv[0], -mv[1]); w.y = cvt_pk_bf16(-mv[2], -mv[3]); *(LAS u32x2*)(Mb + i * 72 + j0) = w; }
            u32x2 w; w.x = cvt_pk_bf16(qv[0], qv[1]); w.y = cvt_pk_bf16(qv[2], qv[3]); *(u32x2*)(QKo + ((size_t)id * 64 + i) * 64 + j0) = w; }
        if (wave >= 2) { const int tz = wave - 2;
            const int it = tz < 3 ? 0 : (tz < 5 ? 1 : 2), jt = tz < 3 ? tz + 1 : (tz < 5 ? tz - 1 : 3);
            *(u32x2*)(QKo + ((size_t)id * 64 + it * 16 + l15) * 64 + jt * 16 + 4 * q4) = (u32x2){0u, 0u}; }
        LDS_BAR();
        if (tid < 64) { const int I = tid >> 4, c = tid & 15; const LAS float* md = Md + I * 16 * 20; float t[16];
#pragma unroll
            for (int i = 0; i < 16; ++i) { float r = (i == c) ? 1.0f : 0.0f;
#pragma unroll
                for (int j4 = 0; j4 < (i + 3) / 4; ++j4) { const f32x4 m = *(const LAS f32x4*)(md + i * 20 + 4 * j4);
                    NFMA(r, m.x, t[4 * j4]); if (4 * j4 + 1 < i) NFMA(r, m.y, t[4 * j4 + 1]); if (4 * j4 + 2 < i) NFMA(r, m.z, t[4 * j4 + 2]); if (4 * j4 + 3 < i) NFMA(r, m.w, t[4 * j4 + 3]); }
                t[i] = r; Tb[(I * 16 + i) * 40 + c] = f2bf(r); } }
        LDS_BAR();
#pragma unroll
        for (int I = 0; I < 4; ++I) {
            f32x4 acc[2];
#pragma unroll
            for (int tt = 0; tt < 2; ++tt) { const int ct = 2 * wave + tt, c0 = ct * 16, col = (c0 & 127) + l15; const LAS bf16_t* src = ct < 8 ? Vl : Kl; const LAS float* rsc = ct < 8 ? bet : betw;
#pragma unroll
                for (int jj = 0; jj < 4; ++jj) { const int i = 16 * I + 4 * q4 + jj; acc[tt][jj] = rsc[i] * bf1(src[i * 136 + col]); }
                if (I >= 1) { acc[tt] = MFMA16(fragl(Mb, 72, 16 * I, 0, lane), fragl(XT, 72, c0, 0, lane), acc[tt]); if (I == 3) acc[tt] = MFMA16(fragl(Mb, 72, 48, 32, lane), fragl(XT, 72, c0, 32, lane), acc[tt]); }
                u32x2 w; w.x = cvt_pk_bf16(acc[tt][0], acc[tt][1]); w.y = cvt_pk_bf16(acc[tt][2], acc[tt][3]); *(LAS u32x2*)(YT + (c0 + l15) * 40 + 4 * q4) = w; }
#pragma unroll
            for (int tt = 0; tt < 2; ++tt) { const int ct = 2 * wave + tt, c0 = ct * 16, col = (c0 & 127) + l15;
                const f32x4 zero4 = {0.f, 0.f, 0.f, 0.f}; const f32x4 x = MFMA16(fragl(Tb + I * 16 * 40, 40, 0, 0, lane), fragl(YT, 40, c0, 0, lane), zero4);
                u32x2 w; w.x = cvt_pk_bf16(x[0], x[1]); w.y = cvt_pk_bf16(x[2], x[3]);
                *(LAS u32x2*)(XT + (c0 + l15) * 72 + 16 * I + 4 * q4) = w;
                *(u32x2*)((ct < 8 ? UT : WT) + ((size_t)id * 128 + col) * 64 + 16 * I + 4 * q4) = w; }
        }
    }
#undef GDN1M_PREFETCH
}

__device__ __forceinline__ void phase_gdn2(const PL& P, LAS unsigned char* lds, size_t ut_off) {
    const int tid = TID + opaque0(), lane = tid & 63, wave = __builtin_amdgcn_readfirstlane(tid >> 6), q4 = lane >> 4, l15 = lane & 15;
    LAS bf16_t* WTl = (LAS bf16_t*)lds;
    LAS bf16_t* Ql = WTl + 128 * 72;
    LAS bf16_t* Kdl = Ql + 64 * 136;
    LAS bf16_t* QKl = Kdl + 64 * 136;
    LAS bf16_t* VnT = QKl + 64 * 72;
    LAS bf16_t* St = VnT + 128 * 72;
    unsigned char* ws = P.ws();
    const bf16_t* Q = (const bf16_t*)(ws + WS_Q); const bf16_t* Kk = (const bf16_t*)(ws + WS_K);
    bf16_t* UT = (bf16_t*)(ws + ut_off); const bf16_t* WT = (const bf16_t*)(ws + WS_GWT); const bf16_t* QKo = (const bf16_t*)(ws + WS_GQK);
    const float* EG = (const float*)(ws + WS_GEG); const float* EGL = EG + (size_t)GDN_NINST * 64; const float* GL = EGL + (size_t)GDN_NINST * 64;
    const int dv0 = wave * 16;
    for (int chain = BID; chain < 256; chain += GDIM) { const int d = chain & 1, h = (chain >> 1) & 3, b = chain >> 3;
        f32x4 S[8];
#pragma unroll
        for (int t = 0; t < 8; ++t) S[t] = (f32x4){0.f, 0.f, 0.f, 0.f};
        for (int i = lane; i < 16 * 136 / 8; i += 64) *(LAS u32x4*)(St + dv0 * 136 + i * 8) = (u32x4){0u, 0u, 0u, 0u};
        u32x4 pw[2], pq[2], pk[2], pqk; float peg[2], pegl[2]; u32x2 uu[4]; float pgl;
#define GDN2_PREFETCH(c_) do { const size_t id_ = (size_t)chain * GDN_NCHUNK + (c_); _Pragma("unroll") for (int u_ = 0; u_ < 2; ++u_) { const int idx = tid + 512 * u_; \
            { const int dk_ = idx >> 3, i8_ = (idx & 7) * 8; pw[u_] = *(const u32x4*)(WT + (id_ * 128 + dk_) * 64 + i8_); } \
            { const int i_ = idx >> 4, off_ = (idx & 15) * 8; const int row_ = seq_row(b, d, (c_) * 64 + i_); pq[u_] = *(const u32x4*)(Q + (size_t)row_ * 512 + h * 128 + off_); pk[u_] = *(const u32x4*)(Kk + (size_t)row_ * 512 + h * 128 + off_); \
              peg[u_] = EG[id_ * 64 + i_]; pegl[u_] = EGL[id_ * 64 + i_]; } } \
            pqk = *(const u32x4*)(QKo + id_ * 4096 + tid * 8); pgl = GL[id_]; \
            _Pragma("unroll") for (int it_ = 0; it_ < 4; ++it_) uu[it_] = *(const u32x2*)(UT + (id_ * 128 + dv0 + l15) * 64 + it_ * 16 + 4 * q4); } while (0)
        GDN2_PREFETCH(0);
        for (int c = 0; c < GDN_NCHUNK; ++c) { const size_t id = (size_t)chain * GDN_NCHUNK + c;
            __syncthreads();
#pragma unroll
            for (int u_ = 0; u_ < 2; ++u_) { const int idx = tid + 512 * u_;
                { const int dk_ = idx >> 3, i8_ = (idx & 7) * 8; *(LAS u32x4*)(WTl + dk_ * 72 + i8_) = (u32x4){pw[u_].x ^ 0x80008000u, pw[u_].y ^ 0x80008000u, pw[u_].z ^ 0x80008000u, pw[u_].w ^ 0x80008000u}; }
                { const int i_ = idx >> 4, off_ = (idx & 15) * 8; float qv[8], kv[8]; unpack8(pq[u_], qv); unpack8(pk[u_], kv); const float sq = peg[u_] * 0.08838834764831845f, sk = pegl[u_];
#pragma unroll
                  for (int e = 0; e < 8; ++e) { qv[e] *= sq; kv[e] *= sk; }
                  *(LAS u32x4*)(Ql + i_ * 136 + off_) = pack8(qv); *(LAS u32x4*)(Kdl + i_ * 136 + off_) = pack8(kv); } }
            { const int i_ = tid >> 3, j8_ = (tid & 7) * 8; *(LAS u32x4*)(QKl + i_ * 72 + j8_) = pqk; }
            const float glast = pgl;
            f32x4 vn[4], o[4];
#pragma unroll
            for (int it = 0; it < 4; ++it) { vn[it] = (f32x4){bflo(uu[it].x), bfhi(uu[it].x), bflo(uu[it].y), bfhi(uu[it].y)}; o[it] = (f32x4){0.f, 0.f, 0.f, 0.f}; }
            LDS_BAR();
            if (c + 1 < GDN_NCHUNK) GDN2_PREFETCH(c + 1);
#pragma unroll
            for (int k0 = 0; k0 < 128; k0 += 32) { const bf16x8 fs = fragl(St, 136, dv0, k0, lane);
#pragma unroll
                for (int it = 0; it < 4; ++it) { vn[it] = MFMA16(fragt(WTl, 72, k0, it * 16, lane), fs, vn[it]); o[it] = MFMA16(fs, fragl(Ql, 136, it * 16, k0, lane), o[it]); } }
#pragma unroll
            for (int it = 0; it < 4; ++it) { u32x2 w; w.x = cvt_pk_bf16(vn[it][0], vn[it][1]); w.y = cvt_pk_bf16(vn[it][2], vn[it][3]); *(LAS u32x2*)(VnT + (dv0 + l15) * 72 + it * 16 + 4 * q4) = w; }
#pragma unroll
            for (int t = 0; t < 8; ++t) S[t] = S[t] * glast;
#pragma unroll
            for (int j0 = 0; j0 < 64; j0 += 32) { const bf16x8 fv = fragl(VnT, 72, dv0, j0, lane);
#pragma unroll
                for (int it = 0; it < 4; ++it) o[it] = MFMA16(fv, fragl(QKl, 72, it * 16, j0, lane), o[it]);
#pragma unroll
                for (int t = 0; t < 8; ++t) S[t] = MFMA16(fragt(Kdl, 136, j0, t * 16, lane), fv, S[t]); }
#pragma unroll
            for (int it = 0; it < 4; ++it) { u32x2 w; w.x = cvt_pk_bf16(o[it][0], o[it][1]); w.y = cvt_pk_bf16(o[it][2], o[it][3]); *(u32x2*)(UT + (id * 64 + it * 16 + l15) * 128 + dv0 + 4 * q4) = w; }
#pragma unroll
            for (int t = 0; t < 8; ++t) { u32x2 w; w.x = cvt_pk_bf16(S[t][0], S[t][1]); w.y = cvt_pk_bf16(S[t][2], S[t][3]); *(LAS u32x2*)(St + (dv0 + l15) * 136 + t * 16 + 4 * q4) = w; }
        }
#undef GDN2_PREFETCH
        __syncthreads();
    }
}

__device__ __forceinline__ void phase_ssd_chunked(const PL& P, LAS unsigned char* lds, size_t out_off) {
    const int tid = TID + opaque0(), lane = tid & 63, wave = __builtin_amdgcn_readfirstlane(tid >> 6), q4 = lane >> 4, l15 = lane & 15, hl = wave >> 2, pt = wave & 3;
    LAS bf16_t* Cl = (LAS bf16_t*)lds;
    LAS bf16_t* Bl = Cl + 64 * 136;
    LAS bf16_t* HD = Bl + 64 * 136;
    constexpr int HDSZ = 3 * 64 * 72 + 64 * 136;
    LAS float* scal = (LAS float*)(HD + 2 * HDSZ);
    LAS bf16_t* XT1 = HD + hl * HDSZ; LAS bf16_t* XT2 = XT1 + 64 * 72; LAS bf16_t* Sc = XT2 + 64 * 72; LAS bf16_t* Hb = Sc + 64 * 72;
    unsigned char* ws = P.ws();
    const bf16_t* XS = (const bf16_t*)(ws + WS_XS); const bf16_t* BMm = (const bf16_t*)(ws + WS_BM); const bf16_t* CMm = (const bf16_t*)(ws + WS_CM);
    const float* DT = (const float*)(ws + WS_GPOST) + (size_t)TT * 16; const float* DA = DT + (size_t)TT * 16;
    bf16_t* OUT = (bf16_t*)(ws + out_off);
    const int p0 = pt * 16;
    for (int unit = BID; unit < 256; unit += GDIM) { const int hp = unit & 1, d = (unit >> 1) & 1, grp = (unit >> 2) & 1, b = unit >> 3, head = grp * 4 + hp * 2 + hl;
        f32x4 H[8];
#pragma unroll
        for (int t = 0; t < 8; ++t) H[t] = (f32x4){0.f, 0.f, 0.f, 0.f};
        for (int i = lane; i < 16 * 136 / 8; i += 64) *(LAS u32x4*)(Hb + p0 * 136 + i * 8) = (u32x4){0u, 0u, 0u, 0u};
        u32x4 pc[2], pb[2], px[2]; float pdt = 0.f, pda = 0.f;
#define SSD_PREFETCH(c_) do { _Pragma("unroll") for (int u_ = 0; u_ < 2; ++u_) { const int idx = tid + 512 * u_; \
            { const int j_ = idx >> 4, off_ = (idx & 15) * 8; const size_t row_ = (size_t)seq_row(b, d, (c_) * 64 + j_); pc[u_] = *(const u32x4*)(CMm + row_ * 256 + grp * 128 + off_); pb[u_] = *(const u32x4*)(BMm + row_ * 256 + grp * 128 + off_); } \
            { const int h2_ = idx >> 9, rem_ = idx & 511, j_ = rem_ >> 3, off_ = (rem_ & 7) * 8; const size_t row_ = (size_t)seq_row(b, d, (c_) * 64 + j_); px[u_] = *(const u32x4*)(XS + row_ * 512 + (grp * 4 + hp * 2 + h2_) * 64 + off_); } } \
            if (tid < 128) { const int h2_ = tid >> 6, j_ = tid & 63; const size_t row_ = (size_t)seq_row(b, d, (c_) * 64 + j_); pdt = DT[row_ * 16 + d * 8 + grp * 4 + hp * 2 + h2_]; pda = DA[row_ * 16 + d * 8 + grp * 4 + hp * 2 + h2_]; } } while (0)
        SSD_PREFETCH(0);
        for (int c = 0; c < 36; ++c) {
            LDS_BAR();
#pragma unroll
            for (int u_ = 0; u_ < 2; ++u_) { const int idx = tid + 512 * u_, j_ = idx >> 4, off_ = (idx & 15) * 8;
                *(LAS u32x4*)(Cl + j_ * 136 + off_) = pc[u_]; *(LAS u32x4*)(Bl + j_ * 136 + off_) = pb[u_]; }
            if (tid < 128) { const int h2_ = tid >> 6; float acs = pda;
#pragma unroll
                for (int o = 1; o < 64; o <<= 1) { const float t = __shfl_up(acs, o); if (lane >= o) acs += t; }
                const float al = __shfl(acs, 63);
                LAS float* sp = scal + h2_ * 256; sp[lane] = acs; sp[64 + lane] = __expf(acs); sp[128 + lane] = __expf(al - acs); sp[192 + lane] = pdt; if (lane == 0) scal[512 + h2_] = __expf(al); }
            LDS_BAR();
#pragma unroll
            for (int u_ = 0; u_ < 2; ++u_) { const int idx = tid + 512 * u_, h2_ = idx >> 9, rem_ = idx & 511, j_ = rem_ >> 3, off_ = (rem_ & 7) * 8; float xv[8]; unpack8(px[u_], xv);
                const float s1 = scal[h2_ * 256 + 192 + j_], s2 = s1 * scal[h2_ * 256 + 128 + j_]; LAS bf16_t* x1 = HD + h2_ * HDSZ; LAS bf16_t* x2 = x1 + 64 * 72; float x2v[8];
#pragma unroll
                for (int e = 0; e < 8; ++e) { x2v[e] = xv[e] * s2; xv[e] *= s1; }
                *(LAS u32x4*)(x1 + j_ * 72 + off_) = pack8(xv); *(LAS u32x4*)(x2 + j_ * 72 + off_) = pack8(x2v); }
            if (c + 1 < 36) SSD_PREFETCH(c + 1);
            { const LAS float* sp = scal + hl * 256; const int i0 = pt * 16, i = i0 + l15; const float ai = sp[i];
#pragma unroll 1
              for (int jt = 0; jt < 4; ++jt) { const int j0 = jt * 16 + 4 * q4; f32x4 g = (f32x4){0.f, 0.f, 0.f, 0.f};
                  if (jt <= pt) {
#pragma unroll
                      for (int k0 = 0; k0 < 128; k0 += 32) g = MFMA16(fragl(Bl, 136, jt * 16, k0, lane), fragl(Cl, 136, i0, k0, lane), g); }
                  float sv[4];
#pragma unroll
                  for (int jj = 0; jj < 4; ++jj) { const int j = j0 + jj; const float ex = __expf(fminf(ai - sp[j], 0.f)); sv[jj] = (j <= i) ? g[jj] * ex : 0.f; }
                  u32x2 w; w.x = cvt_pk_bf16(sv[0], sv[1]); w.y = cvt_pk_bf16(sv[2], sv[3]); *(LAS u32x2*)(Sc + i * 72 + j0) = w; } }
            LDS_BAR();
            { const LAS float* sp = scal + hl * 256; f32x4 y[4];
#pragma unroll
              for (int it = 0; it < 4; ++it) y[it] = (f32x4){0.f, 0.f, 0.f, 0.f};
#pragma unroll
              for (int n0 = 0; n0 < 128; n0 += 32) { const bf16x8 fh = fragl(Hb, 136, p0, n0, lane);
#pragma unroll
                  for (int it = 0; it < 4; ++it) y[it] = MFMA16(fh, fragl(Cl, 136, it * 16, n0, lane), y[it]); }
#pragma unroll
              for (int it = 0; it < 4; ++it) y[it] = y[it] * sp[64 + it * 16 + l15];
#pragma unroll
              for (int j0 = 0; j0 < 64; j0 += 32) { const bf16x8 fx = fragt(XT1, 72, j0, p0, lane);
#pragma unroll
                  for (int it = 0; it < 4; ++it) y[it] = MFMA16(fx, fragl(Sc, 72, it * 16, j0, lane), y[it]); }
#pragma unroll
              for (int it = 0; it < 4; ++it) { const size_t row = (size_t)seq_row(b, d, c * 64 + it * 16 + l15); u32x2 w; w.x = cvt_pk_bf16(y[it][0], y[it][1]); w.y = cvt_pk_bf16(y[it][2], y[it][3]);
                  *(u32x2*)(OUT + ((size_t)d * TT + row) * 512 + head * 64 + p0 + 4 * q4) = w; } }
            { const float gl = scal[512 + hl];
#pragma unroll
              for (int t = 0; t < 8; ++t) H[t] = H[t] * gl;
#pragma unroll
              for (int j0 = 0; j0 < 64; j0 += 32) { const bf16x8 fx = fragt(XT2, 72, j0, p0, lane);
#pragma unroll
                  for (int t = 0; t < 8; ++t) H[t] = MFMA16(fragt(Bl, 136, j0, t * 16, lane), fx, H[t]); }
#pragma unroll
              for (int t = 0; t < 8; ++t) { u32x2 w; w.x = cvt_pk_bf16(H[t][0], H[t][1]); w.y = cvt_pk_bf16(H[t][2], H[t][3]); *(LAS u32x2*)(Hb + (p0 + l15) * 136 + t * 16 + 4 * q4) = w; } }
        }
#undef SSD_PREFETCH
        __syncthreads();
    }
}

__device__ __forceinline__ void phase_merge(const PL& P) {
    const int lane = TID & 63, gw = BID * 8 + wave_id(), NGW = GDIM * 8;
    const bf16_t* OG = (const bf16_t*)(P.ws() + WS_OGDN); const bf16_t* OS = (const bf16_t*)(P.ws() + WS_OSSD); const bf16_t* Z = (const bf16_t*)(P.ws() + WS_Z); const bf16_t* XS = (const bf16_t*)(P.ws() + WS_XS);
    bf16_t* MIX = (bf16_t*)(P.ws() + WS_R2);
    float gw8[8], sw8[8]; { const float* a = P.in(IGNW) + (8 * lane) % 128; const float* s = P.in(ISNW) + 8 * lane;
#pragma unroll
        for (int j = 0; j < 8; ++j) { gw8[j] = a[j]; sw8[j] = s[j]; } }
    const float dsk = P.in(ISD)[lane >> 3];
    for (int r = gw; r < TT; r += NGW) {
        float of[8], orv[8], za[8], o[8];
        { int bb, sf, sr; if (r < TL) { bb = r >> 11; const int l = r & 2047; sf = 256 + l; sr = 256 + 2047 - l; } else { bb = (r - TL) >> 8; const int l = (r - TL) & 255; sf = l; sr = 255 - l; }
          const size_t chf = (size_t)((bb * 4 + (lane >> 4)) * 2);
          unpack8(*(const u32x4*)(OG + ((chf * 2304 + sf) * 128) + 8 * (lane & 15)), of); unpack8(*(const u32x4*)(OG + (((chf + 1) * 2304 + sr) * 128) + 8 * (lane & 15)), orv); }
        unpack8(*(const u32x4*)(Z + (size_t)r * 1024 + 8 * lane), za);
        float ss = 0.f;
#pragma unroll
        for (int j = 0; j < 8; ++j) { o[j] = of[j] + orv[j]; ss += o[j] * o[j]; }
        ss += __shfl_xor(ss, 1); ss += __shfl_xor(ss, 2); ss += __shfl_xor(ss, 4); ss += __shfl_xor(ss, 8);
        float rs = rsqrtf(ss * (1.0f / 128.0f) + RMS_EPS);
#pragma unroll
        for (int j = 0; j < 8; ++j) o[j] = o[j] * rs * gw8[j] * siluf(za[j]);
        { u32x2 q; q.x = pack4_fp8(o[0], o[1], o[2], o[3]); q.y = pack4_fp8(o[4], o[5], o[6], o[7]); *(u32x2*)((unsigned char*)MIX + (size_t)r * 1024 + 8 * lane) = q; }
        float yf[8], yr[8], xs[8], zb[8], y[8]; unpack8(*(const u32x4*)(OS + (size_t)r * 512 + 8 * lane), yf); unpack8(*(const u32x4*)(OS + ((size_t)TT + r) * 512 + 8 * lane), yr);
        unpack8(*(const u32x4*)(XS + (size_t)r * 512 + 8 * lane), xs); unpack8(*(const u32x4*)(Z + (size_t)r * 1024 + 512 + 8 * lane), zb);
        ss = 0.f;
#pragma unroll
        for (int j = 0; j < 8; ++j) { y[j] = (yf[j] + yr[j] + dsk * xs[j]) * siluf(zb[j]); ss += y[j] * y[j]; }
        ss += __shfl_xor(ss, 1); ss += __shfl_xor(ss, 2); ss += __shfl_xor(ss, 4); ss += __shfl_xor(ss, 8); ss += __shfl_xor(ss, 16);
        rs = rsqrtf(ss * (1.0f / 256.0f) + RMS_EPS);
#pragma unroll
        for (int j = 0; j < 8; ++j) y[j] = y[j] * rs * sw8[j];
        { u32x2 q; q.x = pack4_fp8(y[0], y[1], y[2], y[3]); q.y = pack4_fp8(y[4], y[5], y[6], y[7]); *(u32x2*)((unsigned char*)MIX + (size_t)r * 1024 + 512 + 8 * lane) = q; }
    }
}

__device__ __forceinline__ void phase_post2(const PL& P, LAS unsigned char* lds, int layer, const bf16_t* YM, int nrows, int CT) {
    const int tid = TID, lane = tid & 63, gw = BID * 8 + wave_id(), NGW = GDIM * 8;
    unsigned char* ws = P.ws(); const float* xin = P.in(IX); const float* cin = P.in(ICTX); const float* nwpost = P.in(IMNPOST) + layer * D; const float* nwpre = P.in(IFNPRE) + layer * D;
    LAS bf16_t* Wl = (LAS bf16_t*)lds;
    { const float* rw = P.in(IRW) + (size_t)layer * 1024 * 32; __syncthreads();
      for (int idx = tid; idx < 1024 * 32; idx += 512) { const int c = idx >> 5, e = idx & 31, l = (c & 511) >> 3, j = c >> 9, i = c & 7; Wl[(((e * 2 + j) * 64) + l) * 8 + i] = __builtin_bit_cast(unsigned short, (_Float16)rw[idx]); }
      __syncthreads(); }
    const float rbias = P.in(IRB)[layer * 32 + (lane >> 1)];
    int* RE = (int*)(ws + WS_RE); int* RP = RE + (size_t)TT * 4; float* RG = (float*)(RP + (size_t)TT * 4);
    int* TOK = (int*)(ws + WS_TOK); unsigned* CNT = (unsigned*)(ws + WS_CTL) + CW_CNT + layer * NCH * 32;
    float w[16], wp[16]; ld_row_f32(nwpost, lane, w); ld_row_f32(nwpre, lane, wp);
    const int rpw = (nrows + NGW - 1) / NGW, rbeg = gw * rpw, rend = (rbeg + rpw < nrows) ? rbeg + rpw : nrows;
    float m2v[16], shv[16], scv[16]; int curb = -1;
    u32x4 yq0, yq1; f32x4 xq0, xq1, xq2, xq3;
#define P2_LOAD(rr) do { const bf16_t* yp_ = YM + (size_t)(rr) * D + 8 * lane; yq0 = *(const u32x4*)yp_; yq1 = *(const u32x4*)(yp_ + 512); \
        if (layer == 0) { const float* xp_ = xrow(xin, cin, (rr)) + 8 * lane; xq0 = *(const f32x4*)xp_; xq1 = *(const f32x4*)(xp_ + 4); xq2 = *(const f32x4*)(xp_ + 512); xq3 = *(const f32x4*)(xp_ + 516); } \
        else { const bf16_t* hp_ = hbrow(ws, (rr)) + 8 * lane; xq0 = __builtin_bit_cast(f32x4, *(const u32x4*)hp_); xq1 = __builtin_bit_cast(f32x4, *(const u32x4*)(hp_ + 512)); } } while (0)
    if (rbeg < rend) P2_LOAD(rbeg);
    int pr = -1, pek = 0, ppos = 0, pch = 0;
    for (int r = rbeg; r < rend; ++r) {
        float y[16], x[16]; unpack8(yq0, &y[0]); unpack8(yq1, &y[8]);
        if (layer == 0) { x[0] = xq0.x; x[1] = xq0.y; x[2] = xq0.z; x[3] = xq0.w; x[4] = xq1.x; x[5] = xq1.y; x[6] = xq1.z; x[7] = xq1.w; x[8] = xq2.x; x[9] = xq2.y; x[10] = xq2.z; x[11] = xq2.w; x[12] = xq3.x; x[13] = xq3.y; x[14] = xq3.z; x[15] = xq3.w; }
        else { unpack8(__builtin_bit_cast(u32x4, xq0), &x[0]); unpack8(__builtin_bit_cast(u32x4, xq1), &x[8]); }
        if (r + 1 < rend) P2_LOAD(r + 1);
        const int bb = r < TL ? (r >> 11) : 32;
        if (bb != curb) { curb = bb; ld_row_f32(modp(ws, layer, r, 2), lane, m2v); ld_row_f32(modp(ws, layer, r, 3), lane, shv); ld_row_f32(modp(ws, layer, r, 4), lane, scv); }
        float ss = 0.f;
#pragma unroll
        for (int i = 0; i < 16; ++i) ss += y[i] * y[i];
        float rs = rsqrtf(wave_sum(ss) * (1.0f / 1024.0f) + RMS_EPS);
#pragma unroll
        for (int i = 0; i < 16; ++i) x[i] += m2v[i] * (y[i] * rs * w[i]);
        st_row_bf16(hbrow(ws, r), lane, x);
        ss = 0.f;
#pragma unroll
        for (int i = 0; i < 16; ++i) ss += x[i] * x[i];
        rs = rsqrtf(wave_sum(ss) * (1.0f / 1024.0f) + RMS_EPS);
        float o[16];
#pragma unroll
        for (int i = 0; i < 16; ++i) o[i] = x[i] * rs * wp[i] * (1.0f + scv[i]) + shv[i];
        { unsigned char* dst8 = ws + WS_A2Q;
#pragma unroll
          for (int j = 0; j < 2; ++j) { u32x2 q; q.x = pack4_fp8(o[8 * j], o[8 * j + 1], o[8 * j + 2], o[8 * j + 3]); q.y = pack4_fp8(o[8 * j + 4], o[8 * j + 5], o[8 * j + 6], o[8 * j + 7]); *(u32x2*)(dst8 + blk_off8(r, 8 * lane + 512 * j)) = q; } }
        typedef _Float16 h2v __attribute__((ext_vector_type(2)));
        h2v op[8];
#pragma unroll
        for (int q = 0; q < 8; ++q) { op[q].x = (_Float16)o[2 * q]; op[q].y = (_Float16)o[2 * q + 1]; }
        float pl[32];
        { typedef unsigned short u16x8 __attribute__((ext_vector_type(8))); u32x4 wb[2][8];
#define P2_LDG(buf, g) do { _Pragma("unroll") for (int q = 0; q < 8; ++q) wb[buf][q] = __builtin_bit_cast(u32x4, *(const LAS u16x8*)(Wl + ((((4 * (g) + (q >> 1)) * 2 + (q & 1)) * 64) + lane) * 8)); } while (0)
          P2_LDG(0, 0);
#pragma unroll
          for (int g = 0; g < 8; ++g) { if (g < 7) P2_LDG((g + 1) & 1, g + 1);
#pragma unroll
              for (int ee = 0; ee < 4; ++ee) { float acc = 0.f;
#pragma unroll
                  for (int j = 0; j < 2; ++j) { const u32x4 wv = wb[g & 1][2 * ee + j]; const unsigned w0 = wv.x, w1 = wv.y, w2 = wv.z, w3 = wv.w;
                      acc = __builtin_amdgcn_fdot2(op[4 * j + 0], __builtin_bit_cast(h2v, w0), acc, false); acc = __builtin_amdgcn_fdot2(op[4 * j + 1], __builtin_bit_cast(h2v, w1), acc, false);
                      acc = __builtin_amdgcn_fdot2(op[4 * j + 2], __builtin_bit_cast(h2v, w2), acc, false); acc = __builtin_amdgcn_fdot2(op[4 * j + 3], __builtin_bit_cast(h2v, w3), acc, false); }
                  pl[4 * g + ee] = acc; }
              __builtin_amdgcn_sched_barrier(0); }
#undef P2_LDG
        }
#pragma unroll
        for (int n = 32, m = 32; n >= 2; n >>= 1, m >>= 1) { const bool up = (lane & m) != 0;
#pragma unroll
            for (int k = 0; k < n / 2; ++k) { const float a = pl[k], b = pl[k + n / 2]; const float snd = up ? a : b, keep = up ? b : a; pl[k] = keep + __shfl_xor(snd, m); } }
        float lg = pl[0] + __shfl_xor(pl[0], 1) + rbias;
        const int myexp = lane >> 1;
        const int lgb = __builtin_bit_cast(int, lg); int rank = 0;
#pragma unroll
        for (int e = 0; e < 32; ++e) { const float L = __builtin_bit_cast(float, __builtin_amdgcn_readlane(lgb, 2 * e)); rank += (L > lg || (L == lg && e < myexp)) ? 1 : 0; }
        int sel[4]; float sv[4];
#pragma unroll
        for (int k = 0; k < 4; ++k) { const unsigned long long m = __builtin_amdgcn_ballot_w64(rank == k); const int l = m ? (int)__builtin_ctzll(m) : 0; sel[k] = l >> 1; sv[k] = __builtin_bit_cast(float, __builtin_amdgcn_readlane(lgb, l)); }
        const float e1 = expf(sv[1] - sv[0]), e2 = expf(sv[2] - sv[0]), e3 = expf(sv[3] - sv[0]), inv = 1.0f / (1.0f + e1 + e2 + e3);
        if (lane < 4) { const int ek = lane == 0 ? sel[0] : (lane == 1 ? sel[1] : (lane == 2 ? sel[2] : sel[3])); const float gk = (lane == 0 ? 1.0f : (lane == 1 ? e1 : (lane == 2 ? e2 : e3))) * inv;
            if (pr >= 0) { RP[(size_t)pr * 4 + lane] = ppos; TOK[((size_t)pch * 32 + pek) * CT + ppos] = pr; }
            const int ch = r / CT; ppos = (int)atomicAdd(&CNT[ch * 32 + ek], 1u); pek = ek; pch = ch;
            RE[(size_t)r * 4 + lane] = ek; RG[(size_t)r * 4 + lane] = gk; }
        pr = r;
    }
    if (pr >= 0 && lane < 4) { RP[(size_t)pr * 4 + lane] = ppos; TOK[((size_t)pch * 32 + pek) * CT + ppos] = pr; }
#undef P2_LOAD
}

__device__ __forceinline__ void moe_tables(const PL& P, LAS unsigned char* lds, int layer, int ch) {
    LAS int* cnt = (LAS int*)(lds + LDS_X + (ch & 1) * 512); LAS int* tp = cnt + 32;
    __syncthreads();
    if (TID == 0) { const unsigned* CNT = (const unsigned*)(P.ws() + WS_CTL) + CW_CNT + (layer * NCH + ch) * 32; int acc = 0;
        for (int e = 0; e < 32; ++e) { const int c = (int)__hip_atomic_load(CNT + e, __ATOMIC_RELAXED, __HIP_MEMORY_SCOPE_AGENT); cnt[e] = c; tp[e] = acc; acc += (c + 255) >> 8; } tp[32] = acc; }
    __syncthreads();
    { const int t = TID; LAS int* te = (LAS int*)(lds + LDS_X + 1024 + (ch & 1) * 2048); if (t < 32) { const int t1 = tp[t + 1]; for (int i = tp[t]; i < t1; ++i) te[i] = t; } }
    __syncthreads();
}
__device__ __forceinline__ void combine_acc(const u32x2 (&yq)[8], const u32x4 (&hq)[2], const float (&g)[4], float (&f)[16], float (&x)[16]) {
#pragma unroll
    for (int i = 0; i < 16; ++i) f[i] = 0.f;
#pragma unroll
    for (int k = 0; k < 4; ++k)
#pragma unroll
        for (int j = 0; j < 2; ++j) { const u32x2 w = yq[2 * k + j];
            const f32x2 a = __builtin_amdgcn_cvt_pk_f32_fp8((int)w.x, false), b = __builtin_amdgcn_cvt_pk_f32_fp8((int)w.x, true), c = __builtin_amdgcn_cvt_pk_f32_fp8((int)w.y, false), d = __builtin_amdgcn_cvt_pk_f32_fp8((int)w.y, true);
            f[8 * j] += g[k] * a.x; f[8 * j + 1] += g[k] * a.y; f[8 * j + 2] += g[k] * b.x; f[8 * j + 3] += g[k] * b.y; f[8 * j + 4] += g[k] * c.x; f[8 * j + 5] += g[k] * c.y; f[8 * j + 6] += g[k] * d.x; f[8 * j + 7] += g[k] * d.y; }
    unpack8(hq[0], &x[0]); unpack8(hq[1], &x[8]);
}
__device__ __forceinline__ void phase_combine(const PL& P, LAS unsigned char* lds, int layer, int ch, int CT) {
    const LAS int* tp = (const LAS int*)(lds + LDS_X + (ch & 1) * 512) + 32;
    const int lane = TID & 63, gw = BID * 8 + wave_id(), NGW = GDIM * 8;
    unsigned char* ws = P.ws(); float* outp = P.out(); const float* nwpost = P.in(IFNPOST) + layer * D; const float* nwpre1 = P.in(IMNPRE) + D;
    const int* RE = (const int*)(ws + WS_RE); const int* RP = RE + (size_t)TT * 4; const float* RG = (const float*)(RP + (size_t)TT * 4);
    const unsigned char* Y = ws + WS_Y + (size_t)(ch & 1) * (160 * MiB); unsigned char* A1 = ws + WS_A1;
    const int rpw = (CT + NGW - 1) / NGW, rlim = (ch + 1) * CT, rbeg = ch * CT + gw * rpw, rend = rbeg + rpw < rlim ? rbeg + rpw : rlim;
    float w[16], wv[16], m5[16], sh[16], sc[16]; ld_row_f32(nwpost, lane, w);
#pragma unroll
    for (int i = 0; i < 16; ++i) { wv[i] = 0.f; m5[i] = 0.f; sh[i] = 0.f; sc[i] = 0.f; }
    if (layer == 0) ld_row_f32(nwpre1, lane, wv);
    int curb = -1;
#define CB_LOAD(set, j) do { _Pragma("unroll") for (int k_ = 0; k_ < 4; ++k_) { const int slot_ = __builtin_amdgcn_readlane(slotL, 4 * (j) + k_); const unsigned char* yp_ = Y + (size_t)slot_ * D + 8 * lane; \
            yq[set][2 * k_] = *(const u32x2*)yp_; yq[set][2 * k_ + 1] = *(const u32x2*)(yp_ + 512); } \
        const bf16_t* hp_ = hbrow(ws, g0 + (j)) + 8 * lane; hq[set][0] = *(const u32x4*)hp_; hq[set][1] = *(const u32x4*)(hp_ + 512); } while (0)
#define CB_ROW(set, j) do { const int r = g0 + (j); float f[16], x[16], g_[4]; \
        _Pragma("unroll") for (int k_ = 0; k_ < 4; ++k_) g_[k_] = __builtin_bit_cast(float, __builtin_amdgcn_readlane(gLb, 4 * (j) + k_)); \
        combine_acc(yq[set], hq[set], g_, f, x); \
        if ((j) + 2 < gn) CB_LOAD(set, (j) + 2); \
        const int bb = r < TL ? (r >> 11) : 32; \
        if (bb != curb) { curb = bb; ld_row_f32(modp(ws, layer, r, 5), lane, m5); if (layer == 0) { ld_row_f32(modp(ws, 1, r, 0), lane, sh); ld_row_f32(modp(ws, 1, r, 1), lane, sc); } } \
        float ss = 0.f; \
        _Pragma("unroll") for (int i = 0; i < 16; ++i) ss += f[i] * f[i]; \
        const float rs = rsqrtf(wave_sum(ss) * (1.0f / 1024.0f) + RMS_EPS); \
        _Pragma("unroll") for (int i = 0; i < 16; ++i) x[i] += m5[i] * (f[i] * rs * w[i]); \
        if (layer == 0) { st_row_bf16(hbrow(ws, r), lane, x); norm_mod_pre(x, wv, sh, sc, nullptr, lane, A1 + (size_t)r * D); } else st_row_f32(outp + (size_t)r * D, lane, x); } while (0)
    for (int g0 = rbeg; g0 < rend; g0 += 16) {
        const int gn = rend - g0 < 16 ? rend - g0 : 16;
        int slotL = 0; float gL = 0.f;
        if (lane < 4 * gn) { const int e = RE[(size_t)g0 * 4 + lane], pos = RP[(size_t)g0 * 4 + lane]; gL = RG[(size_t)g0 * 4 + lane]; slotL = tp[e] * 256 + pos; }
        const int gLb = __builtin_bit_cast(int, gL);
        u32x2 yq[2][8]; u32x4 hq[2][2];
        CB_LOAD(0, 0); if (gn > 1) CB_LOAD(1, 1);
        for (int j = 0; j < gn; j += 2) { CB_ROW(0, j); if (j + 1 < gn) CB_ROW(1, j + 1); }
    }
#undef CB_LOAD
#undef CB_ROW
}

__device__ __forceinline__ void phase_s5_scan(const PL& P) {
    const float* S = (const float*)(P.ws() + WS_S5S); const float* LP = (const float*)(P.ws() + WS_LP); bf16_t* UL = (bf16_t*)(P.ws() + WS_UL);
    for (int idx = BID * 512 + TID; idx < 32 * 64 * 2 * 64; idx += GDIM * 512) { const int p = idx & 63, d = (idx >> 6) & 1, g = (idx >> 7) & 63, b = idx >> 13, dg = d * 64 + g;
        const float lr = LP[(((size_t)dg * 33 + 32) * 64 + p) * 2], li = LP[(((size_t)dg * 33 + 32) * 64 + p) * 2 + 1];
        const float* Sg = S + (size_t)g * S5ROWS * 256 + d * 128 + p; bf16_t* Ug = UL + (size_t)g * S5ROWS * S5K + 512 + d * 128 + p;
        float xr = 0.f, xi = 0.f;
        for (int c = 0; c < 8; ++c) { const int cc = d ? 7 - c : c, row = 2048 + b * 8 + cc; const float sr = Sg[(size_t)row * 256], si = Sg[(size_t)row * 256 + 64];
            const float nr = lr * xr - li * xi + sr, ni = lr * xi + li * xr + si; xr = nr; xi = ni; }
#pragma unroll 8
        for (int c = 0; c < 64; ++c) { const int cc = d ? 63 - c : c, row = b * 64 + cc; const float sr = Sg[(size_t)row * 256], si = Sg[(size_t)row * 256 + 64];
            Ug[(size_t)row * S5K] = f2bf(xr); Ug[(size_t)row * S5K + 64] = f2bf(xi);
            const float nr = lr * xr - li * xi + sr, ni = lr * xi + li * xr + si; xr = nr; xi = ni; }
    }
}

__global__ void __launch_bounds__(512, 2) hybrid_fwd(Params Pk) {
    extern __shared__ __attribute__((aligned(16))) unsigned char lds_raw[];
    LAS unsigned char* lds = (LAS unsigned char*)lds_raw;
    volatile LAS unsigned* MISC = (volatile LAS unsigned*)(lds + LDS_MISC);
    for (int u = threadIdx.x; u < 256; u += 512) MISC[u] = 0u;
    __syncthreads();
    if (threadIdx.x < (NIN + 2) * 2) ((LAS unsigned*)(lds + LDS_PARAMS))[threadIdx.x] = ((const unsigned*)&Pk)[threadIdx.x];
    __syncthreads();
    const int w0_ = __builtin_amdgcn_readfirstlane((int)threadIdx.x >> 6); const PL P0{lds, 0, w0_};
    (void)xcd_barrier_post((unsigned*)(P0.ws() + WS_CTL) + CW_BAR, MISC + 8);
#define GRID_BAR() do { SITE; xcd_barrier(P, MISC + 8); } while (0)
#define SITE const int z_ = opaque0(); const PL P{lds + z_, z_, w0_}

    { SITE; phase_mod(P, lds); __syncthreads(); phase_cvt_dense(P, lds); __syncthreads(); phase_s5_tables(P, lds); }
    GRID_BAR();
    { SITE; phase_pre0(P); }
    GRID_BAR();
    { SITE; unsigned char* ws = P.ws(); DenseSched S; S.init(ws + WS_R2, ws + WS_WIN, TT / 256, INWP / 256, 1024, 1024, P.z);
      EpiInProj E{(bf16_t*)(ws + WS_CONVA), (bf16_t*)(ws + WS_CONVB), (bf16_t*)(ws + WS_Z), (float*)(ws + WS_GATE)};
      pg8::gemm_phase<EpiInProj, DenseSched, false>(lds, 1024, 64, 64, S, E, TID, 256 * 128); }
    GRID_BAR();
    { SITE; phase_conv2(P, lds); }
    GRID_BAR();
    { SITE; phase_gdn1m(P, lds, WS_OGDN); }
    GRID_BAR();
    { SITE; phase_gdn2(P, lds, WS_OGDN); __syncthreads(); phase_ssd_chunked(P, lds, WS_OSSD); }
    GRID_BAR();
    { SITE; phase_merge(P); phase_cvt_moe(P, lds, 0); }
    GRID_BAR();
    { SITE; unsigned char* ws = P.ws(); DenseSched S; S.init(ws + WS_R2, ws + WS_WOUT, TT / 256, 4, 1024, 1024, P.z, 1);
      EpiBf16 E{(bf16_t*)(ws + WS_YMIX), 1024, nullptr, 0, 1.0f / W8_SCALE};
      pg8::gemm_phase<EpiBf16, DenseSched, false, true>(lds, 1024, 1024, 1024, S, E, TID);
      }
    GRID_BAR();

#pragma unroll 1
    for (int layer = 0; layer < 2; ++layer) {
        const int ntok = layer == 0 ? TT : TL, CT = ntok / NCH;
        if (layer == 1) {
            { SITE; phase_s5_mats(P); }
            { SITE; unsigned char* ws = P.ws(); DenseSched S; S.init(ws + WS_A1, ws + WS_WS5IN, TT / 256, 4, 1024, 1024, P.z, 1);
              EpiS5U E{(bf16_t*)(ws + WS_UL)};
              pg8::gemm_phase<EpiS5U, DenseSched, false, true>(lds, 1024, 1024, 1024, S, E, TID);
              }
            GRID_BAR();
            { SITE; unsigned char* ws = P.ws(); GroupSched S{(const char*)(ws + WS_UL), (const char*)(ws + WS_E), (size_t)S5ROWS * S5K * 2, (size_t)256 * 512 * 2, (size_t)256 * S5K * 2, 0, 64, S5ROWS / 256, 1, GDIM, BID};
              EpiS5S E{(float*)(ws + WS_S5S)};
              pg8::gemm_phase<EpiS5S, GroupSched, false>(lds, 512, S5K, 512, S, E, TID);
              }
            GRID_BAR();
            { SITE; phase_s5_scan(P); }
            GRID_BAR();
            { SITE; unsigned char* ws = P.ws(); GroupSched S{(const char*)(ws + WS_UL), (const char*)(ws + WS_MP), (size_t)S5ROWS * S5K * 2, (size_t)512 * S5K * 2, (size_t)256 * S5K * 2, (size_t)256 * S5K * 2, 64, 8, 2, GDIM, BID};
              EpiS5Y E{ws + WS_R2};
              pg8::gemm_phase<EpiS5Y, GroupSched, false>(lds, S5K, S5K, S5K, S, E, TID);
              }
            GRID_BAR();
            { SITE; unsigned char* ws = P.ws(); DenseSched S; S.init(ws + WS_R2, ws + WS_WGLU, TL / 256, 8, 1024, 1024, P.z, 1);
              EpiGLU E{(bf16_t*)(ws + WS_YMIX1)};
              pg8::gemm_phase<EpiGLU, DenseSched, false, true>(lds, 1024, 1024, 1024, S, E, TID);
              }
            GRID_BAR();
        }
        { SITE; phase_post2(P, lds, layer, (const bf16_t*)(P.ws() + (layer == 0 ? WS_YMIX : WS_YMIX1)), ntok, CT); }
        GRID_BAR();
#pragma unroll 1
        for (int k = 0; k < NCH + 2; ++k) {
            if (k >= 2) { SITE; phase_combine(P, lds, layer, k - 2, CT); if (layer == 0 && k == NCH + 1) phase_cvt_moe(P, lds, 1); }
            if (k < NCH) { SITE; moe_tables(P, lds, layer, k); }
            int xrot = 0;
            if (k >= 1 && k <= NCH) { SITE; const int ch = k - 1; const LAS int* cnt = (const LAS int*)(lds + LDS_X + (ch & 1) * 512); const LAS int* tp = cnt + 32; unsigned char* ws = P.ws();
              MoeSched S{tp, cnt, (const LAS int*)(lds + LDS_X + 1024 + (ch & 1) * 2048), 4, tp[32], false, (const char*)(ws + WS_H + (size_t)(ch & 1) * (80 * MiB)), (const char*)(ws + WS_WMOE) + (size_t)32 * 2048 * 1024, (size_t)1024 * 1024, nullptr, CT, GDIM, BID, 1024, 0};
              EpiFp8 E{ws + WS_Y + (size_t)(ch & 1) * (160 * MiB), 1024, P.in(IBD) + (size_t)layer * 32 * 1024, 1024, 1.0f / (W8_SCALE * H8_SCALE)};
              pg8::gemm_phase<EpiFp8, MoeSched, false, true>(lds, 1024, 128, 128, S, E, TID, 256 * 128);
              xrot = __builtin_amdgcn_readfirstlane(((tp[32] + 7) >> 3) & 7); }
            if (k < NCH) { SITE; const int ch = k; const LAS int* cnt = (const LAS int*)(lds + LDS_X + (ch & 1) * 512); const LAS int* tp = cnt + 32; unsigned char* ws = P.ws();
              MoeSched S{tp, cnt, (const LAS int*)(lds + LDS_X + 1024 + (ch & 1) * 2048), 8, tp[32], true, (const char*)(ws + WS_A2Q), (const char*)(ws + WS_WMOE), (size_t)2048 * 1024, (const int*)(ws + WS_TOK) + (size_t)ch * 32 * CT, CT, GDIM, BID, 1024, xrot};
              EpiSwiGLU E{ws + WS_H + (size_t)(ch & 1) * (80 * MiB), P.in(IBG) + (size_t)layer * 32 * 1024, P.in(IBU) + (size_t)layer * 32 * 1024};
              pg8::gemm_phase<EpiSwiGLU, MoeSched, true, true>(lds, 1024, 128, 128, S, E, TID, 256 * 128);
              }
            GRID_BAR();
        }
    }
#undef GRID_BAR
}

extern "C" void kernel_launch(void* const* d_in, const int* in_sizes, int n_in, void* d_out, int out_size, void* d_ws, size_t ws_size, hipStream_t stream) {
    static int grid = 0;
    if (grid == 0) {
        if (n_in != NIN || in_sizes[IX] != TL * D || out_size != TL * D || ws_size < WS_END) { fprintf(stderr, "kernel_launch: unexpected shapes (n_in %d, x %d, out %d, ws %zu < %zu); nothing launched\n", n_in, n_in > 0 ? in_sizes[0] : -1, out_size, ws_size, (size_t)WS_END); grid = -1; return; }
        int dev = 0, cus = 0, per_cu = 0;
        if (hipGetDevice(&dev) != hipSuccess || hipDeviceGetAttribute(&cus, hipDeviceAttributeMultiprocessorCount, dev) != hipSuccess) { grid = -1; return; }
        if (hipFuncSetAttribute((const void*)hybrid_fwd, hipFuncAttributeMaxDynamicSharedMemorySize, LDS_BYTES) != hipSuccess) { fprintf(stderr, "kernel_launch: hipFuncSetAttribute failed\n"); grid = -1; return; }
        if (hipOccupancyMaxActiveBlocksPerMultiprocessor(&per_cu, (const void*)hybrid_fwd, 512, LDS_BYTES) != hipSuccess || per_cu < 1) fprintf(stderr, "kernel_launch: occupancy query reports %d\n", per_cu);
        (void)hipGetLastError();
        grid = cus;
    }
    if (grid < 0) return;
    if (hipMemsetAsync((char*)d_ws + WS_CTL, 0, CTL_ZERO_BYTES, stream) != hipSuccess) return;
    Params p; memset(&p, 0, sizeof(p));
    for (int i = 0; i < NIN; ++i) p.in[i] = (const float*)d_in[i];
    p.out = (float*)d_out; p.ws = (unsigned char*)d_ws;
    hipLaunchKernelGGL(hybrid_fwd, dim3(grid), dim3(512), LDS_BYTES, stream, p);
}
```

```cpp
#include <hip/hip_runtime.h>
#include <cstdio>
#include <cstdint>
#include <cstring>

#define LAS __attribute__((address_space(3)))
typedef unsigned short bf16_t;
typedef short bf16x8 __attribute__((ext_vector_type(8)));
typedef float f32x4 __attribute__((ext_vector_type(4)));
typedef float f32x2 __attribute__((ext_vector_type(2)));
typedef unsigned u32x4 __attribute__((ext_vector_type(4)));
typedef unsigned u32x2 __attribute__((ext_vector_type(2)));

constexpr int D = 1024, NBATCH = 32, SEQ = 2048, CTXL = 256;
constexpr int TL = NBATCH * SEQ, TC = NBATCH * CTXL, TT = TL + TC;
constexpr int NEXP = 32;
constexpr int INW = 3616, INWP = 3840;
constexpr float RMS_EPS = 1e-6f;
constexpr int NCH = 4;
constexpr int S5T = 32, S5ROWS = 2304, S5K = 768;

enum { IX = 0, IC, ICTX, ICCTX, IADAW, IADAB, IMNPRE, IMNPOST, IFNPRE, IFNPOST, IRW, IRB, IWG, IBG, IWU, IBU, IWD, IBD, IHYIN, IGCW, IGALOG, IGDTB, IGNW,
       ISCW, ISCB, ISALOG, ISDTB, ISD, ISNW, IHYOUT, IS5IN, IS5ARE, IS5AIM, IS5LS, IS5BRE, IS5BIM, IS5CRE, IS5CIM, IS5D, IGLUA, IGLUB, NIN };

constexpr size_t MiB = 1u << 20;
constexpr size_t WS_CTL = 0, CTL_ZERO_BYTES = 65536;
constexpr size_t WS_R2 = 1 * MiB;
constexpr size_t WS_Z = 145 * MiB;
constexpr size_t WS_H = 145 * MiB;
constexpr size_t WS_Y = 305 * MiB;
constexpr size_t WS_UL = 145 * MiB;
constexpr size_t WS_YMIX1 = 145 * MiB;
constexpr size_t WS_XS = 289 * MiB;
constexpr size_t WS_GATE = 361 * MiB;
constexpr size_t WS_S5S = 361 * MiB;
constexpr size_t WS_GPOST = 370 * MiB;
constexpr size_t WS_CONVA = 384 * MiB;
constexpr size_t WS_OGDN = 384 * MiB;
constexpr size_t WS_YMIX = 384 * MiB;
constexpr size_t WS_MP = 505 * MiB;
constexpr size_t WS_E = 553 * MiB;
constexpr size_t WS_OSSD = 528 * MiB;
constexpr size_t WS_CONVB = 600 * MiB;
constexpr size_t WS_A1 = 625 * MiB;
constexpr size_t WS_Q = 744 * MiB, WS_K = 816 * MiB, WS_V = 888 * MiB;
constexpr size_t WS_WMOE = 768 * MiB;
constexpr size_t WS_A2Q = 864 * MiB;
constexpr float W8_SCALE = 32.0f, H8_SCALE = 4.0f;

constexpr size_t WS_BM = 960 * MiB, WS_CM = 996 * MiB;
constexpr size_t WS_HCTX = 1032 * MiB;
constexpr size_t WS_MOD = 1064 * MiB;
constexpr size_t WS_WIN = 1066 * MiB;
constexpr size_t WS_WOUT = 1074 * MiB;
constexpr size_t WS_RB = 1076 * MiB;
constexpr size_t WS_WS5IN = 1077 * MiB;
constexpr size_t WS_WGLU = 1079 * MiB;
constexpr size_t WS_KT = 1083 * MiB;
constexpr size_t WS_LP = 1087 * MiB;
constexpr size_t WS_BB = 1090 * MiB;
constexpr size_t WS_WIN8 = 1091 * MiB;
constexpr size_t WS_RE = 1100 * MiB;
constexpr size_t WS_TOK = 1104 * MiB;
constexpr size_t WS_HBL = 936 * MiB;
constexpr size_t WS_HBC = 1113 * MiB;
constexpr size_t WS_END = 1129 * MiB;
constexpr int CW_BAR = 4096, CW_CNT = 8192;

constexpr int LDS_BYTES = 147456, LDS_X = 131072  , LDS_MISC = LDS_BYTES - 1024;

__device__ __forceinline__ float bflo(unsigned w) { return __uint_as_float(w << 16); }
__device__ __forceinline__ float bfhi(unsigned w) { return __uint_as_float(w & 0xffff0000u); }
__device__ __forceinline__ float bf1(bf16_t b) { return __uint_as_float(((unsigned)b) << 16); }
typedef __bf16 bf16n2 __attribute__((ext_vector_type(2)));
__device__ __forceinline__ unsigned cvt_pk_bf16(float lo, float hi) { bf16n2 v; v.x = (__bf16)lo; v.y = (__bf16)hi; return __builtin_bit_cast(unsigned, v); }
__device__ __forceinline__ bf16_t f2bf(float f) { return (bf16_t)(cvt_pk_bf16(f, 0.f) & 0xffffu); }
__device__ __forceinline__ unsigned pack4_fp8(float a, float b, float c, float d) { int w = 0; w = __builtin_amdgcn_cvt_pk_fp8_f32(a, b, w, false); w = __builtin_amdgcn_cvt_pk_fp8_f32(c, d, w, true); return (unsigned)w; }
template <int CTRL, int RM = 0xF, int BM = 0xF> __device__ __forceinline__ float dppmov(float old, float src) { return __builtin_bit_cast(float, __builtin_amdgcn_update_dpp(__builtin_bit_cast(int, old), __builtin_bit_cast(int, src), CTRL, RM, BM, false)); }
__device__ __forceinline__ float wave_sum(float v) {
    v += dppmov<0xB1>(v, v); v += dppmov<0x4E>(v, v); v += dppmov<0x141>(v, v); v += dppmov<0x140>(v, v);
    const int b = __builtin_bit_cast(int, v);
    return (__builtin_bit_cast(float, __builtin_amdgcn_readlane(b, 0)) + __builtin_bit_cast(float, __builtin_amdgcn_readlane(b, 16))) + (__builtin_bit_cast(float, __builtin_amdgcn_readlane(b, 32)) + __builtin_bit_cast(float, __builtin_amdgcn_readlane(b, 48)));
}
__device__ __forceinline__ float siluf(float x) { return x * __builtin_amdgcn_rcpf(1.0f + __expf(-x)); }
__device__ __forceinline__ float sigmoidf_(float x) { return __builtin_amdgcn_rcpf(1.0f + __expf(-x)); }
__device__ __forceinline__ float softplusf_(float x) { return x > 20.f ? x : log1pf(expf(x)); }
#define PFMA(r, a, b) asm("v_fmac_f32 %0, %1, %2" : "+v"(r) : "v"(a), "v"(b))
#define LDS_WAIT() asm volatile("s_waitcnt lgkmcnt(0)" ::: "memory")
#define VM_WAIT() asm volatile("s_waitcnt vmcnt(0)" ::: "memory")
#define LDS_BAR() do { asm volatile("s_waitcnt lgkmcnt(0)" ::: "memory"); __builtin_amdgcn_s_barrier(); asm volatile("" ::: "memory"); } while (0)

__device__ __forceinline__ void ld_row_f32(const float* p, int lane, float (&v)[16]) {
#pragma unroll
    for (int j = 0; j < 2; ++j) { const f32x4 a = *(const f32x4*)(p + 8 * lane + 512 * j), b = *(const f32x4*)(p + 8 * lane + 512 * j + 4);
        v[8 * j + 0] = a.x; v[8 * j + 1] = a.y; v[8 * j + 2] = a.z; v[8 * j + 3] = a.w; v[8 * j + 4] = b.x; v[8 * j + 5] = b.y; v[8 * j + 6] = b.z; v[8 * j + 7] = b.w; }
}
__device__ __forceinline__ void st_row_f32(float* p, int lane, const float (&v)[16]) {
#pragma unroll
    for (int j = 0; j < 2; ++j) { *(f32x4*)(p + 8 * lane + 512 * j) = (f32x4){v[8 * j], v[8 * j + 1], v[8 * j + 2], v[8 * j + 3]}; *(f32x4*)(p + 8 * lane + 512 * j + 4) = (f32x4){v[8 * j + 4], v[8 * j + 5], v[8 * j + 6], v[8 * j + 7]}; }
}
__device__ __forceinline__ void unpack8(const u32x4 w, float* v) { v[0] = bflo(w.x); v[1] = bfhi(w.x); v[2] = bflo(w.y); v[3] = bfhi(w.y); v[4] = bflo(w.z); v[5] = bfhi(w.z); v[6] = bflo(w.w); v[7] = bfhi(w.w); }
__device__ __forceinline__ u32x4 pack8(const float* v) { u32x4 w; w.x = cvt_pk_bf16(v[0], v[1]); w.y = cvt_pk_bf16(v[2], v[3]); w.z = cvt_pk_bf16(v[4], v[5]); w.w = cvt_pk_bf16(v[6], v[7]); return w; }
__device__ __forceinline__ size_t blk_off(int r, int c) { return (size_t)(r >> 8) * (256 * 1024) + (size_t)(c >> 6) * (256 * 64) + (size_t)(r & 255) * 64 + (c & 63); }
__device__ __forceinline__ int inproj_row(int n) { const int c = n & 255; return (n & ~255) + 128 * ((c >> 5) & 1) + 32 * (c >> 6) + (c & 31); }
__device__ __forceinline__ size_t blk_off8(int r, int c) { return (size_t)(r >> 8) * (256 * 1024) + (size_t)(c >> 7) * (256 * 128) + (size_t)(r & 255) * 128 + (c & 127); }
__device__ __forceinline__ void ld_row_bf16(const bf16_t* p, int lane, float (&v)[16]) {
#pragma unroll
    for (int j = 0; j < 2; ++j) { const u32x4 w = *(const u32x4*)(p + 8 * lane + 512 * j); unpack8(w, &v[8 * j]); }
}
__device__ __forceinline__ void ld_row_fp8(const unsigned char* p, int lane, float (&v)[16]) {
#pragma unroll
    for (int j = 0; j < 2; ++j) { const u32x2 w = *(const u32x2*)(p + 8 * lane + 512 * j);
        const f32x2 a = __builtin_amdgcn_cvt_pk_f32_fp8((int)w.x, false), b = __builtin_amdgcn_cvt_pk_f32_fp8((int)w.x, true), c = __builtin_amdgcn_cvt_pk_f32_fp8((int)w.y, false), d = __builtin_amdgcn_cvt_pk_f32_fp8((int)w.y, true);
        v[8 * j] = a.x; v[8 * j + 1] = a.y; v[8 * j + 2] = b.x; v[8 * j + 3] = b.y; v[8 * j + 4] = c.x; v[8 * j + 5] = c.y; v[8 * j + 6] = d.x; v[8 * j + 7] = d.y; }
}
__device__ __forceinline__ void st_row_bf16(bf16_t* p, int lane, const float (&v)[16]) {
#pragma unroll
    for (int j = 0; j < 2; ++j) *(u32x4*)(p + 8 * lane + 512 * j) = pack8(&v[8 * j]);
}

__device__ __forceinline__ int lane_id(int z) { return (int)__builtin_amdgcn_mbcnt_hi(~0u, __builtin_amdgcn_mbcnt_lo(~0u, (unsigned)z)); }
#define XB_TMO      128
#define XB_XCNT(j)  (256  + 64 * (j))
#define XB_XSUB(j)  (1280 + 64 * (j))
#define XB_XGEN(j)  (2304 + 64 * (j))
#define XB_TOP      3328
#define XB_TOPGEN   3392
#define XCD_BAR_WORDS 3456
#define XB_SPIN_CAP (1u << 22)
__device__ __forceinline__ unsigned xb_ld(unsigned* p)              { return __hip_atomic_load(p, __ATOMIC_RELAXED, __HIP_MEMORY_SCOPE_AGENT); }
__device__ __forceinline__ unsigned xb_add(unsigned* p, unsigned v) { return __hip_atomic_fetch_add(p, v, __ATOMIC_RELAXED, __HIP_MEMORY_SCOPE_AGENT); }
__device__ __forceinline__ unsigned xb_xcc_id() { return (unsigned)__builtin_amdgcn_s_getreg((3 << 11) | 20) & 0xFu; }
#define XB_SPIN(cond, bar) do { unsigned _sp = 0; while (cond) { __builtin_amdgcn_s_sleep(1); \
    if ((++_sp & 255u) == 0u) { if (xb_ld(&(bar)[XB_TMO])) break; if (_sp > XB_SPIN_CAP) { atomicAdd(&(bar)[XB_TMO], 1u); break; } } } } while (0)
struct XcdBarrier { unsigned* bar; unsigned x; volatile LAS unsigned* st; };
__device__ __forceinline__ XcdBarrier xcd_barrier_post(unsigned* bar, volatile LAS unsigned* st) {
    XcdBarrier b; b.bar = bar; b.x = xb_xcc_id(); b.st = st;
    if (threadIdx.x == 0) (void)xb_add(&bar[XB_XCNT(b.x)], 1u);
    return b;
}
__device__ __forceinline__ void xcd_barrier_complete(unsigned* bar, unsigned x, unsigned& nloc, unsigned& nx) {
    const unsigned G = gridDim.x * gridDim.y * gridDim.z;
    unsigned sum, cnt, mine, sp = 0u;
    for (;;) {
        sum = 0u; cnt = 0u; mine = 0u;
#pragma unroll
        for (unsigned j = 0; j < 16; ++j) { const unsigned c = xb_ld(&bar[XB_XCNT(j)]); sum += c; cnt += (c > 0u) ? 1u : 0u; mine = (j == x) ? c : mine; }
        if (sum == G) break;
        __builtin_amdgcn_s_sleep(1);
        if ((++sp & 255u) == 0u) { if (xb_ld(&bar[XB_TMO])) break; if (sp > XB_SPIN_CAP) { atomicAdd(&bar[XB_TMO], 1u); break; } }
    }
    nloc = mine > 0u ? mine : 1u; nx = cnt > 0u ? cnt : 1u;
}
template <class PLT> __device__ __forceinline__ void xcd_barrier(const PLT& P, volatile LAS unsigned* st) {
    asm volatile("s_waitcnt vmcnt(0)" ::: "memory");
    __syncthreads();
    if (P.w0 == 0 && lane_id(P.z) == 0) {
        XcdBarrier b; b.bar = (unsigned*)(P.ws() + WS_CTL) + CW_BAR; b.x = xb_xcc_id(); b.st = st;
        unsigned* bar = b.bar;
        __builtin_amdgcn_s_waitcnt(0);
        unsigned nloc = b.st[0], nx = b.st[1];
        if (nloc == 0u) { xcd_barrier_complete(bar, b.x, nloc, nx); b.st[0] = nloc; b.st[1] = nx; }
        const unsigned old = xb_add(&bar[XB_XSUB(b.x)], 1u);
        const unsigned gen = old / nloc;
        if (old + 1u == (gen + 1u) * nloc) {
            __builtin_amdgcn_fence(__ATOMIC_RELEASE, "agent");
            asm volatile("s_waitcnt vmcnt(0)" ::: "memory");
            const unsigned og = xb_add(&bar[XB_TOP], 1u);
            const unsigned tg = og / nx;
            if (og + 1u == (tg + 1u) * nx) xb_add(&bar[XB_TOPGEN], 1u);
            else XB_SPIN(xb_ld(&bar[XB_TOPGEN]) == tg, bar);
            __builtin_amdgcn_fence(__ATOMIC_ACQUIRE, "agent");
            xb_add(&bar[XB_XGEN(b.x)], 1u);
            asm volatile("s_waitcnt vmcnt(0)" ::: "memory");
        } else {
            XB_SPIN(xb_ld(&bar[XB_XGEN(b.x)]) == gen, bar);
            __builtin_amdgcn_fence(__ATOMIC_ACQUIRE, "agent");
            asm volatile("s_waitcnt vmcnt(0)" ::: "memory");
        }
    }
    __syncthreads();
}

namespace pg8 {
constexpr int BM = 256, BK = 64, HALF = 128, HTB = HALF * BK * 2, STAGE_BYTES = 8 * HTB, NXCD = 8, WGM = 8;
__device__ __forceinline__ int lds_byte(int r, int c) { const int st = (r >> 4) * 2 + (c >> 5), rr = r & 15, cc = c & 31, ob = rr * 64 + cc * 2; return st * 1024 + (ob ^ (((ob >> 9) & 1) << 5)); }
__device__ __forceinline__ void stage_rc(int b, int& R, int& C) { const int st = b / 1024, sb = b % 1024, swz = sb ^ (((sb >> 9) & 1) << 5); R = (st >> 1) * 16 + swz / 64; C = (st & 1) * 32 + (swz % 64) / 2; }
__device__ __forceinline__ int perm32(int rho) { const int n = rho >> 4, i = rho & 15; return 8 * (i >> 2) + 4 * n + (i & 3); }

struct Unit { const char* A; const char* B; const int* gat; int nvalid; int r0, c0, e; };

struct TileOrder {
    int nM, nN, nwg, G, c;
    __device__ void init(int nM_, int nN_, int G_, int c_) { nM = nM_; nN = nN_; nwg = nM * nN; G = G_; c = c_; }
    __device__ bool next(int i, int& pm, int& pn) const {
        const long L = (long)i * G + c; if (L >= nwg) return false;
        int wgid = (int)L; { const int q = nwg / NXCD, r = nwg % NXCD, xcd = wgid % NXCD, off = wgid / NXCD; wgid = (xcd < r ? xcd * (q + 1) : r * (q + 1) + (xcd - r) * q) + off; }
        const int nig = WGM * nN, gid = wgid / nig, fm = gid * WGM, gsz = (nM - fm) < WGM ? (nM - fm) : WGM;
        pm = fm + ((wgid % nig) % gsz); pn = (wgid % nig) / gsz; return true;
    }
};

typedef int v8i32 __attribute__((ext_vector_type(8)));
template <class Epi, class Sched, bool GATHER, bool FP8 = false>
__device__ __forceinline__ void gemm_phase(LAS unsigned char* lds, const int K, const int lda, const int ldb, const Sched& S, const Epi& E, const int tid, const int kstepb = BK * 2) {
    constexpr int ES = FP8 ? 1 : 2;
    const int wid = __builtin_amdgcn_readfirstlane(tid >> 6), lane = tid & 63, wr = wid >> 2, wc = wid & 3, fr = lane & 15, fq = lane >> 4;
    const int nt = K / (FP8 ? 2 * BK : BK);
    unsigned cvA[2][2], nvA[2][2], voffB[2]; int stR[2], stC[2];
#pragma unroll
    for (int i = 0; i < 2; ++i) { int R, C; stage_rc(tid * 16 + i * 8192, R, C); stR[i] = R; stC[i] = C; const int Rb = Epi::PERM ? ((R & ~31) + perm32(R & 31)) : R;
        voffB[i] = (unsigned)(Rb * ldb * ES + C * 2);
#pragma unroll
        for (int h = 0; h < 2; ++h) { cvA[h][i] = (unsigned)((R + HALF * h) * lda * ES + C * 2); nvA[h][i] = cvA[h][i]; } }
    const size_t kstep = (size_t)kstepb;
    const size_t hstepB = (size_t)HALF * ldb * ES;
    const unsigned ldsw = (unsigned)wid * 1024u;
    const int aoff0 = lds_byte(wr * 64 + fr, fq * 8), aoff1 = aoff0 + 1024;
    const int boff0 = lds_byte(wc * 32 + fr, fq * 8), boff1 = boff0 + 1024;
    LAS unsigned char* pA = lds + aoff0; LAS unsigned char* pB = lds + 4 * HTB + boff0;
    asm volatile("" : "+v"(pA), "+v"(pB));
#define PG8_SA(b, h) (((b) * 2 + (h)) * HTB)
#define PG8_SB(b, h) ((4 + (b) * 2 + (h)) * HTB)
#define PG8_STAGE(bufoff, gbase, v0, v1) do { \
        __builtin_amdgcn_global_load_lds((const unsigned*)((const char*)(gbase) + (v0)), (LAS unsigned*)(lds + (bufoff) + ldsw), 16, 0, 0); \
        __builtin_amdgcn_global_load_lds((const unsigned*)((const char*)(gbase) + (v1)), (LAS unsigned*)(lds + (bufoff) + ldsw + 8192), 16, 0, 0); } while (0)
#define PG8_LD32(addr0, addr1) __builtin_bit_cast(v8i32, __builtin_shufflevector(*(const LAS u32x4*)(addr0), *(const LAS u32x4*)(addr1), 0, 1, 2, 3, 4, 5, 6, 7))
#define PG8_LDA(dst, b, h) do { _Pragma("unroll") for (int m = 0; m < 4; ++m) { if constexpr (FP8) dst##8[m] = PG8_LD32(pA + PG8_SA(b, h) + m * 2048, pA + PG8_SA(b, h) + (aoff1 - aoff0) + m * 2048); \
        else { _Pragma("unroll") for (int k = 0; k < 2; ++k) dst[m][k] = *(const LAS bf16x8*)(pA + PG8_SA(b, h) + (k ? aoff1 - aoff0 : 0) + m * 2048); } } } while (0)
#define PG8_LDB(dst, b, h) do { _Pragma("unroll") for (int n = 0; n < 2; ++n) { if constexpr (FP8) dst##8[n] = PG8_LD32(pB + (PG8_SB(b, h) - 4 * HTB) + n * 2048, pB + (PG8_SB(b, h) - 4 * HTB) + (boff1 - boff0) + n * 2048); \
        else { _Pragma("unroll") for (int k = 0; k < 2; ++k) dst[n][k] = *(const LAS bf16x8*)(pB + (PG8_SB(b, h) - 4 * HTB) + (k ? boff1 - boff0 : 0) + n * 2048); } } } while (0)
#define PG8_CAT(x0, x1) __builtin_shufflevector(__builtin_bit_cast(u32x4, x0), __builtin_bit_cast(u32x4, x1), 0, 1, 2, 3, 4, 5, 6, 7)
#define PG8_MMA(ai, bj, At, Bt) do { __builtin_amdgcn_s_setprio(1); _Pragma("unroll") for (int m = 0; m < 4; ++m) _Pragma("unroll") for (int n = 0; n < 2; ++n) { \
        if constexpr (FP8) asm volatile("v_mfma_f32_16x16x128_f8f6f4 %0, %1, %2, %0" : "+v"(acc[ai][bj][m][n]) : "v"(Bt##8[n]), "v"(At##8[m]));   \
        else { _Pragma("unroll") for (int k = 0; k < 2; ++k) acc[ai][bj][m][n] = __builtin_amdgcn_mfma_f32_16x16x32_bf16(Bt[n][k], At[m][k], acc[ai][bj][m][n], 0, 0, 0); } } __builtin_amdgcn_s_setprio(0); } while (0)
#define PG8_WAIT_V(n) asm volatile("s_waitcnt vmcnt(" #n ")" ::: "memory")
#define PG8_WAIT_L(n) asm volatile("s_waitcnt lgkmcnt(" #n ")" ::: "memory")
#define PG8_BAR __builtin_amdgcn_s_barrier()
#define PG8_SCHED __builtin_amdgcn_sched_barrier(0)
#define PG8_GATHER(u, dst) do { _Pragma("unroll") for (int h = 0; h < 2; ++h) _Pragma("unroll") for (int i = 0; i < 2; ++i) { const int rr = h * HALF + stR[i]; \
        const int tok = (rr < (u).nvalid) ? (u).gat[rr] : 0; dst[h][i] = kstepb == BK * 2 ? (unsigned)(tok * lda * ES + stC[i] * 2) : (unsigned)((tok >> 8) * (256 * 1024) + (tok & 255) * 128 + stC[i] * 2); } } while (0)
    Unit cur, nxt; int ui = 0;
    if (!S.next(0, cur)) return;
    f32x4 acc[2][2][4][2];
#pragma unroll
    for (int a = 0; a < 2; ++a)
#pragma unroll
        for (int b = 0; b < 2; ++b)
#pragma unroll
            for (int m = 0; m < 4; ++m)
#pragma unroll
                for (int n = 0; n < 2; ++n) acc[a][b][m][n] = (f32x4){0.f, 0.f, 0.f, 0.f};
    bf16x8 At[4][2], B0[2][2], B1[2][2]; v8i32 At8[4], B08[2], B18[2];
    if constexpr (GATHER) { PG8_GATHER(cur, cvA); }
    const char* cA = cur.A; const char* cB = cur.B;
    PG8_STAGE(PG8_SB(0, 0), cB, voffB[0], voffB[1]); PG8_STAGE(PG8_SB(0, 1), cB + hstepB, voffB[0], voffB[1]); PG8_STAGE(PG8_SA(0, 0), cA, cvA[0][0], cvA[0][1]); PG8_STAGE(PG8_SA(0, 1), cA, cvA[1][0], cvA[1][1]);
    if (wr == 1) PG8_BAR;
    PG8_WAIT_V(2); PG8_BAR;
    PG8_STAGE(PG8_SB(1, 0), cB + kstep, voffB[0], voffB[1]); PG8_STAGE(PG8_SA(1, 0), cA + kstep, cvA[0][0], cvA[0][1]); PG8_STAGE(PG8_SB(1, 1), cB + hstepB + kstep, voffB[0], voffB[1]);
    PG8_WAIT_V(6); PG8_BAR;
    for (;;) {
        const bool has_next = S.next(ui + 1, nxt);
        if constexpr (GATHER) { if (has_next) { PG8_GATHER(nxt, nvA); } else {
#pragma unroll
            for (int h = 0; h < 2; ++h)
#pragma unroll
                for (int i = 0; i < 2; ++i) nvA[h][i] = cvA[h][i]; } }
        const char* nA = has_next ? nxt.A : cA; const char* nB = has_next ? nxt.B : cB;
#pragma unroll 1
        for (int t = 0; t < nt; t += 2) {
            const bool last = (t == nt - 2);
            const char* a1 = cA + (size_t)(t + 1) * kstep;
            const char* a2 = last ? nA : cA + (size_t)(t + 2) * kstep; const char* b2 = last ? nB : cB + (size_t)(t + 2) * kstep;
            asm volatile("" : "+s"(a1), "+s"(a2), "+s"(b2));
            asm volatile("" : "+v"(voffB[0]), "+v"(voffB[1]), "+v"(cvA[0][0]), "+v"(cvA[0][1]), "+v"(cvA[1][0]), "+v"(cvA[1][1]));
            const char* a3 = a2 + kstep; const char* b3 = b2 + kstep;
            unsigned x00 = cvA[0][0], x01 = cvA[0][1], x10 = cvA[1][0], x11 = cvA[1][1];
            if constexpr (GATHER) { if (last) { x00 = nvA[0][0]; x01 = nvA[0][1]; x10 = nvA[1][0]; x11 = nvA[1][1]; } }
            PG8_LDB(B0, 0, 0); PG8_LDB(B1, 0, 1); PG8_SCHED; PG8_LDA(At, 0, 0); PG8_STAGE(PG8_SA(1, 1), a1, cvA[1][0], cvA[1][1]);
            PG8_WAIT_V(8); PG8_WAIT_L(0); PG8_BAR; PG8_MMA(0, 0, At, B0); PG8_MMA(0, 1, At, B1); PG8_BAR; PG8_SCHED;
            PG8_LDA(At, 0, 1); PG8_STAGE(PG8_SB(0, 0), b2, voffB[0], voffB[1]); PG8_STAGE(PG8_SB(0, 1), b2 + hstepB, voffB[0], voffB[1]); PG8_STAGE(PG8_SA(0, 0), a2, x00, x01);
            PG8_WAIT_V(8); PG8_WAIT_L(0); PG8_BAR; PG8_MMA(1, 0, At, B0); PG8_MMA(1, 1, At, B1); PG8_BAR; PG8_SCHED;
            PG8_LDB(B0, 1, 0); PG8_LDB(B1, 1, 1); PG8_SCHED; PG8_LDA(At, 1, 0); PG8_STAGE(PG8_SA(0, 1), a2, x10, x11);
            PG8_WAIT_V(8); PG8_WAIT_L(0); PG8_BAR; PG8_MMA(0, 0, At, B0); PG8_MMA(0, 1, At, B1); PG8_BAR; PG8_SCHED;
            PG8_LDA(At, 1, 1); PG8_STAGE(PG8_SB(1, 0), b3, voffB[0], voffB[1]); PG8_STAGE(PG8_SB(1, 1), b3 + hstepB, voffB[0], voffB[1]); PG8_STAGE(PG8_SA(1, 0), a3, x00, x01);
            PG8_WAIT_V(8); PG8_WAIT_L(0); PG8_BAR; PG8_MMA(1, 0, At, B0); PG8_MMA(1, 1, At, B1); PG8_BAR; PG8_SCHED;
        }
        if constexpr (FP8) asm volatile("s_nop 15\n\ts_nop 15\n\ts_nop 7" ::: "memory");
        if (wr == 0) PG8_BAR;
        { Unit eu = cur; asm volatile("" : "+s"(eu.r0), "+s"(eu.c0), "+s"(eu.e));
          E(acc, eu, wr, wc, fr, fq); }
        if (!has_next) break;
#pragma unroll
        for (int a = 0; a < 2; ++a)
#pragma unroll
            for (int b = 0; b < 2; ++b)
#pragma unroll
                for (int m = 0; m < 4; ++m)
#pragma unroll
                    for (int n = 0; n < 2; ++n) acc[a][b][m][n] = (f32x4){0.f, 0.f, 0.f, 0.f};
        cur = nxt; cA = nA; cB = nB; ++ui;
        if constexpr (GATHER) {
#pragma unroll
            for (int h = 0; h < 2; ++h)
#pragma unroll
                for (int i = 0; i < 2; ++i) cvA[h][i] = nvA[h][i]; }
        if (wr == 1) PG8_BAR;
    }
    PG8_WAIT_V(0);
    PG8_BAR;
#undef PG8_SA
#undef PG8_SB
#undef PG8_STAGE
#undef PG8_LDA
#undef PG8_LD32
#undef PG8_LDB
#undef PG8_MMA
#undef PG8_CAT
#undef PG8_WAIT_V
#undef PG8_WAIT_L
#undef PG8_BAR
#undef PG8_SCHED
#undef PG8_GATHER
}
}
using pg8::Unit;

struct Params { const float* in[NIN]; float* out; unsigned char* ws; };
constexpr int LDS_PARAMS = LDS_BYTES - 1024 + 256;
__device__ __forceinline__ int opaque0() { int z; asm volatile("s_mov_b32 %0, 0" : "=s"(z)); return z; }
struct PL {
    LAS unsigned char* lds; int z; int w0;
    __device__ __forceinline__ unsigned long long word(int i) const { const LAS unsigned* w = (const LAS unsigned*)(lds + LDS_PARAMS) + 2 * i;
        const unsigned lo = __builtin_amdgcn_readfirstlane(w[0]), hi = __builtin_amdgcn_readfirstlane(w[1]); return ((unsigned long long)hi << 32) | lo; }
    __device__ __forceinline__ const float* in(int i) const { return (const float*)(__attribute__((address_space(1))) const float*)word(i); }
    __device__ __forceinline__ float* out() const { return (float*)(__attribute__((address_space(1))) float*)word(NIN); }
    __device__ __forceinline__ unsigned char* ws() const { return (unsigned char*)(__attribute__((address_space(1))) unsigned char*)word(NIN + 1); }
};

struct EpiBf16 {
    static constexpr bool PERM = true;
    bf16_t* O; int ldc; const float* bias; int bias_estride; float ascale = 1.0f;
    __device__ __forceinline__ void operator()(const f32x4 (&acc)[2][2][4][2], const Unit& u, int wr, int wc, int fr, int fq) const {
        const int row0 = u.r0 + wr * 64 + fr, col0 = u.c0 * 256 + wc * 32 + 8 * fq;
        f32x4 bv[2][2];
#pragma unroll
        for (int bj = 0; bj < 2; ++bj)
#pragma unroll
            for (int n = 0; n < 2; ++n) bv[bj][n] = bias ? *(const f32x4*)(bias + (size_t)u.e * bias_estride + col0 + bj * 128 + 4 * n) : (f32x4){0.f, 0.f, 0.f, 0.f};
#pragma unroll
        for (int ai = 0; ai < 2; ++ai)
#pragma unroll
            for (int m = 0; m < 4; ++m) { bf16_t* rowp = O + (size_t)(row0 + ai * 128 + m * 16) * ldc + col0;
#pragma unroll
                for (int bj = 0; bj < 2; ++bj) { const f32x4 v0 = acc[ai][bj][m][0] * ascale + bv[bj][0], v1 = acc[ai][bj][m][1] * ascale + bv[bj][1];
                    u32x4 w; w.x = cvt_pk_bf16(v0[0], v0[1]); w.y = cvt_pk_bf16(v0[2], v0[3]); w.z = cvt_pk_bf16(v1[0], v1[1]); w.w = cvt_pk_bf16(v1[2], v1[3]);
                    *(u32x4*)(rowp + bj * 128) = w; } }
    }
};
struct EpiFp8 {
    static constexpr bool PERM = true;
    unsigned char* O; int ldc; const float* bias; int bias_estride; float ascale;
    __device__ __forceinline__ void operator()(const f32x4 (&acc)[2][2][4][2], const Unit& u, int wr, int wc, int fr, int fq) const {
        const int row0 = u.r0 + wr * 64 + fr, col0 = u.c0 * 256 + wc * 32 + 8 * fq;
        f32x4 bv[2][2];
#pragma unroll
        for (int bj = 0; bj < 2; ++bj)
#pragma unroll
            for (int n = 0; n < 2; ++n) bv[bj][n] = *(const f32x4*)(bias + (size_t)u.e * bias_estride + col0 + bj * 128 + 4 * n);
#pragma unroll
        for (int ai = 0; ai < 2; ++ai)
#pragma unroll
            for (int m = 0; m < 4; ++m) { unsigned char* rowp = O + (size_t)(row0 + ai * 128 + m * 16) * ldc + col0;
#pragma unroll
                for (int bj = 0; bj < 2; ++bj) { const f32x4 v0 = acc[ai][bj][m][0] * ascale + bv[bj][0], v1 = acc[ai][bj][m][1] * ascale + bv[bj][1];
                    u32x2 q; q.x = pack4_fp8(v0[0], v0[1], v0[2], v0[3]); q.y = pack4_fp8(v1[0], v1[1], v1[2], v1[3]); *(u32x2*)(rowp + bj * 128) = q; } }
    }
};
__device__ __forceinline__ void epi_cols32(const f32x4 (&acc)[2][2][4][2], float* dst, const float* bias, int r0, int wr, int wc, int fr, int fq, float ascale) {
    if (wc != 0) return;
    const int row0 = r0 + wr * 64 + fr, c = 8 * fq;
    f32x4 b0 = (f32x4){0.f, 0.f, 0.f, 0.f}, b1 = b0;
    if (bias) { b0 = *(const f32x4*)(bias + c); b1 = *(const f32x4*)(bias + c + 4); }
#pragma unroll
    for (int ai = 0; ai < 2; ++ai)
#pragma unroll
        for (int m = 0; m < 4; ++m) { float* p = dst + (size_t)(row0 + ai * 128 + m * 16) * 32 + c;
            *(f32x4*)p = acc[ai][0][m][0] * ascale + b0; *(f32x4*)(p + 4) = acc[ai][0][m][1] * ascale + b1; }
}
struct EpiInProj {
    static constexpr bool PERM = true;
    bf16_t *ca, *cb, *z; float* gate; int f8 = 0;
    __device__ __forceinline__ void operator()(const f32x4 (&acc)[2][2][4][2], const Unit& u, int wr, int wc, int fr, int fq) const {
        const int ct = f8 ? u.c0 : u.c0 + 6; const float ascale = f8 ? 1.0f / W8_SCALE : 1.0f;
        if (ct == 14) { epi_cols32(acc, gate, nullptr, u.r0, wr, wc, fr, fq, 1.0f); return; }
        bf16_t* O; int ldc, c0;
        if (ct < 6) { O = ca; ldc = 1536; c0 = ct; } else if (ct < 10) { O = cb; ldc = 1024; c0 = ct - 6; } else { O = z; ldc = 1024; c0 = ct - 10; }
        const bool odd = (fr & 1) != 0;
        const int col = c0 * 256 + wc * 64 + (odd ? 32 : 0) + 8 * fq, rowb = u.r0 + wr * 64 + (fr & ~1);
#pragma unroll
        for (int ai = 0; ai < 2; ++ai)
#pragma unroll
            for (int m = 0; m < 4; ++m) { unsigned p0[4], p1[4], s0[4], s1[4];
#pragma unroll
                for (int n = 0; n < 2; ++n) { const f32x4 v0 = acc[ai][0][m][n] * ascale, v1 = acc[ai][1][m][n] * ascale;
                    p0[2 * n] = cvt_pk_bf16(v0[0], v0[1]); p0[2 * n + 1] = cvt_pk_bf16(v0[2], v0[3]); p1[2 * n] = cvt_pk_bf16(v1[0], v1[1]); p1[2 * n + 1] = cvt_pk_bf16(v1[2], v1[3]); }
#pragma unroll
                for (int i = 0; i < 4; ++i) { const unsigned x = odd ? p0[i] : p1[i]; const unsigned rcv = (unsigned)__builtin_amdgcn_update_dpp(0, (int)x, 0xB1, 0xF, 0xF, false);
                    s0[i] = odd ? rcv : p0[i]; s1[i] = odd ? p1[i] : rcv; }
                bf16_t* rp = O + (size_t)(rowb + ai * 128 + m * 16) * ldc + col;
                *(u32x4*)rp = (u32x4){s0[0], s0[1], s0[2], s0[3]}; *(u32x4*)(rp + ldc) = (u32x4){s1[0], s1[1], s1[2], s1[3]}; }
    }
};
struct EpiSwiGLU {
    static constexpr bool PERM = true;
    unsigned char* H; const float* bg; const float* bu;
    __device__ __forceinline__ void operator()(const f32x4 (&acc)[2][2][4][2], const Unit& u, int wr, int wc, int fr, int fq) const {
        const int row0 = u.r0 + wr * 64 + fr, colf = u.c0 * 128 + wc * 32 + 8 * fq;
        f32x4 gv[2], uv[2];
#pragma unroll
        for (int n = 0; n < 2; ++n) { gv[n] = *(const f32x4*)(bg + (size_t)u.e * 1024 + colf + 4 * n); uv[n] = (*(const f32x4*)(bu + (size_t)u.e * 1024 + colf + 4 * n) + 1.0f) * H8_SCALE; }
#pragma unroll
        for (int ai = 0; ai < 2; ++ai)
#pragma unroll
            for (int m = 0; m < 4; ++m) { float o[8];
#pragma unroll
                for (int n = 0; n < 2; ++n) { const f32x4 g = acc[ai][0][m][n] * (1.0f / W8_SCALE) + gv[n], l = acc[ai][1][m][n] * (H8_SCALE / W8_SCALE) + uv[n];
#pragma unroll
                    for (int j = 0; j < 4; ++j) { const float gl = fminf(g[j], 7.0f), lp = fminf(fmaxf(l[j], -6.0f * H8_SCALE), 8.0f * H8_SCALE);
                        o[4 * n + j] = gl * __builtin_amdgcn_rcpf(1.0f + __builtin_amdgcn_exp2f(gl * (-1.702f * 1.4426950408889634f))) * lp; } }
                u32x2 q; q.x = pack4_fp8(o[0], o[1], o[2], o[3]); q.y = pack4_fp8(o[4], o[5], o[6], o[7]);
                *(u32x2*)(H + blk_off8(row0 + ai * 128 + m * 16, colf)) = q; }
    }
};
struct EpiGLU {
    static constexpr bool PERM = true;
    bf16_t* O;
    __device__ __forceinline__ void operator()(const f32x4 (&acc)[2][2][4][2], const Unit& u, int wr, int wc, int fr, int fq) const {
        const int row0 = u.r0 + wr * 64 + fr, colf = u.c0 * 128 + wc * 32 + 8 * fq;
#pragma unroll
        for (int ai = 0; ai < 2; ++ai)
#pragma unroll
            for (int m = 0; m < 4; ++m) { float o[8];
#pragma unroll
                for (int n = 0; n < 2; ++n) { const f32x4 a = acc[ai][0][m][n], b = acc[ai][1][m][n];
#pragma unroll
                    for (int j = 0; j < 4; ++j) o[4 * n + j] = a[j] * (1.0f / W8_SCALE) * sigmoidf_(b[j] * (1.0f / W8_SCALE)); }
                *(u32x4*)(O + (size_t)(row0 + ai * 128 + m * 16) * 1024 + colf) = pack8(o); }
    }
};
__device__ __forceinline__ void s5_rowmap(int r, int& crow, int& t) {
    if (r < TL) { const int b = r >> 11, l = r & 2047; crow = b * 64 + (l >> 5); t = l & 31; }
    else { const int rc = r - TL, b = rc >> 8, l = rc & 255; crow = 2048 + b * 8 + (l >> 5); t = l & 31; }
}
struct EpiS5U {
    static constexpr bool PERM = true;
    bf16_t* UL;
    __device__ __forceinline__ void operator()(const f32x4 (&acc)[2][2][4][2], const Unit& u, int wr, int wc, int fr, int fq) const {
        const int row0 = u.r0 + wr * 64 + fr, col0 = u.c0 * 256 + wc * 32 + 8 * fq;
#pragma unroll
        for (int ai = 0; ai < 2; ++ai)
#pragma unroll
            for (int m = 0; m < 4; ++m) { int crow, t; s5_rowmap(row0 + ai * 128 + m * 16, crow, t);
#pragma unroll
                for (int bj = 0; bj < 2; ++bj) { const int c = col0 + bj * 128, g = c >> 4; const f32x4 v0 = acc[ai][bj][m][0] * (1.0f / W8_SCALE), v1 = acc[ai][bj][m][1] * (1.0f / W8_SCALE);
                    u32x4 w; w.x = cvt_pk_bf16(v0[0], v0[1]); w.y = cvt_pk_bf16(v0[2], v0[3]); w.z = cvt_pk_bf16(v1[0], v1[1]); w.w = cvt_pk_bf16(v1[2], v1[3]);
                    *(u32x4*)(UL + ((size_t)g * S5ROWS + crow) * S5K + t * 16 + (c & 15)) = w; } }
    }
};
struct EpiS5S {
    static constexpr bool PERM = false;
    float* S;
    __device__ __forceinline__ void operator()(const f32x4 (&acc)[2][2][4][2], const Unit& u, int wr, int wc, int fr, int fq) const {
        const int row0 = u.r0 + wr * 64 + fr, col0 = wc * 32 + 4 * fq;
#pragma unroll
        for (int ai = 0; ai < 2; ++ai)
#pragma unroll
            for (int m = 0; m < 4; ++m) { float* rowp = S + ((size_t)u.e * S5ROWS + row0 + ai * 128 + m * 16) * 256 + col0;
#pragma unroll
                for (int bj = 0; bj < 2; ++bj)
#pragma unroll
                    for (int n = 0; n < 2; ++n) *(f32x4*)(rowp + bj * 128 + n * 16) = acc[ai][bj][m][n]; }
    }
};
__device__ __forceinline__ float gelu_tanh(float x) { const float u = 0.7978845608f * (x + 0.044715f * x * x * x); return x * sigmoidf_(2.0f * u); }
struct EpiS5Y {
    static constexpr bool PERM = true;
    unsigned char* OG;
    __device__ __forceinline__ void operator()(const f32x4 (&acc)[2][2][4][2], const Unit& u, int wr, int wc, int fr, int fq) const {
        const int row0 = u.r0 + wr * 64 + fr, n0 = u.c0 * 256 + wc * 32 + 8 * fq;
#pragma unroll
        for (int ai = 0; ai < 2; ++ai)
#pragma unroll
            for (int m = 0; m < 4; ++m) { const int crow = row0 + ai * 128 + m * 16;
#pragma unroll
                for (int bj = 0; bj < 2; ++bj) { const int n = n0 + bj * 128, t = n >> 4, h0 = n & 15; float o[8];
#pragma unroll
                    for (int j = 0; j < 4; ++j) { o[j] = gelu_tanh(acc[ai][bj][m][0][j]); o[4 + j] = gelu_tanh(acc[ai][bj][m][1][j]); }
                    u32x2 q; q.x = pack4_fp8(o[0], o[1], o[2], o[3]); q.y = pack4_fp8(o[4], o[5], o[6], o[7]);
                    *(u32x2*)(OG + ((size_t)crow * 32 + t) * 1024 + u.e * 16 + h0) = q; } }
    }
};

struct DenseSched {
    pg8::TileOrder T; const char* A; const char* B; size_t astep, bstep;
    __device__ void init(const void* A_, const void* B_, int nM, int nN, int lda, int ldb, int z, int es = 2) { T.init(nM, nN, (int)gridDim.x + z, (int)blockIdx.x + z); A = (const char*)A_; B = (const char*)B_; astep = (size_t)256 * lda * es; bstep = (size_t)256 * ldb * es; }
    __device__ __forceinline__ bool next(int i, Unit& u) const { int pm, pn; if (!T.next(i, pm, pn)) return false;
        u.A = A + pm * astep; u.B = B + pn * bstep; u.gat = nullptr; u.nvalid = 256; u.r0 = pm * 256; u.c0 = pn; u.e = 0; return true; }
};
struct GroupSched {
    const char* A; const char* B; size_t agstep, bgstep, astep, bstep; int nG, nM, nN, G, c;
    __device__ __forceinline__ bool next(int i, Unit& u) const { const long L = (long)i * G + c; if (L >= (long)nG * nM * nN) return false;
        const int per = nM * nN, g = (int)(L / per), rem = (int)(L % per), pm = rem / nN, pn = rem % nN;
        u.A = A + g * agstep + pm * astep; u.B = B + g * bgstep + pn * bstep; u.gat = nullptr; u.nvalid = 256; u.r0 = pm * 256; u.c0 = pn; u.e = g; return true; }
};
struct MoeSched {
    const LAS int* tp; const LAS int* cnt; const LAS int* te  ; int NC, ntiles; bool gather;
    const char* A; const char* B; size_t bestep  ; const int* tok; int CT, G, c; int rowbytes  ; int xrot  ;
    __device__ __forceinline__ bool next(int i, Unit& u) const {
        int rt, ct;
        if (G == 256) { const int xcd = ((c & 7) + 8 - xrot) & 7, j = c >> 3, RPS = 32 / NC; rt = (i * 8 + xcd) * RPS + j / NC; ct = j % NC; }
        else { const long L = (long)i * G + c; rt = (int)(L / NC); ct = (int)(L % NC); }
        if (rt >= ntiles) return false;
        const int e = __builtin_amdgcn_readfirstlane(te[rt]), lt = rt - __builtin_amdgcn_readfirstlane(tp[e]);
        u.e = e; u.r0 = rt * 256; u.c0 = ct; u.nvalid = cnt[e] - lt * 256; u.gat = tok + (size_t)e * CT + lt * 256;
        u.A = gather ? A : A + (size_t)rt * 256 * rowbytes; u.B = B + (size_t)e * bestep + (size_t)ct * 256 * rowbytes; return true;
    }
};

#define TID (P.w0 * 64 + lane_id(P.z))
#define BID ((int)blockIdx.x + P.z)
#define GDIM ((int)gridDim.x + P.z)
#define wave_id() __builtin_amdgcn_readfirstlane(TID >> 6)
__device__ __forceinline__ bf16_t* hbrow(unsigned char* ws, int r) { return r < TL ? (bf16_t*)(ws + WS_HBL) + (size_t)r * D : (bf16_t*)(ws + WS_HBC) + (size_t)(r - TL) * D; }
__device__ __forceinline__ const float* xrow(const float* x, const float* ctx, int r) { return r < TL ? x + (size_t)r * D : ctx + (size_t)(r - TL) * D; }
__device__ __forceinline__ const float* modp(const unsigned char* ws, int layer, int r, int which) { const int mb = r < TL ? (r >> 11) : 32; return (const float*)(ws + WS_MOD) + ((size_t)(layer * 33 + mb) * 6 + which) * D; }

__device__ __forceinline__ void phase_mod(const PL& P, LAS unsigned char* lds) {
    LAS float* sT = (LAS float*)lds; LAS float* red = (LAS float*)(lds + 17 * 1024 * 4);
    const int tid = TID, lane = tid & 63, wave = wave_id();
    float* MOD = (float*)(P.ws() + WS_MOD); const float* cc = P.in(IC); const float* cctx = P.in(ICCTX); const float* adaw = P.in(IADAW); const float* adab = P.in(IADAB);
    for (int rg = 0; rg < 2; ++rg) {
        const int r0 = rg * 17, nr = rg == 0 ? 17 : 16;
        __syncthreads();
        for (int i = tid; i < nr * 1024; i += 512) { const int r = r0 + (i >> 10), k = i & 1023; const float x = r < 32 ? cc[r * 1024 + k] : cctx[k]; sT[i] = x / (1.0f + expf(-x)); }
        __syncthreads();
        for (int cb = BID; cb < 256; cb += GDIM) {
            const int col0 = cb * 48, layer = col0 / 6144, cl0 = col0 % 6144;
            const float* W = adaw + (size_t)layer * 1024 * 6144 + cl0;
            float acc[17];
#pragma unroll
            for (int r = 0; r < 17; ++r) acc[r] = 0.f;
            if (lane < 48) {
#pragma unroll 1
                for (int k = wave * 128; k < wave * 128 + 128; k += 16) {
                    float wk[16];
#pragma unroll
                    for (int q = 0; q < 16; ++q) wk[q] = W[(size_t)(k + q) * 6144 + lane];
#pragma unroll
                    for (int q = 0; q < 16; q += 4)
#pragma unroll
                        for (int r = 0; r < 17; ++r) { if (r < nr) { const f32x4 s4 = *(const LAS f32x4*)(sT + r * 1024 + k + q); PFMA(acc[r], s4.x, wk[q]); PFMA(acc[r], s4.y, wk[q + 1]); PFMA(acc[r], s4.z, wk[q + 2]); PFMA(acc[r], s4.w, wk[q + 3]); }
                            if (r == 16) asm volatile("" ::: "memory"); }
                }
#pragma unroll
                for (int r = 0; r < 17; ++r) red[(wave * 17 + r) * 48 + lane] = acc[r];
            }
            __syncthreads();
            for (int o = tid; o < nr * 48; o += 512) { const int r = o / 48, c = o % 48; float s = 0.f;
#pragma unroll
                for (int w = 0; w < 8; ++w) s += red[(w * 17 + r) * 48 + c];
                MOD[(size_t)(layer * 33 + r0 + r) * 6144 + cl0 + c] = s + adab[layer * 6144 + cl0 + c]; }
            __syncthreads();
        }
    }
}

__device__ __forceinline__ void cvt_item(const float* W, int K, int N, bf16_t* WT, int drow0, LAS float* scr, int kb, int nb, int lane, bool blk = false) {
    const int k0 = 64 * kb, n0 = 32 * nb;
#pragma unroll 8
    for (int i = 0; i < 32; ++i) { const int kk = 2 * i + (lane >> 5); scr[kk * 33 + (lane & 31)] = W[(size_t)(k0 + kk) * N + n0 + (lane & 31)]; }
    LDS_WAIT(); asm volatile("" ::: "memory");
    const int c = lane & 7;
#pragma unroll
    for (int j = 0; j < 4; ++j) { const int n = (lane >> 3) + 8 * j; const LAS float* s = scr + (8 * c) * 33 + n;
        u32x4 o; o.x = cvt_pk_bf16(s[0 * 33], s[1 * 33]); o.y = cvt_pk_bf16(s[2 * 33], s[3 * 33]); o.z = cvt_pk_bf16(s[4 * 33], s[5 * 33]); o.w = cvt_pk_bf16(s[6 * 33], s[7 * 33]);
        *(u32x4*)(WT + (blk ? blk_off(inproj_row(drow0 + n), k0 + 8 * c) : (size_t)(drow0 + n) * K + k0 + 8 * c)) = o; }
    LDS_WAIT(); asm volatile("" ::: "memory");
}
__device__ __forceinline__ void cvt_item8(const float* W, int K, int N, unsigned char* WT, int drow0, LAS float* scr, int kb, int nb, int lane, bool blkperm = false) {
    const int k0 = 64 * kb, n0 = 32 * nb;
#pragma unroll 8
    for (int i = 0; i < 32; ++i) { const int kk = 2 * i + (lane >> 5); scr[kk * 33 + (lane & 31)] = W[(size_t)(k0 + kk) * N + n0 + (lane & 31)]; }
    LDS_WAIT(); asm volatile("" ::: "memory");
    const int n = lane >> 1, kh = (lane & 1) * 32; const LAS float* sp = scr + kh * 33 + n; unsigned w[8];
#pragma unroll
    for (int q = 0; q < 8; ++q) w[q] = pack4_fp8(sp[(4 * q) * 33] * W8_SCALE, sp[(4 * q + 1) * 33] * W8_SCALE, sp[(4 * q + 2) * 33] * W8_SCALE, sp[(4 * q + 3) * 33] * W8_SCALE);
    unsigned char* dst = WT + (blkperm ? blk_off8(inproj_row(drow0 + n), k0 + kh) : (size_t)(drow0 + n) * K + k0 + kh);
    *(u32x4*)dst = (u32x4){w[0], w[1], w[2], w[3]}; *(u32x4*)(dst + 16) = (u32x4){w[4], w[5], w[6], w[7]};
    LDS_WAIT(); asm volatile("" ::: "memory");
}
__device__ __forceinline__ void cvt_matrix_item(const float* W, int N, bf16_t* WT, int mode, LAS float* scr, int item, int lane, bool f8 = false, bool blk = false) {
    const int nblk = N / 32, kb = item / nblk, nb = item % nblk, n0 = nb * 32;
    const int drow0 = mode == 0 ? n0 : ((n0 >> 7) * 256 + (n0 & 127) + (mode == 2 ? 128 : 0));
    if (f8) cvt_item8(W, 1024, N, (unsigned char*)WT, drow0, scr, kb, nb, lane); else cvt_item(W, 1024, N, WT, drow0, scr, kb, nb, lane, blk);
}
__device__ __forceinline__ void phase_cvt_dense(const PL& P, LAS unsigned char* lds) {
    const int lane = TID & 63, wave = wave_id(), gw = BID * 8 + wave, NGW = GDIM * 8;
    LAS float* scr = (LAS float*)(lds + wave * 16384);
    constexpr int I_IN = 16 * 113, I_SQ = 16 * 32, I_R = 16;
    constexpr int NIT = I_IN + 4 * I_SQ + 2 * I_R;
    unsigned char* ws = P.ws(); const float* w_in = P.in(IHYIN); const float* w_out = P.in(IHYOUT); const float* w_s5 = P.in(IS5IN); const float* w_ga = P.in(IGLUA); const float* w_gb = P.in(IGLUB); const float* w_r = P.in(IRW);
    for (int it = gw; it < NIT; it += NGW) { int r = it;
        if (r < I_IN) { const int kb = r / 113, nb = r % 113, ct = nb >> 3;
            if (ct < 6) cvt_item8(w_in, 1024, INW, ws + WS_WIN8, nb * 32, scr, kb, nb, lane, true);
            else cvt_item(w_in, 1024, INW, (bf16_t*)(ws + WS_WIN), nb * 32 - 1536, scr, kb, nb, lane, true);
            continue; } r -= I_IN;
        if (r < I_SQ) { cvt_matrix_item(w_out, 1024, (bf16_t*)(ws + WS_WOUT), 0, scr, r, lane, true); continue; } r -= I_SQ;
        if (r < I_SQ) { cvt_matrix_item(w_s5, 1024, (bf16_t*)(ws + WS_WS5IN), 0, scr, r, lane, true); continue; } r -= I_SQ;
        if (r < I_SQ) { cvt_matrix_item(w_ga, 1024, (bf16_t*)(ws + WS_WGLU), 1, scr, r, lane, true); continue; } r -= I_SQ;
        if (r < I_SQ) { cvt_matrix_item(w_gb, 1024, (bf16_t*)(ws + WS_WGLU), 2, scr, r, lane, true); continue; } r -= I_SQ;
        const int l = r / I_R; r -= l * I_R;
        cvt_matrix_item(w_r + (size_t)l * 1024 * 32, 32, (bf16_t*)(ws + WS_RB) + (size_t)l * 256 * 1024, 0, scr, r, lane);
    }
    const int gt = BID * 512 + TID, NT = GDIM * 512; const u32x4 z = (u32x4){0u, 0u, 0u, 0u};
    for (int i = gt; i < (INWP - INW) * 128; i += NT) *(u32x4*)((bf16_t*)(ws + WS_WIN) + blk_off(inproj_row(2048 + 32 + (i >> 7)), (i & 127) * 8)) = z;
    for (int i = gt; i < 2 * 224 * 128; i += NT) { const int l = i / (224 * 128), j = i % (224 * 128); *((u32x4*)((bf16_t*)(ws + WS_RB) + ((size_t)l * 256 + 32) * 1024) + j) = z; }
}
struct CvtJob { const float* W; unsigned char* WT; int drow0, k0, n0; };
__device__ __forceinline__ void cvt_load128(const CvtJob& j, float (&v)[32], int tid) {
#pragma unroll
    for (int u = 0; u < 8; ++u) { const int idx = tid + 512 * u, n = idx & 127, kq = idx >> 7; const float* src = j.W + (size_t)(j.k0 + 4 * kq) * 1024 + j.n0 + n;
#pragma unroll
        for (int r = 0; r < 4; ++r) v[4 * u + r] = src[(size_t)r * 1024]; }
}
__device__ __forceinline__ void cvt_store128(const CvtJob& j, const float (&v)[32], LAS unsigned* T32, int tid) {
#pragma unroll
    for (int u = 0; u < 8; ++u) { const int idx = tid + 512 * u, n = idx & 127, kq = idx >> 7;
        T32[n * 33 + kq] = pack4_fp8(v[4 * u] * W8_SCALE, v[4 * u + 1] * W8_SCALE, v[4 * u + 2] * W8_SCALE, v[4 * u + 3] * W8_SCALE); }
    LDS_BAR();
#pragma unroll
    for (int u = 0; u < 2; ++u) { const int idx = tid + 512 * u, n = idx >> 3, q = (idx & 7) * 4; const LAS unsigned* sp = T32 + n * 33 + q;
        u32x4 w; w.x = sp[0]; w.y = sp[1]; w.z = sp[2]; w.w = sp[3];
        *(u32x4*)(j.WT + blk_off8(j.drow0 + n, j.k0 + 4 * q)) = w; }
    LDS_BAR();
}
__device__ __forceinline__ CvtJob cvt_moe_job(int it, int layer, const float* wg, const float* wu, const float* wd, unsigned char* WGU, unsigned char* WDN) {
    const int mat = it >> 6, r = it & 63, e = mat / 3, w = mat % 3, kb = r >> 3, nb = r & 7; const size_t eo = ((size_t)layer * 32 + e) * 1024 * 1024; CvtJob j;
    j.W = (w == 0 ? wg : (w == 1 ? wu : wd)) + eo; j.WT = w == 2 ? WDN + (size_t)e * 1024 * 1024 : WGU + (size_t)e * 2048 * 1024; j.drow0 = w == 2 ? nb * 128 : nb * 256 + (w == 1 ? 128 : 0); j.k0 = kb * 128; j.n0 = nb * 128; return j;
}
__device__ __forceinline__ void phase_cvt_moe(const PL& P, LAS unsigned char* lds, int layer) {
    const int tid = TID;
    LAS unsigned* T = (LAS unsigned*)lds;
    unsigned char* WGU = P.ws() + WS_WMOE; unsigned char* WDN = WGU + (size_t)32 * 2048 * 1024; const float* wg = P.in(IWG); const float* wu = P.in(IWU); const float* wd = P.in(IWD);
    __syncthreads();
    int it = BID;
    if (it < 96 * 64) {
        float v[32], vn[32]; CvtJob cur = cvt_moe_job(it, layer, wg, wu, wd, WGU, WDN); cvt_load128(cur, v, tid);
        for (;;) { const int nx = it + GDIM; const bool has = nx < 96 * 64; CvtJob nj = cur; if (has) { nj = cvt_moe_job(nx, layer, wg, wu, wd, WGU, WDN); cvt_load128(nj, vn, tid); }
            cvt_store128(cur, v, T, tid);
            if (!has) break;
#pragma unroll
            for (int u = 0; u < 32; ++u) v[u] = vn[u];
            cur = nj; it = nx; }
    }
}

__device__ __forceinline__ void phase_s5_tables(const PL& P, LAS unsigned char* lds) {
    LAS float* ar = (LAS float*)lds; LAS float* ai = ar + 64; LAS float* fre = ai + 64; LAS float* fim = fre + 64;
    LAS float* Bb = fim + 64;
    LAS float* Cc = Bb + 2048;
    LAS float* lj = Cc + 2048;
    const int tid = TID;
    float* LP = (float*)(P.ws() + WS_LP); float* BB = (float*)(P.ws() + WS_BB); float* KT = (float*)(P.ws() + WS_KT);
    const float* i_ls = P.in(IS5LS); const float* i_are = P.in(IS5ARE); const float* i_aim = P.in(IS5AIM); const float* i_bre = P.in(IS5BRE); const float* i_bim = P.in(IS5BIM); const float* i_cre = P.in(IS5CRE); const float* i_cim = P.in(IS5CIM);
    for (int it = BID; it < 128; it += GDIM) { const int d = it >> 6, g = it & 63, dg = d * 64 + g;
        __syncthreads();
        if (tid < 64) { const float step = expf(i_ls[dg]), are = i_are[dg * 64 + tid], aim = i_aim[dg * 64 + tid];
            const float a_r = are * step, a_i = aim * step, mag = expf(a_r); float sn, cs; sincosf(a_i, &sn, &cs); const float lr = mag * cs, li = mag * sn, den = are * are + aim * aim;
            ar[tid] = a_r; ai[tid] = a_i; fre[tid] = ((lr - 1.0f) * are + li * aim) / den; fim[tid] = (li * are - (lr - 1.0f) * aim) / den; }
        __syncthreads();
        for (int i = tid; i < 1024; i += 512) { const int p = i >> 4; const float br = i_bre[(size_t)dg * 1024 + i], bi = i_bim[(size_t)dg * 1024 + i];
            const float re = fre[p] * br - fim[p] * bi, im = fre[p] * bi + fim[p] * br; Bb[2 * i] = re; Bb[2 * i + 1] = im; BB[((size_t)dg * 1024 + i) * 2] = re; BB[((size_t)dg * 1024 + i) * 2 + 1] = im;
            Cc[2 * i] = i_cre[(size_t)dg * 1024 + i]; Cc[2 * i + 1] = i_cim[(size_t)dg * 1024 + i]; }
        __syncthreads();
        if (tid < 64) {
            for (int j = 0; j <= 32; ++j) { const float m = expf(ar[tid] * (float)j); float sn, cs; sincosf(ai[tid] * (float)j, &sn, &cs);
                LP[(((size_t)dg * 33 + j) * 64 + tid) * 2] = m * cs; LP[(((size_t)dg * 33 + j) * 64 + tid) * 2 + 1] = m * sn; }
            { const float m = expf(ar[tid]); float sn, cs; sincosf(ai[tid], &sn, &cs); lj[2 * tid] = m * cs; lj[2 * tid + 1] = m * sn; }
        }
        __syncthreads();
        if (tid < 256) { const int h = tid >> 4, h2 = tid & 15; float acc[32];
#pragma unroll
            for (int j = 0; j < 32; ++j) acc[j] = 0.f;
            for (int p = 0; p < 64; ++p) { const float cr = Cc[2 * (h * 64 + p)], ci = Cc[2 * (h * 64 + p) + 1], br = Bb[2 * (p * 16 + h2)], bi = Bb[2 * (p * 16 + h2) + 1], lr = lj[2 * p], li = lj[2 * p + 1];
                float zr = cr * br - ci * bi, zi = cr * bi + ci * br;
#pragma unroll
                for (int j = 0; j < 32; ++j) { acc[j] += zr; const float nr = zr * lr - zi * li, ni = zr * li + zi * lr; zr = nr; zi = ni; } }
#pragma unroll
            for (int j = 0; j < 32; ++j) KT[(((size_t)g * 2 + d) * 32 + j) * 256 + tid] = acc[j]; }
    }
}
__device__ __forceinline__ void phase_s5_mats(const PL& P) {
    unsigned char* ws = P.ws(); const float* i_d = P.in(IS5D); const float* i_cre = P.in(IS5CRE); const float* i_cim = P.in(IS5CIM);
    const float* LP = (const float*)(ws + WS_LP); const float* BB = (const float*)(ws + WS_BB); const float* KT = (const float*)(ws + WS_KT);
    bf16_t* MPm = (bf16_t*)(ws + WS_MP); bf16_t* Em = (bf16_t*)(ws + WS_E);
    const int gt = BID * 512 + TID, NT = GDIM * 512;
    for (int idx = gt; idx < 64 * 512 * 96; idx += NT) { const int k8 = idx % 96, n = (idx / 96) & 511, g = idx / (96 * 512), t = n >> 4, h = n & 15; float v[8];
        if (k8 < 64) { const int s = k8 >> 1, h0 = (k8 & 1) * 8;
#pragma unroll
            for (int i = 0; i < 8; ++i) v[i] = 0.f;
            if (s <= t) { const float* kp = KT + (((size_t)g * 2 + 0) * 32 + (t - s)) * 256 + h * 16 + h0;
#pragma unroll
                for (int i = 0; i < 8; ++i) v[i] += kp[i]; }
            if (s >= t) { const float* kp = KT + (((size_t)g * 2 + 1) * 32 + (s - t)) * 256 + h * 16 + h0;
#pragma unroll
                for (int i = 0; i < 8; ++i) v[i] += kp[i]; }
            if (s == t && (h >> 3) == (k8 & 1)) v[h & 7] += i_d[g * 16 + h];
        } else { const int q = (k8 - 64) * 8, seg = q >> 6, p0 = q & 63, d = seg >> 1, im = seg & 1, e = d == 0 ? t + 1 : 32 - t, dg = d * 64 + g;
#pragma unroll
            for (int i = 0; i < 8; ++i) { const int p = p0 + i; const float cr = i_cre[(size_t)dg * 1024 + h * 64 + p], ci = i_cim[(size_t)dg * 1024 + h * 64 + p];
                const float lr = LP[(((size_t)dg * 33 + e) * 64 + p) * 2], li = LP[(((size_t)dg * 33 + e) * 64 + p) * 2 + 1];
                v[i] = im ? -(cr * li + ci * lr) : (cr * lr - ci * li); } }
        *(u32x4*)(MPm + ((size_t)g * 512 + n) * S5K + k8 * 8) = pack8(v); }
    for (int idx = gt; idx < 64 * 256 * 64; idx += NT) { const int k8 = idx & 63, n = (idx >> 6) & 255, g = idx >> 14, seg = n >> 6, p = n & 63, d = seg >> 1, im = seg & 1, s = k8 >> 1, h0 = (k8 & 1) * 8, e = d == 0 ? 31 - s : s, dg = d * 64 + g;
        const float lr = LP[(((size_t)dg * 33 + e) * 64 + p) * 2], li = LP[(((size_t)dg * 33 + e) * 64 + p) * 2 + 1]; float v[8];
#pragma unroll
        for (int i = 0; i < 8; ++i) { const float br = BB[((size_t)dg * 1024 + p * 16 + h0 + i) * 2], bi = BB[((size_t)dg * 1024 + p * 16 + h0 + i) * 2 + 1]; v[i] = im ? (lr * bi + li * br) : (lr * br - li * bi); }
        *(u32x4*)(Em + ((size_t)g * 256 + n) * 512 + k8 * 8) = pack8(v); }
}

__device__ __forceinline__ void norm_mod_row(const float (&x)[16], const float* w, const float* shift, const float* scale, bf16_t* dst, int lane, unsigned char* dst8 = nullptr) {
    float ss = 0.f;
#pragma unroll
    for (int i = 0; i < 16; ++i) ss += x[i] * x[i];
    const float rs = rsqrtf(wave_sum(ss) * (1.0f / 1024.0f) + RMS_EPS);
    float wv[16], sh[16], sc[16], o[16]; ld_row_f32(w, lane, wv); ld_row_f32(shift, lane, sh); ld_row_f32(scale, lane, sc);
#pragma unroll
    for (int i = 0; i < 16; ++i) o[i] = x[i] * rs * wv[i] * (1.0f + sc[i]) + sh[i];
    if (dst) st_row_bf16(dst, lane, o);
    if (dst8) {
#pragma unroll
        for (int j = 0; j < 2; ++j) { u32x2 q; q.x = pack4_fp8(o[8 * j], o[8 * j + 1], o[8 * j + 2], o[8 * j + 3]); q.y = pack4_fp8(o[8 * j + 4], o[8 * j + 5], o[8 * j + 6], o[8 * j + 7]); *(u32x2*)(dst8 + 8 * lane + 512 * j) = q; } }
}
__device__ __forceinline__ void norm_mod_pre(const float (&x)[16], const float (&wv)[16], const float (&sh)[16], const float (&sc)[16], bf16_t* dst, int lane, unsigned char* dst8) {
    float ss = 0.f;
#pragma unroll
    for (int i = 0; i < 16; ++i) ss += x[i] * x[i];
    const float rs = rsqrtf(wave_sum(ss) * (1.0f / 1024.0f) + RMS_EPS); float o[16];
#pragma unroll
    for (int i = 0; i < 16; ++i) o[i] = x[i] * rs * wv[i] * (1.0f + sc[i]) + sh[i];
    if (dst) st_row_bf16(dst, lane, o);
    if (dst8) {
#pragma unroll
        for (int j = 0; j < 2; ++j) { u32x2 q; q.x = pack4_fp8(o[8 * j], o[8 * j + 1], o[8 * j + 2], o[8 * j + 3]); q.y = pack4_fp8(o[8 * j + 4], o[8 * j + 5], o[8 * j + 6], o[8 * j + 7]); *(u32x2*)(dst8 + 8 * lane + 512 * j) = q; } }
}
__device__ __forceinline__ void norm_mod_blk(const float (&x)[16], const float (&wv)[16], const float (&sh)[16], const float (&sc)[16], bf16_t* base, unsigned char* base8, int r, int lane) {
    float ss = 0.f;
#pragma unroll
    for (int i = 0; i < 16; ++i) ss += x[i] * x[i];
    const float rs = rsqrtf(wave_sum(ss) * (1.0f / 1024.0f) + RMS_EPS); float o[16];
#pragma unroll
    for (int i = 0; i < 16; ++i) o[i] = x[i] * rs * wv[i] * (1.0f + sc[i]) + sh[i];
#pragma unroll
    for (int j = 0; j < 2; ++j) *(u32x4*)(base + blk_off(r, 8 * lane + 512 * j)) = pack8(&o[8 * j]);
#pragma unroll
    for (int j = 0; j < 2; ++j) { u32x2 q; q.x = pack4_fp8(o[8 * j], o[8 * j + 1], o[8 * j + 2], o[8 * j + 3]); q.y = pack4_fp8(o[8 * j + 4], o[8 * j + 5], o[8 * j + 6], o[8 * j + 7]); *(u32x2*)(base8 + blk_off8(r, 8 * lane + 512 * j)) = q; }
}
__device__ __forceinline__ void phase_pre0(const PL& P) {
    const int lane = TID & 63, gw = BID * 8 + wave_id(), NGW = GDIM * 8;
    unsigned char* ws = P.ws(); const float* xin = P.in(IX); const float* cin = P.in(ICTX); const float* nw = P.in(IMNPRE);
    bf16_t* A0 = (bf16_t*)(ws + WS_R2); unsigned char* A08 = ws + WS_A2Q;
    float wv[16]; ld_row_f32(nw, lane, wv);
    for (int r = gw; r < TT; r += 2 * NGW) { const int r2 = r + NGW; const bool has2 = r2 < TT;
        float xa[16], sha[16], sca[16], xb[16], shb[16], scb[16];
        ld_row_f32(xrow(xin, cin, r), lane, xa); ld_row_f32(modp(ws, 0, r, 0), lane, sha); ld_row_f32(modp(ws, 0, r, 1), lane, sca);
        if (has2) { ld_row_f32(xrow(xin, cin, r2), lane, xb); ld_row_f32(modp(ws, 0, r2, 0), lane, shb); ld_row_f32(modp(ws, 0, r2, 1), lane, scb); }
        norm_mod_blk(xa, wv, sha, sca, A0, A08, r, lane);
        if (has2) norm_mod_blk(xb, wv, shb, scb, A0, A08, r2, lane); }
}

template <int I0, int NI>
__device__ __forceinline__ void conv_finish(float (&acc)[NI][8], int r, int lane, const LAS float* cbias, float gc0, float gc1, unsigned char* ws) {
    static_assert(NI == 1, "one chunk per pass");
#pragma unroll
    for (int j = 0; j < 8; ++j) { float a = acc[0][j]; if (I0 >= 3) a += cbias[8 * (lane + 64 * (I0 - 3)) + j]; acc[0][j] = siluf(a); }
    if (I0 < 2) { float ss = 0.f;
#pragma unroll
        for (int j = 0; j < 8; ++j) ss += acc[0][j] * acc[0][j];
        ss += __shfl_xor(ss, 1); ss += __shfl_xor(ss, 2); ss += __shfl_xor(ss, 4); ss += __shfl_xor(ss, 8);
        const float sc = rsqrtf(ss + RMS_EPS);
#pragma unroll
        for (int j = 0; j < 8; ++j) acc[0][j] *= sc; }
    if (I0 < 4) { bf16_t* dst = (bf16_t*)(ws + (I0 == 0 ? WS_Q : (I0 == 1 ? WS_K : (I0 == 2 ? WS_V : WS_XS)))); *(u32x4*)(dst + (size_t)r * 512 + 8 * lane) = pack8(acc[0]); }
    else {
        bf16_t* BMm = (bf16_t*)(ws + WS_BM); bf16_t* CMm = (bf16_t*)(ws + WS_CM);
        const float* GATE = (const float*)(ws + WS_GATE); float* G = (float*)(ws + WS_GPOST); float* BETA = G + (size_t)TT * 8; float* DT = BETA + (size_t)TT * 8; float* DA = DT + (size_t)TT * 16;
        if (lane < 32) *(u32x4*)(BMm + (size_t)r * 256 + 8 * lane) = pack8(acc[0]); else *(u32x4*)(CMm + (size_t)r * 256 + 8 * (lane - 32)) = pack8(acc[0]);
        if (lane < 32) { const float raw = GATE[(size_t)r * 32 + lane];
            if (lane < 8) { G[(size_t)r * 8 + lane] = gc0 * softplusf_(raw + gc1); }
            else if (lane < 16) { BETA[(size_t)r * 8 + lane - 8] = 1.0f / (1.0f + expf(-raw)); }
            else { const int j = lane - 16; const float dt = softplusf_(raw + gc1); DT[(size_t)r * 16 + j] = dt; DA[(size_t)r * 16 + j] = gc0 * dt; } }
    }
}
template <int I>
__device__ __forceinline__ void conv_step1(float (&Am)[1][8], float (&Az)[1][8], float (&Ap)[1][8], const u32x4 (&x)[3], const float (&wr)[9][8], int cn, int c0, int rowbase, int lane,
                                           const LAS float* cbias, float gc0, float gc1, unsigned char* ws) {
#pragma unroll
    for (int d = 0; d < 3; ++d) { float xv[8]; unpack8(x[d], xv);
#pragma unroll
        for (int j = 0; j < 8; ++j) { Am[0][j] += xv[j] * wr[d * 3 + 2][j]; Az[0][j] += xv[j] * wr[d * 3 + 1][j]; Ap[0][j] += xv[j] * wr[d * 3 + 0][j]; } }
    const int co = cn - 1;
    if (co >= c0 && co < c0 + 32) conv_finish<I, 1>(Am, rowbase + co, lane, cbias, gc0, gc1, ws);
#pragma unroll
    for (int j = 0; j < 8; ++j) Am[0][j] = 0.f;
}
template <int I>
__device__ __forceinline__ void conv_walk1(int c0, int rr, int nrows, int ncols, int rowbase, int lane, const bf16_t* CA, const bf16_t* CB, const LAS float* cw, const LAS float* cbias, float gc0, float gc1, unsigned char* ws) {
    const int ch = 8 * (lane + 64 * I), pitch = I < 3 ? 1536 : 1024; const bf16_t* src = I < 3 ? CA + ch : CB + ch - 1536;
    float wr[9][8];
#pragma unroll
    for (int tap = 0; tap < 9; ++tap) { const f32x4 w0 = *(const LAS f32x4*)(cw + tap * 2560 + ch), w1 = *(const LAS f32x4*)(cw + tap * 2560 + ch + 4); wr[tap][0] = w0.x; wr[tap][1] = w0.y; wr[tap][2] = w0.z; wr[tap][3] = w0.w; wr[tap][4] = w1.x; wr[tap][5] = w1.y; wr[tap][6] = w1.z; wr[tap][7] = w1.w; }
    const bool rup = rr - 1 >= 0, rdn = rr + 1 < nrows;
#define CONV_LDCOL(cn_, x_) do { const int cq_ = (cn_) < 0 ? 0 : ((cn_) >= ncols ? ncols - 1 : (cn_)); const bool cok_ = (cn_) >= 0 && (cn_) < ncols; \
        const u32x4 z_ = (u32x4){0u, 0u, 0u, 0u}; \
        const u32x4 a_ = *(const u32x4*)(src + (size_t)(rowbase + (rup ? -ncols : 0) + cq_) * pitch), b_ = *(const u32x4*)(src + (size_t)(rowbase + cq_) * pitch), c_ = *(const u32x4*)(src + (size_t)(rowbase + (rdn ? ncols : 0) + cq_) * pitch); \
        x_[0] = (cok_ && rup) ? a_ : z_; x_[1] = cok_ ? b_ : z_; x_[2] = (cok_ && rdn) ? c_ : z_; } while (0)
    float A0[1][8], A1[1][8], A2[1][8];
#pragma unroll
    for (int j = 0; j < 8; ++j) { A0[0][j] = 0.f; A1[0][j] = 0.f; A2[0][j] = 0.f; }
    u32x4 X0[3], X1[3], X2[3], X3[3];
    CONV_LDCOL(c0 - 1, X0); CONV_LDCOL(c0, X1); CONV_LDCOL(c0 + 1, X2); CONV_LDCOL(c0 + 2, X3);
#define CONV_ST(k_, Am_, Az_, Ap_, X_) do { conv_step1<I>(Am_, Az_, Ap_, X_, wr, cn + (k_), c0, rowbase, lane, cbias, gc0, gc1, ws); CONV_LDCOL(cn + (k_) + 4, X_); } while (0)
#pragma unroll 1
    for (int st = 0; st < 36; st += 12) { const int cn = c0 - 1 + st;
        CONV_ST(0, A0, A1, A2, X0); CONV_ST(1, A1, A2, A0, X1); CONV_ST(2, A2, A0, A1, X2); CONV_ST(3, A0, A1, A2, X3);
        CONV_ST(4, A1, A2, A0, X0); CONV_ST(5, A2, A0, A1, X1); CONV_ST(6, A0, A1, A2, X2); CONV_ST(7, A1, A2, A0, X3);
        CONV_ST(8, A2, A0, A1, X0); CONV_ST(9, A0, A1, A2, X1); CONV_ST(10, A1, A2, A0, X2); CONV_ST(11, A2, A0, A1, X3); }
#undef CONV_ST
#undef CONV_LDCOL
}
__device__ __forceinline__ void phase_conv2(const PL& P, LAS unsigned char* lds) {
    LAS float* cw = (LAS float*)lds;
    LAS float* cbias = cw + 9 * 2560;
    const int tid = TID, lane = tid & 63, gw = BID * 8 + wave_id(), NGW = GDIM * 8;
    unsigned char* ws = P.ws();
    { const float* gcw = P.in(IGCW); const float* scw = P.in(ISCW); const float* scb = P.in(ISCB);
    for (int i = tid; i < 9 * 2560; i += 512) { const int tap = i / 2560, c = i % 2560; cw[i] = c < 1536 ? gcw[tap * 1536 + c] : scw[tap * 1024 + c - 1536]; }
    for (int i = tid; i < 1024; i += 512) cbias[i] = scb[i]; }
    float gc0 = 0.f, gc1 = 0.f;
    if (lane < 8) { gc0 = -expf(P.in(IGALOG)[lane]); gc1 = P.in(IGDTB)[lane]; } else if (lane >= 16 && lane < 32) { gc0 = -expf(P.in(ISALOG)[lane - 16]); gc1 = P.in(ISDTB)[lane - 16]; }
    __syncthreads();
    const bf16_t* CA = (const bf16_t*)(ws + WS_CONVA); const bf16_t* CB = (const bf16_t*)(ws + WS_CONVB);
    for (int it2 = gw; it2 < 5 * 2304; it2 += NGW) { const int pass = it2 / 2304, item = it2 - pass * 2304;
        int rr, nrows, ncols, rowbase, c0;
        if (item < 2048) { const int b = item >> 6; rr = (item >> 1) & 31; c0 = (item & 1) * 32; nrows = 32; ncols = 64; rowbase = b * 2048 + rr * 64; }
        else { const int j = item - 2048, b = j >> 3; rr = 0; c0 = (j & 7) * 32; nrows = 1; ncols = 256; rowbase = TL + b * 256; }
        if (pass == 0) conv_walk1<0>(c0, rr, nrows, ncols, rowbase, lane, CA, CB, cw, cbias, gc0, gc1, ws);
        else if (pass == 1) conv_walk1<1>(c0, rr, nrows, ncols, rowbase, lane, CA, CB, cw, cbias, gc0, gc1, ws);
        else if (pass == 2) conv_walk1<2>(c0, rr, nrows, ncols, rowbase, lane, CA, CB, cw, cbias, gc0, gc1, ws);
        else if (pass == 3) conv_walk1<3>(c0, rr, nrows, ncols, rowbase, lane, CA, CB, cw, cbias, gc0, gc1, ws);
        else conv_walk1<4>(c0, rr, nrows, ncols, rowbase, lane, CA, CB, cw, cbias, gc0, gc1, ws);
    }
}

__device__ __forceinline__ int seq_row(int b, int d, int s) { if (s < 256) { const int l = d ? 255 - s : s; return TL + b * 256 + l; } const int l0 = s - 256, l = d ? 2047 - l0 : l0; return b * 2048 + l; }

#define NFMA(r, a, b) asm("v_fma_f32 %0, -%1, %2, %0" : "+v"(r) : "v"(a), "v"(b))
#define MFMA16(a, b, c) __builtin_amdgcn_mfma_f32_16x16x32_bf16((a), (b), (c), 0, 0, 0)
__device__ __forceinline__ bf16x8 fragl(const LAS bf16_t* M, int pitch, int row0, int k0, int lane) { return *(const LAS bf16x8*)(M + (row0 + (lane & 15)) * pitch + k0 + 8 * (lane >> 4)); }
typedef short s16x4 __attribute__((ext_vector_type(4)));
__device__ __forceinline__ bf16x8 fragt(const LAS bf16_t* M, int pitch, int r0, int c0, int lane) {
    const LAS bf16_t* p = M + (r0 + 8 * (lane >> 4) + ((lane & 15) >> 2)) * pitch + c0 + 4 * (lane & 3);
    const s16x4 lo = __builtin_amdgcn_ds_read_tr16_b64_v4i16((LAS s16x4*)p), hi = __builtin_amdgcn_ds_read_tr16_b64_v4i16((LAS s16x4*)(p + 4 * pitch));
    return (bf16x8){lo[0], lo[1], lo[2], lo[3], hi[0], hi[1], hi[2], hi[3]};
}
constexpr int GDN_NCHUNK = 36, GDN_NINST = 256 * GDN_NCHUNK;
constexpr size_t WS_GUT = WS_OGDN, WS_GWT = WS_R2, WS_GQK = 672 * MiB, WS_GEG = WS_GATE;

__device__ __forceinline__ void phase_gdn1m(const PL& P, LAS unsigned char* lds, size_t ut_off) {
    unsigned char* ws = P.ws();
    const bf16_t* Q = (const bf16_t*)(ws + WS_Q); const bf16_t* Kk = (const bf16_t*)(ws + WS_K); const bf16_t* V = (const bf16_t*)(ws + WS_V);
    const float* G = (const float*)(ws + WS_GPOST); const float* BETA = G + (size_t)TT * 8;
    bf16_t* UT = (bf16_t*)(ws + ut_off); bf16_t* WT = (bf16_t*)(ws + WS_GWT); bf16_t* QKo = (bf16_t*)(ws + WS_GQK);
    float* EG = (float*)(ws + WS_GEG); float* EGL = EG + (size_t)GDN_NINST * 64; float* GL = EGL + (size_t)GDN_NINST * 64;
    LAS bf16_t* Kl = (LAS bf16_t*)lds; LAS bf16_t* Ql = Kl + 64 * 136; LAS bf16_t* Vl = Ql + 64 * 136;
    LAS bf16_t* Mb = Vl + 64 * 136;
    LAS float* Md = (LAS float*)(Mb + 64 * 72);
    LAS bf16_t* Tb = (LAS bf16_t*)(Md + 4 * 16 * 20);
    LAS bf16_t* XT = Tb + 4 * 16 * 40;
    LAS bf16_t* YT = XT + 256 * 72;
    LAS float* gcs = (LAS float*)(YT + 256 * 40); LAS float* bet = gcs + 64; LAS float* betw = bet + 64;
    { const int t0 = TID; __syncthreads();
      for (int i = t0; i < (64 * 72 + 4 * 16 * 20 * 2 + 4 * 16 * 40 + 256 * 72 + 256 * 40) / 8; i += 512) *(LAS u32x4*)((LAS unsigned char*)Mb + i * 16) = (u32x4){0u, 0u, 0u, 0u};
      __syncthreads(); }
    u32x4 pf[6]; float pg = 0.f, pbeta = 0.f;
#define GDN1M_PREFETCH(id_) do { const int tid_ = TID + opaque0(), chain_ = (id_) / GDN_NCHUNK, c_ = (id_) % GDN_NCHUNK, d_ = chain_ & 1, h_ = (chain_ >> 1) & 3, b_ = chain_ >> 3; \
        _Pragma("unroll") for (int u_ = 0; u_ < 6; ++u_) { const int idx = tid_ + 512 * u_, wh = idx >> 10, rem = idx & 1023, i = rem >> 4, off = (rem & 15) * 8; const int row = seq_row(b_, d_, c_ * 64 + i); \
            const bf16_t* src = wh == 0 ? Kk : (wh == 1 ? Q : V); pf[u_] = *(const u32x4*)(src + (size_t)row * 512 + h_ * 128 + off); } \
        if (tid_ < 64) { const int row = seq_row(b_, d_, c_ * 64 + tid_); pg = G[(size_t)row * 8 + d_ * 4 + h_]; pbeta = BETA[(size_t)row * 8 + d_ * 4 + h_]; } } while (0)
    if (BID < GDN_NINST) GDN1M_PREFETCH(BID);
    for (int id = BID; id < GDN_NINST; id += GDIM) {
        const int tid = TID + opaque0(), lane = tid & 63, wave = __builtin_amdgcn_readfirstlane(tid >> 6), q4 = lane >> 4, l15 = lane & 15;
        LDS_BAR();
#pragma unroll
        for (int u_ = 0; u_ < 6; ++u_) { const int idx = tid + 512 * u_, wh = idx >> 10, rem = idx & 1023, i = rem >> 4, off = (rem & 15) * 8;
            LAS bf16_t* dst = wh == 0 ? Kl : (wh == 1 ? Ql : Vl); *(LAS u32x4*)(dst + i * 136 + off) = pf[u_]; }
        if (wave == 0) { float gc = pg; const float be = pbeta;
#pragma unroll
            for (int o = 1; o < 64; o <<= 1) { const float t = __shfl_up(gc, o); if (lane >= o) gc += t; }
            const float gl = __shfl(gc, 63);
            gcs[lane] = gc; bet[lane] = be; betw[lane] = be * expf(gc); EG[(size_t)id * 64 + lane] = expf(gc); EGL[(size_t)id * 64 + lane] = expf(gl - gc); if (lane == 0) GL[id] = expf(gl); }
        LDS_BAR();
        if (id + GDIM < GDN_NINST) GDN1M_PREFETCH(id + GDIM);
#pragma unroll 1
        for (int tl = wave; tl < 10; tl += 8) { const int it = tl < 1 ? 0 : (tl < 3 ? 1 : (tl < 6 ? 2 : 3)), jt = tl - (it * (it + 1)) / 2;
            const int i0 = it * 16, i = i0 + l15, j0 = jt * 16 + 4 * q4; const float gci = gcs[i], bi = bet[i]; f32x4 a = (f32x4){0.f, 0.f, 0.f, 0.f}, a2 = a;
#pragma unroll
            for (int k0 = 0; k0 < 128; k0 += 32) { const bf16x8 fj = fragl(Kl, 136, jt * 16, k0, lane); a = MFMA16(fj, fragl(Kl, 136, i0, k0, lane), a); a2 = MFMA16(fj, fragl(Ql, 136, i0, k0, lane), a2); }
            float mv[4], qv[4];
#pragma unroll
            for (int jj = 0; jj < 4; ++jj) { const int j = j0 + jj; const float ex = __expf(fminf(gci - gcs[j], 0.f)); const float dec = (j <= i) ? ex : 0.f; mv[jj] = (j < i) ? bi * a[jj] * dec : 0.f; qv[jj] = a2[jj] * 0.08838834764831845f * dec; }
            if (it == jt) *(LAS f32x4*)(Md + (it * 16 + l15) * 20 + 4 * q4) = (f32x4){mv[0], mv[1], mv[2], mv[3]};
            else { u32x2 w; w.x = cvt_pk_bf16(-mv[0], -mv[1]); w.y = cvt_pk_bf16(-mv[2], -mv[3]); *(LAS u32x2*)(Mb + i * 72 + j0) = w; }
            u32x2 w; w.x = cvt_pk_bf16(qv[0], qv[1]); w.y = cvt_pk_bf16(qv[2], qv[3]); *(u32x2*)(QKo + ((size_t)id * 64 + i) * 64 + j0) = w; }
        if (wave >= 2) { const int tz = wave - 2;
            const int it = tz < 3 ? 0 : (tz < 5 ? 1 : 2), jt = tz < 3 ? tz + 1 : (tz < 5 ? tz - 1 : 3);
            *(u32x2*)(QKo + ((size_t)id * 64 + it * 16 + l15) * 64 + jt * 16 + 4 * q4) = (u32x2){0u, 0u}; }
        LDS_BAR();
        if (tid < 64) { const int I = tid >> 4, c = tid & 15; const LAS float* md = Md + I * 16 * 20; float t[16];
#pragma unroll
            for (int i = 0; i < 16; ++i) { float r = (i == c) ? 1.0f : 0.0f;
#pragma unroll
                for (int j4 = 0; j4 < (i + 3) / 4; ++j4) { const f32x4 m = *(const LAS f32x4*)(md + i * 20 + 4 * j4);
                    NFMA(r, m.x, t[4 * j4]); if (4 * j4 + 1 < i) NFMA(r, m.y, t[4 * j4 + 1]); if (4 * j4 + 2 < i) NFMA(r, m.z, t[4 * j4 + 2]); if (4 * j4 + 3 < i) NFMA(r, m.w, t[4 * j4 + 3]); }
                t[i] = r; Tb[(I * 16 + i) * 40 + c] = f2bf(r); } }
        LDS_BAR();
#pragma unroll
        for (int I = 0; I < 4; ++I) {
            f32x4 acc[2];
#pragma unroll
            for (int tt = 0; tt < 2; ++tt) { const int ct = 2 * wave + tt, c0 = ct * 16, col = (c0 & 127) + l15; const LAS bf16_t* src = ct < 8 ? Vl : Kl; const LAS float* rsc = ct < 8 ? bet : betw;
#pragma unroll
                for (int jj = 0; jj < 4; ++jj) { const int i = 16 * I + 4 * q4 + jj; acc[tt][jj] = rsc[i] * bf1(src[i * 136 + col]); }
                if (I >= 1) { acc[tt] = MFMA16(fragl(Mb, 72, 16 * I, 0, lane), fragl(XT, 72, c0, 0, lane), acc[tt]); if (I == 3) acc[tt] = MFMA16(fragl(Mb, 72, 48, 32, lane), fragl(XT, 72, c0, 32, lane), acc[tt]); }
                u32x2 w; w.x = cvt_pk_bf16(acc[tt][0], acc[tt][1]); w.y = cvt_pk_bf16(acc[tt][2], acc[tt][3]); *(LAS u32x2*)(YT + (c0 + l15) * 40 + 4 * q4) = w; }
#pragma unroll
            for (int tt = 0; tt < 2; ++tt) { const int ct = 2 * wave + tt, c0 = ct * 16, col = (c0 & 127) + l15;
                const f32x4 zero4 = {0.f, 0.f, 0.f, 0.f}; const f32x4 x = MFMA16(fragl(Tb + I * 16 * 40, 40, 0, 0, lane), fragl(YT, 40, c0, 0, lane), zero4);
                u32x2 w; w.x = cvt_pk_bf16(x[0], x[1]); w.y = cvt_pk_bf16(x[2], x[3]);
                *(LAS u32x2*)(XT + (c0 + l15) * 72 + 16 * I + 4 * q4) = w;
                *(u32x2*)((ct < 8 ? UT : WT) + ((size_t)id * 128 + col) * 64 + 16 * I + 4 * q4) = w; }
        }
    }
#undef GDN1M_PREFETCH
}

__device__ __forceinline__ void phase_gdn2(const PL& P, LAS unsigned char* lds, size_t ut_off) {
    const int tid = TID + opaque0(), lane = tid & 63, wave = __builtin_amdgcn_readfirstlane(tid >> 6), q4 = lane >> 4, l15 = lane & 15;
    LAS bf16_t* WTl = (LAS bf16_t*)lds;
    LAS bf16_t* Ql = WTl + 128 * 72;
    LAS bf16_t* Kdl = Ql + 64 * 136;
    LAS bf16_t* QKl = Kdl + 64 * 136;
    LAS bf16_t* VnT = QKl + 64 * 72;
    LAS bf16_t* St = VnT + 128 * 72;
    unsigned char* ws = P.ws();
    const bf16_t* Q = (const bf16_t*)(ws + WS_Q); const bf16_t* Kk = (const bf16_t*)(ws + WS_K);
    bf16_t* UT = (bf16_t*)(ws + ut_off); const bf16_t* WT = (const bf16_t*)(ws + WS_GWT); const bf16_t* QKo = (const bf16_t*)(ws + WS_GQK);
    const float* EG = (const float*)(ws + WS_GEG); const float* EGL = EG + (size_t)GDN_NINST * 64; const float* GL = EGL + (size_t)GDN_NINST * 64;
    const int dv0 = wave * 16;
    for (int chain = BID; chain < 256; chain += GDIM) { const int d = chain & 1, h = (chain >> 1) & 3, b = chain >> 3;
        f32x4 S[8];
#pragma unroll
        for (int t = 0; t < 8; ++t) S[t] = (f32x4){0.f, 0.f, 0.f, 0.f};
        for (int i = lane; i < 16 * 136 / 8; i += 64) *(LAS u32x4*)(St + dv0 * 136 + i * 8) = (u32x4){0u, 0u, 0u, 0u};
        u32x4 pw[2], pq[2], pk[2], pqk; float peg[2], pegl[2]; u32x2 uu[4]; float pgl;
#define GDN2_PREFETCH(c_) do { const size_t id_ = (size_t)chain * GDN_NCHUNK + (c_); _Pragma("unroll") for (int u_ = 0; u_ < 2; ++u_) { const int idx = tid + 512 * u_; \
            { const int dk_ = idx >> 3, i8_ = (idx & 7) * 8; pw[u_] = *(const u32x4*)(WT + (id_ * 128 + dk_) * 64 + i8_); } \
            { const int i_ = idx >> 4, off_ = (idx & 15) * 8; const int row_ = seq_row(b, d, (c_) * 64 + i_); pq[u_] = *(const u32x4*)(Q + (size_t)row_ * 512 + h * 128 + off_); pk[u_] = *(const u32x4*)(Kk + (size_t)row_ * 512 + h * 128 + off_); \
              peg[u_] = EG[id_ * 64 + i_]; pegl[u_] = EGL[id_ * 64 + i_]; } } \
            pqk = *(const u32x4*)(QKo + id_ * 4096 + tid * 8); pgl = GL[id_]; \
            _Pragma("unroll") for (int it_ = 0; it_ < 4; ++it_) uu[it_] = *(const u32x2*)(UT + (id_ * 128 + dv0 + l15) * 64 + it_ * 16 + 4 * q4); } while (0)
        GDN2_PREFETCH(0);
        for (int c = 0; c < GDN_NCHUNK; ++c) { const size_t id = (size_t)chain * GDN_NCHUNK + c;
            __syncthreads();
#pragma unroll
            for (int u_ = 0; u_ < 2; ++u_) { const int idx = tid + 512 * u_;
                { const int dk_ = idx >> 3, i8_ = (idx & 7) * 8; *(LAS u32x4*)(WTl + dk_ * 72 + i8_) = (u32x4){pw[u_].x ^ 0x80008000u, pw[u_].y ^ 0x80008000u, pw[u_].z ^ 0x80008000u, pw[u_].w ^ 0x80008000u}; }
                { const int i_ = idx >> 4, off_ = (idx & 15) * 8; float qv[8], kv[8]; unpack8(pq[u_], qv); unpack8(pk[u_], kv); const float sq = peg[u_] * 0.08838834764831845f, sk = pegl[u_];
#pragma unroll
                  for (int e = 0; e < 8; ++e) { qv[e] *= sq; kv[e] *= sk; }
                  *(LAS u32x4*)(Ql + i_ * 136 + off_) = pack8(qv); *(LAS u32x4*)(Kdl + i_ * 136 + off_) = pack8(kv); } }
            { const int i_ = tid >> 3, j8_ = (tid & 7) * 8; *(LAS u32x4*)(QKl + i_ * 72 + j8_) = pqk; }
            const float glast = pgl;
            f32x4 vn[4], o[4];
#pragma unroll
            for (int it = 0; it < 4; ++it) { vn[it] = (f32x4){bflo(uu[it].x), bfhi(uu[it].x), bflo(uu[it].y), bfhi(uu[it].y)}; o[it] = (f32x4){0.f, 0.f, 0.f, 0.f}; }
            LDS_BAR();
            if (c + 1 < GDN_NCHUNK) GDN2_PREFETCH(c + 1);
#pragma unroll
            for (int k0 = 0; k0 < 128; k0 += 32) { const bf16x8 fs = fragl(St, 136, dv0, k0, lane);
#pragma unroll
                for (int it = 0; it < 4; ++it) { vn[it] = MFMA16(fragt(WTl, 72, k0, it * 16, lane), fs, vn[it]); o[it] = MFMA16(fs, fragl(Ql, 136, it * 16, k0, lane), o[it]); } }
#pragma unroll
            for (int it = 0; it < 4; ++it) { u32x2 w; w.x = cvt_pk_bf16(vn[it][0], vn[it][1]); w.y = cvt_pk_bf16(vn[it][2], vn[it][3]); *(LAS u32x2*)(VnT + (dv0 + l15) * 72 + it * 16 + 4 * q4) = w; }
#pragma unroll
            for (int t = 0; t < 8; ++t) S[t] = S[t] * glast;
#pragma unroll
            for (int j0 = 0; j0 < 64; j0 += 32) { const bf16x8 fv = fragl(VnT, 72, dv0, j0, lane);
#pragma unroll
                for (int it = 0; it < 4; ++it) o[it] = MFMA16(fv, fragl(QKl, 72, it * 16, j0, lane), o[it]);
#pragma unroll
                for (int t = 0; t < 8; ++t) S[t] = MFMA16(fragt(Kdl, 136, j0, t * 16, lane), fv, S[t]); }
#pragma unroll
            for (int it = 0; it < 4; ++it) { u32x2 w; w.x = cvt_pk_bf16(o[it][0], o[it][1]); w.y = cvt_pk_bf16(o[it][2], o[it][3]); *(u32x2*)(UT + (id * 64 + it * 16 + l15) * 128 + dv0 + 4 * q4) = w; }
#pragma unroll
            for (int t = 0; t < 8; ++t) { u32x2 w; w.x = cvt_pk_bf16(S[t][0], S[t][1]); w.y = cvt_pk_bf16(S[t][2], S[t][3]); *(LAS u32x2*)(St + (dv0 + l15) * 136 + t * 16 + 4 * q4) = w; }
        }
#undef GDN2_PREFETCH
        __syncthreads();
    }
}

__device__ __forceinline__ void phase_ssd_chunked(const PL& P, LAS unsigned char* lds, size_t out_off) {
    const int tid = TID + opaque0(), lane = tid & 63, wave = __builtin_amdgcn_readfirstlane(tid >> 6), q4 = lane >> 4, l15 = lane & 15, hl = wave >> 2, pt = wave & 3;
    LAS bf16_t* Cl = (LAS bf16_t*)lds;
    LAS bf16_t* Bl = Cl + 64 * 136;
    LAS bf16_t* HD = Bl + 64 * 136;
    constexpr int HDSZ = 3 * 64 * 72 + 64 * 136;
    LAS float* scal = (LAS float*)(HD + 2 * HDSZ);
    LAS bf16_t* XT1 = HD + hl * HDSZ; LAS bf16_t* XT2 = XT1 + 64 * 72; LAS bf16_t* Sc = XT2 + 64 * 72; LAS bf16_t* Hb = Sc + 64 * 72;
    unsigned char* ws = P.ws();
    const bf16_t* XS = (const bf16_t*)(ws + WS_XS); const bf16_t* BMm = (const bf16_t*)(ws + WS_BM); const bf16_t* CMm = (const bf16_t*)(ws + WS_CM);
    const float* DT = (const float*)(ws + WS_GPOST) + (size_t)TT * 16; const float* DA = DT + (size_t)TT * 16;
    bf16_t* OUT = (bf16_t*)(ws + out_off);
    const int p0 = pt * 16;
    for (int unit = BID; unit < 256; unit += GDIM) { const int hp = unit & 1, d = (unit >> 1) & 1, grp = (unit >> 2) & 1, b = unit >> 3, head = grp * 4 + hp * 2 + hl;
        f32x4 H[8];
#pragma unroll
        for (int t = 0; t < 8; ++t) H[t] = (f32x4){0.f, 0.f, 0.f, 0.f};
        for (int i = lane; i < 16 * 136 / 8; i += 64) *(LAS u32x4*)(Hb + p0 * 136 + i * 8) = (u32x4){0u, 0u, 0u, 0u};
        u32x4 pc[2], pb[2], px[2]; float pdt = 0.f, pda = 0.f;
#define SSD_PREFETCH(c_) do { _Pragma("unroll") for (int u_ = 0; u_ < 2; ++u_) { const int idx = tid + 512 * u_; \
            { const int j_ = idx >> 4, off_ = (idx & 15) * 8; const size_t row_ = (size_t)seq_row(b, d, (c_) * 64 + j_); pc[u_] = *(const u32x4*)(CMm + row_ * 256 + grp * 128 + off_); pb[u_] = *(const u32x4*)(BMm + row_ * 256 + grp * 128 + off_); } \
            { const int h2_ = idx >> 9, rem_ = idx & 511, j_ = rem_ >> 3, off_ = (rem_ & 7) * 8; const size_t row_ = (size_t)seq_row(b, d, (c_) * 64 + j_); px[u_] = *(const u32x4*)(XS + row_ * 512 + (grp * 4 + hp * 2 + h2_) * 64 + off_); } } \
            if (tid < 128) { const int h2_ = tid >> 6, j_ = tid & 63; const size_t row_ = (size_t)seq_row(b, d, (c_) * 64 + j_); pdt = DT[row_ * 16 + d * 8 + grp * 4 + hp * 2 + h2_]; pda = DA[row_ * 16 + d * 8 + grp * 4 + hp * 2 + h2_]; } } while (0)
        SSD_PREFETCH(0);
        for (int c = 0; c < 36; ++c) {
            LDS_BAR();
#pragma unroll
            for (int u_ = 0; u_ < 2; ++u_) { const int idx = tid + 512 * u_, j_ = idx >> 4, off_ = (idx & 15) * 8;
                *(LAS u32x4*)(Cl + j_ * 136 + off_) = pc[u_]; *(LAS u32x4*)(Bl + j_ * 136 + off_) = pb[u_]; }
            if (tid < 128) { const int h2_ = tid >> 6; float acs = pda;
#pragma unroll
                for (int o = 1; o < 64; o <<= 1) { const float t = __shfl_up(acs, o); if (lane >= o) acs += t; }
                const float al = __shfl(acs, 63);
                LAS float* sp = scal + h2_ * 256; sp[lane] = acs; sp[64 + lane] = __expf(acs); sp[128 + lane] = __expf(al - acs); sp[192 + lane] = pdt; if (lane == 0) scal[512 + h2_] = __expf(al); }
            LDS_BAR();
#pragma unroll
            for (int u_ = 0; u_ < 2; ++u_) { const int idx = tid + 512 * u_, h2_ = idx >> 9, rem_ = idx & 511, j_ = rem_ >> 3, off_ = (rem_ & 7) * 8; float xv[8]; unpack8(px[u_], xv);
                const float s1 = scal[h2_ * 256 + 192 + j_], s2 = s1 * scal[h2_ * 256 + 128 + j_]; LAS bf16_t* x1 = HD + h2_ * HDSZ; LAS bf16_t* x2 = x1 + 64 * 72; float x2v[8];
#pragma unroll
                for (int e = 0; e < 8; ++e) { x2v[e] = xv[e] * s2; xv[e] *= s1; }
                *(LAS u32x4*)(x1 + j_ * 72 + off_) = pack8(xv); *(LAS u32x4*)(x2 + j_ * 72 + off_) = pack8(x2v); }
            if (c + 1 < 36) SSD_PREFETCH(c + 1);
            { const LAS float* sp = scal + hl * 256; const int i0 = pt * 16, i = i0 + l15; const float ai = sp[i];
#pragma unroll 1
              for (int jt = 0; jt < 4; ++jt) { const int j0 = jt * 16 + 4 * q4; f32x4 g = (f32x4){0.f, 0.f, 0.f, 0.f};
                  if (jt <= pt) {
#pragma unroll
                      for (int k0 = 0; k0 < 128; k0 += 32) g = MFMA16(fragl(Bl, 136, jt * 16, k0, lane), fragl(Cl, 136, i0, k0, lane), g); }
                  float sv[4];
#pragma unroll
                  for (int jj = 0; jj < 4; ++jj) { const int j = j0 + jj; const float ex = __expf(fminf(ai - sp[j], 0.f)); sv[jj] = (j <= i) ? g[jj] * ex : 0.f; }
                  u32x2 w; w.x = cvt_pk_bf16(sv[0], sv[1]); w.y = cvt_pk_bf16(sv[2], sv[3]); *(LAS u32x2*)(Sc + i * 72 + j0) = w; } }
            LDS_BAR();
            { const LAS float* sp = scal + hl * 256; f32x4 y[4];
#pragma unroll
              for (int it = 0; it < 4; ++it) y[it] = (f32x4){0.f, 0.f, 0.f, 0.f};
#pragma unroll
              for (int n0 = 0; n0 < 128; n0 += 32) { const bf16x8 fh = fragl(Hb, 136, p0, n0, lane);
#pragma unroll
                  for (int it = 0; it < 4; ++it) y[it] = MFMA16(fh, fragl(Cl, 136, it * 16, n0, lane), y[it]); }
#pragma unroll
              for (int it = 0; it < 4; ++it) y[it] = y[it] * sp[64 + it * 16 + l15];
#pragma unroll
              for (int j0 = 0; j0 < 64; j0 += 32) { const bf16x8 fx = fragt(XT1, 72, j0, p0, lane);
#pragma unroll
                  for (int it = 0; it < 4; ++it) y[it] = MFMA16(fx, fragl(Sc, 72, it * 16, j0, lane), y[it]); }
#pragma unroll
              for (int it = 0; it < 4; ++it) { const size_t row = (size_t)seq_row(b, d, c * 64 + it * 16 + l15); u32x2 w; w.x = cvt_pk_bf16(y[it][0], y[it][1]); w.y = cvt_pk_bf16(y[it][2], y[it][3]);
                  *(u32x2*)(OUT + ((size_t)d * TT + row) * 512 + head * 64 + p0 + 4 * q4) = w; } }
            { const float gl = scal[512 + hl];
#pragma unroll
              for (int t = 0; t < 8; ++t) H[t] = H[t] * gl;
#pragma unroll
              for (int j0 = 0; j0 < 64; j0 += 32) { const bf16x8 fx = fragt(XT2, 72, j0, p0, lane);
#pragma unroll
                  for (int t = 0; t < 8; ++t) H[t] = MFMA16(fragt(Bl, 136, j0, t * 16, lane), fx, H[t]); }
#pragma unroll
              for (int t = 0; t < 8; ++t) { u32x2 w; w.x = cvt_pk_bf16(H[t][0], H[t][1]); w.y = cvt_pk_bf16(H[t][2], H[t][3]); *(LAS u32x2*)(Hb + (p0 + l15) * 136 + t * 16 + 4 * q4) = w; } }
        }
#undef SSD_PREFETCH
        __syncthreads();
    }
}

__device__ __forceinline__ void phase_merge(const PL& P) {
    const int lane = TID & 63, gw = BID * 8 + wave_id(), NGW = GDIM * 8;
    const bf16_t* OG = (const bf16_t*)(P.ws() + WS_OGDN); const bf16_t* OS = (const bf16_t*)(P.ws() + WS_OSSD); const bf16_t* Z = (const bf16_t*)(P.ws() + WS_Z); const bf16_t* XS = (const bf16_t*)(P.ws() + WS_XS);
    bf16_t* MIX = (bf16_t*)(P.ws() + WS_R2);
    float gw8[8], sw8[8]; { const float* a = P.in(IGNW) + (8 * lane) % 128; const float* s = P.in(ISNW) + 8 * lane;
#pragma unroll
        for (int j = 0; j < 8; ++j) { gw8[j] = a[j]; sw8[j] = s[j]; } }
    const float dsk = P.in(ISD)[lane >> 3];
    for (int r = gw; r < TT; r += NGW) {
        float of[8], orv[8], za[8], o[8];
        { int bb, sf, sr; if (r < TL) { bb = r >> 11; const int l = r & 2047; sf = 256 + l; sr = 256 + 2047 - l; } else { bb = (r - TL) >> 8; const int l = (r - TL) & 255; sf = l; sr = 255 - l; }
          const size_t chf = (size_t)((bb * 4 + (lane >> 4)) * 2);
          unpack8(*(const u32x4*)(OG + ((chf * 2304 + sf) * 128) + 8 * (lane & 15)), of); unpack8(*(const u32x4*)(OG + (((chf + 1) * 2304 + sr) * 128) + 8 * (lane & 15)), orv); }
        unpack8(*(const u32x4*)(Z + (size_t)r * 1024 + 8 * lane), za);
        float ss = 0.f;
#pragma unroll
        for (int j = 0; j < 8; ++j) { o[j] = of[j] + orv[j]; ss += o[j] * o[j]; }
        ss += __shfl_xor(ss, 1); ss += __shfl_xor(ss, 2); ss += __shfl_xor(ss, 4); ss += __shfl_xor(ss, 8);
        float rs = rsqrtf(ss * (1.0f / 128.0f) + RMS_EPS);
#pragma unroll
        for (int j = 0; j < 8; ++j) o[j] = o[j] * rs * gw8[j] * siluf(za[j]);
        { u32x2 q; q.x = pack4_fp8(o[0], o[1], o[2], o[3]); q.y = pack4_fp8(o[4], o[5], o[6], o[7]); *(u32x2*)((unsigned char*)MIX + (size_t)r * 1024 + 8 * lane) = q; }
        float yf[8], yr[8], xs[8], zb[8], y[8]; unpack8(*(const u32x4*)(OS + (size_t)r * 512 + 8 * lane), yf); unpack8(*(const u32x4*)(OS + ((size_t)TT + r) * 512 + 8 * lane), yr);
        unpack8(*(const u32x4*)(XS + (size_t)r * 512 + 8 * lane), xs); unpack8(*(const u32x4*)(Z + (size_t)r * 1024 + 512 + 8 * lane), zb);
        ss = 0.f;
#pragma unroll
        for (int j = 0; j < 8; ++j) { y[j] = (yf[j] + yr[j] + dsk * xs[j]) * siluf(zb[j]); ss += y[j] * y[j]; }
        ss += __shfl_xor(ss, 1); ss += __shfl_xor(ss, 2); ss += __shfl_xor(ss, 4); ss += __shfl_xor(ss, 8); ss += __shfl_xor(ss, 16);
        rs = rsqrtf(ss * (1.0f / 256.0f) + RMS_EPS);
#pragma unroll
        for (int j = 0; j < 8; ++j) y[j] = y[j] * rs * sw8[j];
        { u32x2 q; q.x = pack4_fp8(y[0], y[1], y[2], y[3]); q.y = pack4_fp8(y[4], y[5], y[6], y[7]); *(u32x2*)((unsigned char*)MIX + (size_t)r * 1024 + 512 + 8 * lane) = q; }
    }
}

__device__ __forceinline__ void phase_post2(const PL& P, LAS unsigned char* lds, int layer, const bf16_t* YM, int nrows, int CT) {
    const int tid = TID, lane = tid & 63, gw = BID * 8 + wave_id(), NGW = GDIM * 8;
    unsigned char* ws = P.ws(); const float* xin = P.in(IX); const float* cin = P.in(ICTX); const float* nwpost = P.in(IMNPOST) + layer * D; const float* nwpre = P.in(IFNPRE) + layer * D;
    LAS bf16_t* Wl = (LAS bf16_t*)lds;
    { const float* rw = P.in(IRW) + (size_t)layer * 1024 * 32; __syncthreads();
      for (int idx = tid; idx < 1024 * 32; idx += 512) { const int c = idx >> 5, e = idx & 31, l = (c & 511) >> 3, j = c >> 9, i = c & 7; Wl[(((e * 2 + j) * 64) + l) * 8 + i] = __builtin_bit_cast(unsigned short, (_Float16)rw[idx]); }
      __syncthreads(); }
    const float rbias = P.in(IRB)[layer * 32 + (lane >> 1)];
    int* RE = (int*)(ws + WS_RE); int* RP = RE + (size_t)TT * 4; float* RG = (float*)(RP + (size_t)TT * 4);
    int* TOK = (int*)(ws + WS_TOK); unsigned* CNT = (unsigned*)(ws + WS_CTL) + CW_CNT + layer * NCH * 32;
    float w[16], wp[16]; ld_row_f32(nwpost, lane, w); ld_row_f32(nwpre, lane, wp);
    const int rpw = (nrows + NGW - 1) / NGW, rbeg = gw * rpw, rend = (rbeg + rpw < nrows) ? rbeg + rpw : nrows;
    float m2v[16], shv[16], scv[16]; int curb = -1;
    u32x4 yq0, yq1; f32x4 xq0, xq1, xq2, xq3;
#define P2_LOAD(rr) do { const bf16_t* yp_ = YM + (size_t)(rr) * D + 8 * lane; yq0 = *(const u32x4*)yp_; yq1 = *(const u32x4*)(yp_ + 512); \
        if (layer == 0) { const float* xp_ = xrow(xin, cin, (rr)) + 8 * lane; xq0 = *(const f32x4*)xp_; xq1 = *(const f32x4*)(xp_ + 4); xq2 = *(const f32x4*)(xp_ + 512); xq3 = *(const f32x4*)(xp_ + 516); } \
        else { const bf16_t* hp_ = hbrow(ws, (rr)) + 8 * lane; xq0 = __builtin_bit_cast(f32x4, *(const u32x4*)hp_); xq1 = __builtin_bit_cast(f32x4, *(const u32x4*)(hp_ + 512)); } } while (0)
    if (rbeg < rend) P2_LOAD(rbeg);
    int pr = -1, pek = 0, ppos = 0, pch = 0;
    for (int r = rbeg; r < rend; ++r) {
        float y[16], x[16]; unpack8(yq0, &y[0]); unpack8(yq1, &y[8]);
        if (layer == 0) { x[0] = xq0.x; x[1] = xq0.y; x[2] = xq0.z; x[3] = xq0.w; x[4] = xq1.x; x[5] = xq1.y; x[6] = xq1.z; x[7] = xq1.w; x[8] = xq2.x; x[9] = xq2.y; x[10] = xq2.z; x[11] = xq2.w; x[12] = xq3.x; x[13] = xq3.y; x[14] = xq3.z; x[15] = xq3.w; }
        else { unpack8(__builtin_bit_cast(u32x4, xq0), &x[0]); unpack8(__builtin_bit_cast(u32x4, xq1), &x[8]); }
        if (r + 1 < rend) P2_LOAD(r + 1);
        const int bb = r < TL ? (r >> 11) : 32;
        if (bb != curb) { curb = bb; ld_row_f32(modp(ws, layer, r, 2), lane, m2v); ld_row_f32(modp(ws, layer, r, 3), lane, shv); ld_row_f32(modp(ws, layer, r, 4), lane, scv); }
        float ss = 0.f;
#pragma unroll
        for (int i = 0; i < 16; ++i) ss += y[i] * y[i];
        float rs = rsqrtf(wave_sum(ss) * (1.0f / 1024.0f) + RMS_EPS);
#pragma unroll
        for (int i = 0; i < 16; ++i) x[i] += m2v[i] * (y[i] * rs * w[i]);
        st_row_bf16(hbrow(ws, r), lane, x);
        ss = 0.f;
#pragma unroll
        for (int i = 0; i < 16; ++i) ss += x[i] * x[i];
        rs = rsqrtf(wave_sum(ss) * (1.0f / 1024.0f) + RMS_EPS);
        float o[16];
#pragma unroll
        for (int i = 0; i < 16; ++i) o[i] = x[i] * rs * wp[i] * (1.0f + scv[i]) + shv[i];
        { unsigned char* dst8 = ws + WS_A2Q;
#pragma unroll
          for (int j = 0; j < 2; ++j) { u32x2 q; q.x = pack4_fp8(o[8 * j], o[8 * j + 1], o[8 * j + 2], o[8 * j + 3]); q.y = pack4_fp8(o[8 * j + 4], o[8 * j + 5], o[8 * j + 6], o[8 * j + 7]); *(u32x2*)(dst8 + blk_off8(r, 8 * lane + 512 * j)) = q; } }
        typedef _Float16 h2v __attribute__((ext_vector_type(2)));
        h2v op[8];
#pragma unroll
        for (int q = 0; q < 8; ++q) { op[q].x = (_Float16)o[2 * q]; op[q].y = (_Float16)o[2 * q + 1]; }
        float pl[32];
        { typedef unsigned short u16x8 __attribute__((ext_vector_type(8))); u32x4 wb[2][8];
#define P2_LDG(buf, g) do { _Pragma("unroll") for (int q = 0; q < 8; ++q) wb[buf][q] = __builtin_bit_cast(u32x4, *(const LAS u16x8*)(Wl + ((((4 * (g) + (q >> 1)) * 2 + (q & 1)) * 64) + lane) * 8)); } while (0)
          P2_LDG(0, 0);
#pragma unroll
          for (int g = 0; g < 8; ++g) { if (g < 7) P2_LDG((g + 1) & 1, g + 1);
#pragma unroll
              for (int ee = 0; ee < 4; ++ee) { float acc = 0.f;
#pragma unroll
                  for (int j = 0; j < 2; ++j) { const u32x4 wv = wb[g & 1][2 * ee + j]; const unsigned w0 = wv.x, w1 = wv.y, w2 = wv.z, w3 = wv.w;
                      acc = __builtin_amdgcn_fdot2(op[4 * j + 0], __builtin_bit_cast(h2v, w0), acc, false); acc = __builtin_amdgcn_fdot2(op[4 * j + 1], __builtin_bit_cast(h2v, w1), acc, false);
                      acc = __builtin_amdgcn_fdot2(op[4 * j + 2], __builtin_bit_cast(h2v, w2), acc, false); acc = __builtin_amdgcn_fdot2(op[4 * j + 3], __builtin_bit_cast(h2v, w3), acc, false); }
                  pl[4 * g + ee] = acc; }
              __builtin_amdgcn_sched_barrier(0); }
#undef P2_LDG
        }
#pragma unroll
        for (int n = 32, m = 32; n >= 2; n >>= 1, m >>= 1) { const bool up = (lane & m) != 0;
#pragma unroll
            for (int k = 0; k < n / 2; ++k) { const float a = pl[k], b = pl[k + n / 2]; const float snd = up ? a : b, keep = up ? b : a; pl[k] = keep + __shfl_xor(snd, m); } }
        float lg = pl[0] + __shfl_xor(pl[0], 1) + rbias;
        const int myexp = lane >> 1;
        const int lgb = __builtin_bit_cast(int, lg); int rank = 0;
#pragma unroll
        for (int e = 0; e < 32; ++e) { const float L = __builtin_bit_cast(float, __builtin_amdgcn_readlane(lgb, 2 * e)); rank += (L > lg || (L == lg && e < myexp)) ? 1 : 0; }
        int sel[4]; float sv[4];
#pragma unroll
        for (int k = 0; k < 4; ++k) { const unsigned long long m = __builtin_amdgcn_ballot_w64(rank == k); const int l = m ? (int)__builtin_ctzll(m) : 0; sel[k] = l >> 1; sv[k] = __builtin_bit_cast(float, __builtin_amdgcn_readlane(lgb, l)); }
        const float e1 = expf(sv[1] - sv[0]), e2 = expf(sv[2] - sv[0]), e3 = expf(sv[3] - sv[0]), inv = 1.0f / (1.0f + e1 + e2 + e3);
        if (lane < 4) { const int ek = lane == 0 ? sel[0] : (lane == 1 ? sel[1] : (lane == 2 ? sel[2] : sel[3])); const float gk = (lane == 0 ? 1.0f : (lane == 1 ? e1 : (lane == 2 ? e2 : e3))) * inv;
            if (pr >= 0) { RP[(size_t)pr * 4 + lane] = ppos; TOK[((size_t)pch * 32 + pek) * CT + ppos] = pr; }
            const int ch = r / CT; ppos = (int)atomicAdd(&CNT[ch * 32 + ek], 1u); pek = ek; pch = ch;
            RE[(size_t)r * 4 + lane] = ek; RG[(size_t)r * 4 + lane] = gk; }
        pr = r;
    }
    if (pr >= 0 && lane < 4) { RP[(size_t)pr * 4 + lane] = ppos; TOK[((size_t)pch * 32 + pek) * CT + ppos] = pr; }
#undef P2_LOAD
}

__device__ __forceinline__ void moe_tables(const PL& P, LAS unsigned char* lds, int layer, int ch) {
    LAS int* cnt = (LAS int*)(lds + LDS_X + (ch & 1) * 512); LAS int* tp = cnt + 32;
    __syncthreads();
    if (TID == 0) { const unsigned* CNT = (const unsigned*)(P.ws() + WS_CTL) + CW_CNT + (layer * NCH + ch) * 32; int acc = 0;
        for (int e = 0; e < 32; ++e) { const int c = (int)__hip_atomic_load(CNT + e, __ATOMIC_RELAXED, __HIP_MEMORY_SCOPE_AGENT); cnt[e] = c; tp[e] = acc; acc += (c + 255) >> 8; } tp[32] = acc; }
    __syncthreads();
    { const int t = TID; LAS int* te = (LAS int*)(lds + LDS_X + 1024 + (ch & 1) * 2048); if (t < 32) { const int t1 = tp[t + 1]; for (int i = tp[t]; i < t1; ++i) te[i] = t; } }
    __syncthreads();
}
__device__ __forceinline__ void combine_acc(const u32x2 (&yq)[8], const u32x4 (&hq)[2], const float (&g)[4], float (&f)[16], float (&x)[16]) {
#pragma unroll
    for (int i = 0; i < 16; ++i) f[i] = 0.f;
#pragma unroll
    for (int k = 0; k < 4; ++k)
#pragma unroll
        for (int j = 0; j < 2; ++j) { const u32x2 w = yq[2 * k + j];
            const f32x2 a = __builtin_amdgcn_cvt_pk_f32_fp8((int)w.x, false), b = __builtin_amdgcn_cvt_pk_f32_fp8((int)w.x, true), c = __builtin_amdgcn_cvt_pk_f32_fp8((int)w.y, false), d = __builtin_amdgcn_cvt_pk_f32_fp8((int)w.y, true);
            f[8 * j] += g[k] * a.x; f[8 * j + 1] += g[k] * a.y; f[8 * j + 2] += g[k] * b.x; f[8 * j + 3] += g[k] * b.y; f[8 * j + 4] += g[k] * c.x; f[8 * j + 5] += g[k] * c.y; f[8 * j + 6] += g[k] * d.x; f[8 * j + 7] += g[k] * d.y; }
    unpack8(hq[0], &x[0]); unpack8(hq[1], &x[8]);
}
__device__ __forceinline__ void phase_combine(const PL& P, LAS unsigned char* lds, int layer, int ch, int CT) {
    const LAS int* tp = (const LAS int*)(lds + LDS_X + (ch & 1) * 512) + 32;
    const int lane = TID & 63, gw = BID * 8 + wave_id(), NGW = GDIM * 8;
    unsigned char* ws = P.ws(); float* outp = P.out(); const float* nwpost = P.in(IFNPOST) + layer * D; const float* nwpre1 = P.in(IMNPRE) + D;
    const int* RE = (const int*)(ws + WS_RE); const int* RP = RE + (size_t)TT * 4; const float* RG = (const float*)(RP + (size_t)TT * 4);
    const unsigned char* Y = ws + WS_Y + (size_t)(ch & 1) * (160 * MiB); unsigned char* A1 = ws + WS_A1;
    const int rpw = (CT + NGW - 1) / NGW, rlim = (ch + 1) * CT, rbeg = ch * CT + gw * rpw, rend = rbeg + rpw < rlim ? rbeg + rpw : rlim;
    float w[16], wv[16], m5[16], sh[16], sc[16]; ld_row_f32(nwpost, lane, w);
#pragma unroll
    for (int i = 0; i < 16; ++i) { wv[i] = 0.f; m5[i] = 0.f; sh[i] = 0.f; sc[i] = 0.f; }
    if (layer == 0) ld_row_f32(nwpre1, lane, wv);
    int curb = -1;
#define CB_LOAD(set, j) do { _Pragma("unroll") for (int k_ = 0; k_ < 4; ++k_) { const int slot_ = __builtin_amdgcn_readlane(slotL, 4 * (j) + k_); const unsigned char* yp_ = Y + (size_t)slot_ * D + 8 * lane; \
            yq[set][2 * k_] = *(const u32x2*)yp_; yq[set][2 * k_ + 1] = *(const u32x2*)(yp_ + 512); } \
        const bf16_t* hp_ = hbrow(ws, g0 + (j)) + 8 * lane; hq[set][0] = *(const u32x4*)hp_; hq[set][1] = *(const u32x4*)(hp_ + 512); } while (0)
#define CB_ROW(set, j) do { const int r = g0 + (j); float f[16], x[16], g_[4]; \
        _Pragma("unroll") for (int k_ = 0; k_ < 4; ++k_) g_[k_] = __builtin_bit_cast(float, __builtin_amdgcn_readlane(gLb, 4 * (j) + k_)); \
        combine_acc(yq[set], hq[set], g_, f, x); \
        if ((j) + 2 < gn) CB_LOAD(set, (j) + 2); \
        const int bb = r < TL ? (r >> 11) : 32; \
        if (bb != curb) { curb = bb; ld_row_f32(modp(ws, layer, r, 5), lane, m5); if (layer == 0) { ld_row_f32(modp(ws, 1, r, 0), lane, sh); ld_row_f32(modp(ws, 1, r, 1), lane, sc); } } \
        float ss = 0.f; \
        _Pragma("unroll") for (int i = 0; i < 16; ++i) ss += f[i] * f[i]; \
        const float rs = rsqrtf(wave_sum(ss) * (1.0f / 1024.0f) + RMS_EPS); \
        _Pragma("unroll") for (int i = 0; i < 16; ++i) x[i] += m5[i] * (f[i] * rs * w[i]); \
        if (layer == 0) { st_row_bf16(hbrow(ws, r), lane, x); norm_mod_pre(x, wv, sh, sc, nullptr, lane, A1 + (size_t)r * D); } else st_row_f32(outp + (size_t)r * D, lane, x); } while (0)
    for (int g0 = rbeg; g0 < rend; g0 += 16) {
        const int gn = rend - g0 < 16 ? rend - g0 : 16;
        int slotL = 0; float gL = 0.f;
        if (lane < 4 * gn) { const int e = RE[(size_t)g0 * 4 + lane], pos = RP[(size_t)g0 * 4 + lane]; gL = RG[(size_t)g0 * 4 + lane]; slotL = tp[e] * 256 + pos; }
        const int gLb = __builtin_bit_cast(int, gL);
        u32x2 yq[2][8]; u32x4 hq[2][2];
        CB_LOAD(0, 0); if (gn > 1) CB_LOAD(1, 1);
        for (int j = 0; j < gn; j += 2) { CB_ROW(0, j); if (j + 1 < gn) CB_ROW(1, j + 1); }
    }
#undef CB_LOAD
#undef CB_ROW
}

__device__ __forceinline__ void phase_s5_scan(const PL& P) {
    const float* S = (const float*)(P.ws() + WS_S5S); const float* LP = (const float*)(P.ws() + WS_LP); bf16_t* UL = (bf16_t*)(P.ws() + WS_UL);
    for (int idx = BID * 512 + TID; idx < 32 * 64 * 2 * 64; idx += GDIM * 512) { const int p = idx & 63, d = (idx >> 6) & 1, g = (idx >> 7) & 63, b = idx >> 13, dg = d * 64 + g;
        const float lr = LP[(((size_t)dg * 33 + 32) * 64 + p) * 2], li = LP[(((size_t)dg * 33 + 32) * 64 + p) * 2 + 1];
        const float* Sg = S + (size_t)g * S5ROWS * 256 + d * 128 + p; bf16_t* Ug = UL + (size_t)g * S5ROWS * S5K + 512 + d * 128 + p;
        float xr = 0.f, xi = 0.f;
        for (int c = 0; c < 8; ++c) { const int cc = d ? 7 - c : c, row = 2048 + b * 8 + cc; const float sr = Sg[(size_t)row * 256], si = Sg[(size_t)row * 256 + 64];
            const float nr = lr * xr - li * xi + sr, ni = lr * xi + li * xr + si; xr = nr; xi = ni; }
#pragma unroll 8
        for (int c = 0; c < 64; ++c) { const int cc = d ? 63 - c : c, row = b * 64 + cc; const float sr = Sg[(size_t)row * 256], si = Sg[(size_t)row * 256 + 64];
            Ug[(size_t)row * S5K] = f2bf(xr); Ug[(size_t)row * S5K + 64] = f2bf(xi);
            const float nr = lr * xr - li * xi + sr, ni = lr * xi + li * xr + si; xr = nr; xi = ni; }
    }
}

__global__ void __launch_bounds__(512, 2) hybrid_fwd(Params Pk) {
    extern __shared__ __attribute__((aligned(16))) unsigned char lds_raw[];
    LAS unsigned char* lds = (LAS unsigned char*)lds_raw;
    volatile LAS unsigned* MISC = (volatile LAS unsigned*)(lds + LDS_MISC);
    for (int u = threadIdx.x; u < 256; u += 512) MISC[u] = 0u;
    __syncthreads();
    if (threadIdx.x < (NIN + 2) * 2) ((LAS unsigned*)(lds + LDS_PARAMS))[threadIdx.x] = ((const unsigned*)&Pk)[threadIdx.x];
    __syncthreads();
    const int w0_ = __builtin_amdgcn_readfirstlane((int)threadIdx.x >> 6); const PL P0{lds, 0, w0_};
    (void)xcd_barrier_post((unsigned*)(P0.ws() + WS_CTL) + CW_BAR, MISC + 8);
#define GRID_BAR() do { SITE; xcd_barrier(P, MISC + 8); } while (0)
#define SITE const int z_ = opaque0(); const PL P{lds + z_, z_, w0_}

    { SITE; phase_mod(P, lds); __syncthreads(); phase_cvt_dense(P, lds); __syncthreads(); phase_s5_tables(P, lds); }
    GRID_BAR();
    { SITE; phase_pre0(P); }
    GRID_BAR();
    { SITE; unsigned char* ws = P.ws(); DenseSched S; S.init(ws + WS_R2, ws + WS_WIN, TT / 256, 9, 1024, 1024, P.z);
      EpiInProj E{(bf16_t*)(ws + WS_CONVA), (bf16_t*)(ws + WS_CONVB), (bf16_t*)(ws + WS_Z), (float*)(ws + WS_GATE), 0};
      pg8::gemm_phase<EpiInProj, DenseSched, false>(lds, 1024, 64, 64, S, E, TID, 256 * 128); }
    { SITE; unsigned char* ws = P.ws(); DenseSched S; S.init(ws + WS_A2Q, ws + WS_WIN8, TT / 256, 6, 1024, 1024, P.z, 1);
      EpiInProj E{(bf16_t*)(ws + WS_CONVA), (bf16_t*)(ws + WS_CONVB), (bf16_t*)(ws + WS_Z), (float*)(ws + WS_GATE), 1};
      pg8::gemm_phase<EpiInProj, DenseSched, false, true>(lds, 1024, 128, 128, S, E, TID, 256 * 128); }
    GRID_BAR();
    { SITE; phase_conv2(P, lds); }
    GRID_BAR();
    { SITE; phase_gdn1m(P, lds, WS_OGDN); }
    GRID_BAR();
    { SITE; phase_gdn2(P, lds, WS_OGDN); __syncthreads(); phase_ssd_chunked(P, lds, WS_OSSD); }
    GRID_BAR();
    { SITE; phase_merge(P); phase_cvt_moe(P, lds, 0); }
    GRID_BAR();
    { SITE; unsigned char* ws = P.ws(); DenseSched S; S.init(ws + WS_R2, ws + WS_WOUT, TT / 256, 4, 1024, 1024, P.z, 1);
      EpiBf16 E{(bf16_t*)(ws + WS_YMIX), 1024, nullptr, 0, 1.0f / W8_SCALE};
      pg8::gemm_phase<EpiBf16, DenseSched, false, true>(lds, 1024, 1024, 1024, S, E, TID);
      }
    GRID_BAR();

#pragma unroll 1
    for (int layer = 0; layer < 2; ++layer) {
        const int ntok = layer == 0 ? TT : TL, CT = ntok / NCH;
        if (layer == 1) {
            { SITE; phase_s5_mats(P); }
            { SITE; unsigned char* ws = P.ws(); DenseSched S; S.init(ws + WS_A1, ws + WS_WS5IN, TT / 256, 4, 1024, 1024, P.z, 1);
              EpiS5U E{(bf16_t*)(ws + WS_UL)};
              pg8::gemm_phase<EpiS5U, DenseSched, false, true>(lds, 1024, 1024, 1024, S, E, TID);
              }
            GRID_BAR();
            { SITE; unsigned char* ws = P.ws(); GroupSched S{(const char*)(ws + WS_UL), (const char*)(ws + WS_E), (size_t)S5ROWS * S5K * 2, (size_t)256 * 512 * 2, (size_t)256 * S5K * 2, 0, 64, S5ROWS / 256, 1, GDIM, BID};
              EpiS5S E{(float*)(ws + WS_S5S)};
              pg8::gemm_phase<EpiS5S, GroupSched, false>(lds, 512, S5K, 512, S, E, TID);
              }
            GRID_BAR();
            { SITE; phase_s5_scan(P); }
            GRID_BAR();
            { SITE; unsigned char* ws = P.ws(); GroupSched S{(const char*)(ws + WS_UL), (const char*)(ws + WS_MP), (size_t)S5ROWS * S5K * 2, (size_t)512 * S5K * 2, (size_t)256 * S5K * 2, (size_t)256 * S5K * 2, 64, 8, 2, GDIM, BID};
              EpiS5Y E{ws + WS_R2};
              pg8::gemm_phase<EpiS5Y, GroupSched, false>(lds, S5K, S5K, S5K, S, E, TID);
              }
            GRID_BAR();
            { SITE; unsigned char* ws = P.ws(); DenseSched S; S.init(ws + WS_R2, ws + WS_WGLU, TL / 256, 8, 1024, 1024, P.z, 1);
              EpiGLU E{(bf16_t*)(ws + WS_YMIX1)};
              pg8::gemm_phase<EpiGLU, DenseSched, false, true>(lds, 1024, 1024, 1024, S, E, TID);
              }
            GRID_BAR();
        }
        { SITE; phase_post2(P, lds, layer, (const bf16_t*)(P.ws() + (layer == 0 ? WS_YMIX : WS_YMIX1)), ntok, CT); }
        GRID_BAR();
#pragma unroll 1
        for (int k = 0; k < NCH + 2; ++k) {
            if (k >= 2) { SITE; phase_combine(P, lds, layer, k - 2, CT); if (layer == 0 && k == NCH + 1) phase_cvt_moe(P, lds, 1); }
            if (k < NCH) { SITE; moe_tables(P, lds, layer, k); }
            int xrot = 0;
            if (k >= 1 && k <= NCH) { SITE; const int ch = k - 1; const LAS int* cnt = (const LAS int*)(lds + LDS_X + (ch & 1) * 512); const LAS int* tp = cnt + 32; unsigned char* ws = P.ws();
              MoeSched S{tp, cnt, (const LAS int*)(lds + LDS_X + 1024 + (ch & 1) * 2048), 4, tp[32], false, (const char*)(ws + WS_H + (size_t)(ch & 1) * (80 * MiB)), (const char*)(ws + WS_WMOE) + (size_t)32 * 2048 * 1024, (size_t)1024 * 1024, nullptr, CT, GDIM, BID, 1024, 0};
              EpiFp8 E{ws + WS_Y + (size_t)(ch & 1) * (160 * MiB), 1024, P.in(IBD) + (size_t)layer * 32 * 1024, 1024, 1.0f / (W8_SCALE * H8_SCALE)};
              pg8::gemm_phase<EpiFp8, MoeSched, false, true>(lds, 1024, 128, 128, S, E, TID, 256 * 128);
              xrot = __builtin_amdgcn_readfirstlane(((tp[32] + 7) >> 3) & 7); }
            if (k < NCH) { SITE; const int ch = k; const LAS int* cnt = (const LAS int*)(lds + LDS_X + (ch & 1) * 512); const LAS int* tp = cnt + 32; unsigned char* ws = P.ws();
              MoeSched S{tp, cnt, (const LAS int*)(lds + LDS_X + 1024 + (ch & 1) * 2048), 8, tp[32], true, (const char*)(ws + WS_A2Q), (const char*)(ws + WS_WMOE), (size_t)2048 * 1024, (const int*)(ws + WS_TOK) + (size_t)ch * 32 * CT, CT, GDIM, BID, 1024, xrot};
              EpiSwiGLU E{ws + WS_H + (size_t)(ch & 1) * (80 * MiB), P.in(IBG) + (size_t)layer * 32 * 1024, P.in(IBU) + (size_t)layer * 32 * 1024};
              pg8::gemm_phase<EpiSwiGLU, MoeSched, true, true>(lds, 1024, 128, 128, S, E, TID, 256 * 128);
              }
            GRID_BAR();
        }
    }
#undef GRID_BAR
}

extern "C" void kernel_launch(void* const* d_in, const int* in_sizes, int n_in, void* d_out, int out_size, void* d_ws, size_t ws_size, hipStream_t stream) {
    static int grid = 0;
    if (grid == 0) {
        if (n_in != NIN || in_sizes[IX] != TL * D || out_size != TL * D || ws_size < WS_END) { fprintf(stderr, "kernel_launch: unexpected shapes (n_in %d, x %d, out %d, ws %zu < %zu); nothing launched\n", n_in, n_in > 0 ? in_sizes[0] : -1, out_size, ws_size, (size_t)WS_END); grid = -1; return; }
        int dev = 0, cus = 0, per_cu = 0;
        if (hipGetDevice(&dev) != hipSuccess || hipDeviceGetAttribute(&cus, hipDeviceAttributeMultiprocessorCount, dev) != hipSuccess) { grid = -1; return; }
        if (hipFuncSetAttribute((const void*)hybrid_fwd, hipFuncAttributeMaxDynamicSharedMemorySize, LDS_BYTES) != hipSuccess) { fprintf(stderr, "kernel_launch: hipFuncSetAttribute failed\n"); grid = -1; return; }
        if (hipOccupancyMaxActiveBlocksPerMultiprocessor(&per_cu, (const void*)hybrid_fwd, 512, LDS_BYTES) != hipSuccess || per_cu < 1) fprintf(stderr, "kernel_launch: occupancy query reports %d\n", per_cu);
        (void)hipGetLastError();
        grid = cus;
    }
    if (grid < 0) return;
    if (hipMemsetAsync((char*)d_ws + WS_CTL, 0, CTL_ZERO_BYTES, stream) != hipSuccess) return;
    Params p; memset(&p, 0, sizeof(p));
    for (int i = 0; i < NIN; ++i) p.in[i] = (const float*)d_in[i];
    p.out = (float*)d_out; p.ws = (unsigned char*)d_ws;
    hipLaunchKernelGGL(hybrid_fwd, dim3(grid), dim3(512), LDS_BYTES, stream, p);
}
```

```cpp
#include <hip/hip_runtime.h>
#include <cstdio>
#include <cstdint>
#include <cstring>

#define LAS __attribute__((address_space(3)))
typedef unsigned short bf16_t;
typedef short bf16x8 __attribute__((ext_vector_type(8)));
typedef float f32x4 __attribute__((ext_vector_type(4)));
typedef float f32x2 __attribute__((ext_vector_type(2)));
typedef unsigned u32x4 __attribute__((ext_vector_type(4)));
typedef unsigned u32x2 __attribute__((ext_vector_type(2)));

constexpr int D = 1024, NBATCH = 32, SEQ = 2048, CTXL = 256;
constexpr int TL = NBATCH * SEQ, TC = NBATCH * CTXL, TT = TL + TC;
constexpr int NEXP = 32;
constexpr int INW = 3616, INWP = 3840;
constexpr float RMS_EPS = 1e-6f;
constexpr int NCH = 4;
constexpr int S5T = 32, S5ROWS = 2304, S5K = 768;

enum { IX = 0, IC, ICTX, ICCTX, IADAW, IADAB, IMNPRE, IMNPOST, IFNPRE, IFNPOST, IRW, IRB, IWG, IBG, IWU, IBU, IWD, IBD, IHYIN, IGCW, IGALOG, IGDTB, IGNW,
       ISCW, ISCB, ISALOG, ISDTB, ISD, ISNW, IHYOUT, IS5IN, IS5ARE, IS5AIM, IS5LS, IS5BRE, IS5BIM, IS5CRE, IS5CIM, IS5D, IGLUA, IGLUB, NIN };

constexpr size_t MiB = 1u << 20;
constexpr size_t WS_CTL = 0, CTL_ZERO_BYTES = 65536;
constexpr size_t WS_R2 = 1 * MiB;
constexpr size_t WS_Z = 145 * MiB;
constexpr size_t WS_H = 145 * MiB;
constexpr size_t WS_Y = 305 * MiB;
constexpr size_t WS_UL = 145 * MiB;
constexpr size_t WS_YMIX1 = 145 * MiB;
constexpr size_t WS_XS = 289 * MiB;
constexpr size_t WS_GATE = 361 * MiB;
constexpr size_t WS_S5S = 361 * MiB;
constexpr size_t WS_GPOST = 370 * MiB;
constexpr size_t WS_CONVA = 384 * MiB;
constexpr size_t WS_OGDN = 384 * MiB;
constexpr size_t WS_YMIX = 384 * MiB;
constexpr size_t WS_MP = 505 * MiB;
constexpr size_t WS_E = 553 * MiB;
constexpr size_t WS_OSSD = 528 * MiB;
constexpr size_t WS_CONVB = 600 * MiB;
constexpr size_t WS_A1 = 625 * MiB;
constexpr size_t WS_Q = 744 * MiB, WS_K = 816 * MiB, WS_V = 888 * MiB;
constexpr size_t WS_WMOE = 768 * MiB;
constexpr size_t WS_A2Q = 864 * MiB;
constexpr float W8_SCALE = 32.0f, H8_SCALE = 4.0f;

constexpr size_t WS_BM = 960 * MiB, WS_CM = 996 * MiB;
constexpr size_t WS_HCTX = 1032 * MiB;
constexpr size_t WS_MOD = 1064 * MiB;
constexpr size_t WS_WIN = 1066 * MiB;
constexpr size_t WS_WOUT = 1074 * MiB;
constexpr size_t WS_RB = 1076 * MiB;
constexpr size_t WS_WS5IN = 1077 * MiB;
constexpr size_t WS_WGLU = 1079 * MiB;
constexpr size_t WS_KT = 1083 * MiB;
constexpr size_t WS_LP = 1087 * MiB;
constexpr size_t WS_BB = 1090 * MiB;
constexpr size_t WS_WIN8 = 1091 * MiB;
constexpr size_t WS_RE = 1100 * MiB;
constexpr size_t WS_TOK = 1104 * MiB;
constexpr size_t WS_HBL = 936 * MiB;
constexpr size_t WS_HBC = 1113 * MiB;
constexpr size_t WS_END = 1129 * MiB;
constexpr int CW_BAR = 4096, CW_CNT = 8192;

constexpr int LDS_BYTES = 147456, LDS_X = 131072  , LDS_MISC = LDS_BYTES - 1024;

__device__ __forceinline__ float bflo(unsigned w) { return __uint_as_float(w << 16); }
__device__ __forceinline__ float bfhi(unsigned w) { return __uint_as_float(w & 0xffff0000u); }
__device__ __forceinline__ float bf1(bf16_t b) { return __uint_as_float(((unsigned)b) << 16); }
typedef __bf16 bf16n2 __attribute__((ext_vector_type(2)));
__device__ __forceinline__ unsigned cvt_pk_bf16(float lo, float hi) { bf16n2 v; v.x = (__bf16)lo; v.y = (__bf16)hi; return __builtin_bit_cast(unsigned, v); }
__device__ __forceinline__ bf16_t f2bf(float f) { return (bf16_t)(cvt_pk_bf16(f, 0.f) & 0xffffu); }
__device__ __forceinline__ unsigned pack4_fp8(float a, float b, float c, float d) { int w = 0; w = __builtin_amdgcn_cvt_pk_fp8_f32(a, b, w, false); w = __builtin_amdgcn_cvt_pk_fp8_f32(c, d, w, true); return (unsigned)w; }
template <int CTRL, int RM = 0xF, int BM = 0xF> __device__ __forceinline__ float dppmov(float old, float src) { return __builtin_bit_cast(float, __builtin_amdgcn_update_dpp(__builtin_bit_cast(int, old), __builtin_bit_cast(int, src), CTRL, RM, BM, false)); }
__device__ __forceinline__ float wave_sum(float v) {
    v += dppmov<0xB1>(v, v); v += dppmov<0x4E>(v, v); v += dppmov<0x141>(v, v); v += dppmov<0x140>(v, v);
    const int b = __builtin_bit_cast(int, v);
    return (__builtin_bit_cast(float, __builtin_amdgcn_readlane(b, 0)) + __builtin_bit_cast(float, __builtin_amdgcn_readlane(b, 16))) + (__builtin_bit_cast(float, __builtin_amdgcn_readlane(b, 32)) + __builtin_bit_cast(float, __builtin_amdgcn_readlane(b, 48)));
}
__device__ __forceinline__ float siluf(float x) { return x * __builtin_amdgcn_rcpf(1.0f + __expf(-x)); }
__device__ __forceinline__ float sigmoidf_(float x) { return __builtin_amdgcn_rcpf(1.0f + __expf(-x)); }
__device__ __forceinline__ float softplusf_(float x) { return x > 20.f ? x : log1pf(expf(x)); }
#define PFMA(r, a, b) asm("v_fmac_f32 %0, %1, %2" : "+v"(r) : "v"(a), "v"(b))
#define LDS_WAIT() asm volatile("s_waitcnt lgkmcnt(0)" ::: "memory")
#define VM_WAIT() asm volatile("s_waitcnt vmcnt(0)" ::: "memory")
#define LDS_BAR() do { asm volatile("s_waitcnt lgkmcnt(0)" ::: "memory"); __builtin_amdgcn_s_barrier(); asm volatile("" ::: "memory"); } while (0)

__device__ __forceinline__ void ld_row_f32(const float* p, int lane, float (&v)[16]) {
#pragma unroll
    for (int j = 0; j < 2; ++j) { const f32x4 a = *(const f32x4*)(p + 8 * lane + 512 * j), b = *(const f32x4*)(p + 8 * lane + 512 * j + 4);
        v[8 * j + 0] = a.x; v[8 * j + 1] = a.y; v[8 * j + 2] = a.z; v[8 * j + 3] = a.w; v[8 * j + 4] = b.x; v[8 * j + 5] = b.y; v[8 * j + 6] = b.z; v[8 * j + 7] = b.w; }
}
__device__ __forceinline__ void st_row_f32(float* p, int lane, const float (&v)[16]) {
#pragma unroll
    for (int j = 0; j < 2; ++j) { *(f32x4*)(p + 8 * lane + 512 * j) = (f32x4){v[8 * j], v[8 * j + 1], v[8 * j + 2], v[8 * j + 3]}; *(f32x4*)(p + 8 * lane + 512 * j + 4) = (f32x4){v[8 * j + 4], v[8 * j + 5], v[8 * j + 6], v[8 * j + 7]}; }
}
__device__ __forceinline__ void unpack8(const u32x4 w, float* v) { v[0] = bflo(w.x); v[1] = bfhi(w.x); v[2] = bflo(w.y); v[3] = bfhi(w.y); v[4] = bflo(w.z); v[5] = bfhi(w.z); v[6] = bflo(w.w); v[7] = bfhi(w.w); }
__device__ __forceinline__ u32x4 pack8(const float* v) { u32x4 w; w.x = cvt_pk_bf16(v[0], v[1]); w.y = cvt_pk_bf16(v[2], v[3]); w.z = cvt_pk_bf16(v[4], v[5]); w.w = cvt_pk_bf16(v[6], v[7]); return w; }
__device__ __forceinline__ size_t blk_off(int r, int c) { return (size_t)(r >> 8) * (256 * 1024) + (size_t)(c >> 6) * (256 * 64) + (size_t)(r & 255) * 64 + (c & 63); }
__device__ __forceinline__ int inproj_row(int n) { const int c = n & 255; return (n & ~255) + 128 * ((c >> 5) & 1) + 32 * (c >> 6) + (c & 31); }
__device__ __forceinline__ size_t blk_off8(int r, int c) { return (size_t)(r >> 8) * (256 * 1024) + (size_t)(c >> 7) * (256 * 128) + (size_t)(r & 255) * 128 + (c & 127); }
__device__ __forceinline__ void ld_row_bf16(const bf16_t* p, int lane, float (&v)[16]) {
#pragma unroll
    for (int j = 0; j < 2; ++j) { const u32x4 w = *(const u32x4*)(p + 8 * lane + 512 * j); unpack8(w, &v[8 * j]); }
}
__device__ __forceinline__ void ld_row_fp8(const unsigned char* p, int lane, float (&v)[16]) {
#pragma unroll
    for (int j = 0; j < 2; ++j) { const u32x2 w = *(const u32x2*)(p + 8 * lane + 512 * j);
        const f32x2 a = __builtin_amdgcn_cvt_pk_f32_fp8((int)w.x, false), b = __builtin_amdgcn_cvt_pk_f32_fp8((int)w.x, true), c = __builtin_amdgcn_cvt_pk_f32_fp8((int)w.y, false), d = __builtin_amdgcn_cvt_pk_f32_fp8((int)w.y, true);
        v[8 * j] = a.x; v[8 * j + 1] = a.y; v[8 * j + 2] = b.x; v[8 * j + 3] = b.y; v[8 * j + 4] = c.x; v[8 * j + 5] = c.y; v[8 * j + 6] = d.x; v[8 * j + 7] = d.y; }
}
__device__ __forceinline__ void st_row_bf16(bf16_t* p, int lane, const float (&v)[16]) {
#pragma unroll
    for (int j = 0; j < 2; ++j) *(u32x4*)(p + 8 * lane + 512 * j) = pack8(&v[8 * j]);
}

__device__ __forceinline__ int lane_id(int z) { return (int)__builtin_amdgcn_mbcnt_hi(~0u, __builtin_amdgcn_mbcnt_lo(~0u, (unsigned)z)); }
#define XB_TMO      128
#define XB_XCNT(j)  (256  + 64 * (j))
#define XB_XSUB(j)  (1280 + 64 * (j))
#define XB_XGEN(j)  (2304 + 64 * (j))
#define XB_TOP      3328
#define XB_TOPGEN   3392
#define XCD_BAR_WORDS 3456
#define XB_SPIN_CAP (1u << 22)
__device__ __forceinline__ unsigned xb_ld(unsigned* p)              { return __hip_atomic_load(p, __ATOMIC_RELAXED, __HIP_MEMORY_SCOPE_AGENT); }
__device__ __forceinline__ unsigned xb_add(unsigned* p, unsigned v) { return __hip_atomic_fetch_add(p, v, __ATOMIC_RELAXED, __HIP_MEMORY_SCOPE_AGENT); }
__device__ __forceinline__ unsigned xb_xcc_id() { return (unsigned)__builtin_amdgcn_s_getreg((3 << 11) | 20) & 0xFu; }
#define XB_SPIN(cond, bar) do { unsigned _sp = 0; while (cond) { __builtin_amdgcn_s_sleep(1); \
    if ((++_sp & 255u) == 0u) { if (xb_ld(&(bar)[XB_TMO])) break; if (_sp > XB_SPIN_CAP) { atomicAdd(&(bar)[XB_TMO], 1u); break; } } } } while (0)
struct XcdBarrier { unsigned* bar; unsigned x; volatile LAS unsigned* st; };
__device__ __forceinline__ XcdBarrier xcd_barrier_post(unsigned* bar, volatile LAS unsigned* st) {
    XcdBarrier b; b.bar = bar; b.x = xb_xcc_id(); b.st = st;
    if (threadIdx.x == 0) (void)xb_add(&bar[XB_XCNT(b.x)], 1u);
    return b;
}
__device__ __forceinline__ void xcd_barrier_complete(unsigned* bar, unsigned x, unsigned& nloc, unsigned& nx) {
    const unsigned G = gridDim.x * gridDim.y * gridDim.z;
    unsigned sum, cnt, mine, sp = 0u;
    for (;;) {
        sum = 0u; cnt = 0u; mine = 0u;
#pragma unroll
        for (unsigned j = 0; j < 16; ++j) { const unsigned c = xb_ld(&bar[XB_XCNT(j)]); sum += c; cnt += (c > 0u) ? 1u : 0u; mine = (j == x) ? c : mine; }
        if (sum == G) break;
        __builtin_amdgcn_s_sleep(1);
        if ((++sp & 255u) == 0u) { if (xb_ld(&bar[XB_TMO])) break; if (sp > XB_SPIN_CAP) { atomicAdd(&bar[XB_TMO], 1u); break; } }
    }
    nloc = mine > 0u ? mine : 1u; nx = cnt > 0u ? cnt : 1u;
}
template <class PLT> __device__ __forceinline__ void xcd_barrier(const PLT& P, volatile LAS unsigned* st) {
    asm volatile("s_waitcnt vmcnt(0)" ::: "memory");
    __syncthreads();
    if (P.w0 == 0 && lane_id(P.z) == 0) {
        XcdBarrier b; b.bar = (unsigned*)(P.ws() + WS_CTL) + CW_BAR; b.x = xb_xcc_id(); b.st = st;
        unsigned* bar = b.bar;
        __builtin_amdgcn_s_waitcnt(0);
        unsigned nloc = b.st[0], nx = b.st[1];
        if (nloc == 0u) { xcd_barrier_complete(bar, b.x, nloc, nx); b.st[0] = nloc; b.st[1] = nx; }
        const unsigned old = xb_add(&bar[XB_XSUB(b.x)], 1u);
        const unsigned gen = old / nloc;
        if (old + 1u == (gen + 1u) * nloc) {
            __builtin_amdgcn_fence(__ATOMIC_RELEASE, "agent");
            asm volatile("s_waitcnt vmcnt(0)" ::: "memory");
            const unsigned og = xb_add(&bar[XB_TOP], 1u);
            const unsigned tg = og / nx;
            if (og + 1u == (tg + 1u) * nx) xb_add(&bar[XB_TOPGEN], 1u);
            else XB_SPIN(xb_ld(&bar[XB_TOPGEN]) == tg, bar);
            __builtin_amdgcn_fence(__ATOMIC_ACQUIRE, "agent");
            xb_add(&bar[XB_XGEN(b.x)], 1u);
            asm volatile("s_waitcnt vmcnt(0)" ::: "memory");
        } else {
            XB_SPIN(xb_ld(&bar[XB_XGEN(b.x)]) == gen, bar);
            __builtin_amdgcn_fence(__ATOMIC_ACQUIRE, "agent");
            asm volatile("s_waitcnt vmcnt(0)" ::: "memory");
        }
    }
    __syncthreads();
}

namespace pg8 {
constexpr int BM = 256, BK = 64, HALF = 128, HTB = HALF * BK * 2, STAGE_BYTES = 8 * HTB, NXCD = 8, WGM = 8;
__device__ __forceinline__ int lds_byte(int r, int c) { const int st = (r >> 4) * 2 + (c >> 5), rr = r & 15, cc = c & 31, ob = rr * 64 + cc * 2; return st * 1024 + (ob ^ (((ob >> 9) & 1) << 5)); }
__device__ __forceinline__ void stage_rc(int b, int& R, int& C) { const int st = b / 1024, sb = b % 1024, swz = sb ^ (((sb >> 9) & 1) << 5); R = (st >> 1) * 16 + swz / 64; C = (st & 1) * 32 + (swz % 64) / 2; }
__device__ __forceinline__ int perm32(int rho) { const int n = rho >> 4, i = rho & 15; return 8 * (i >> 2) + 4 * n + (i & 3); }

struct Unit { const char* A; const char* B; const int* gat; int nvalid; int r0, c0, e; };

struct TileOrder {
    int nM, nN, nwg, G, c;
    __device__ void init(int nM_, int nN_, int G_, int c_) { nM = nM_; nN = nN_; nwg = nM * nN; G = G_; c = c_; }
    __device__ bool next(int i, int& pm, int& pn) const {
        const long L = (long)i * G + c; if (L >= nwg) return false;
        int wgid = (int)L; { const int q = nwg / NXCD, r = nwg % NXCD, xcd = wgid % NXCD, off = wgid / NXCD; wgid = (xcd < r ? xcd * (q + 1) : r * (q + 1) + (xcd - r) * q) + off; }
        const int nig = WGM * nN, gid = wgid / nig, fm = gid * WGM, gsz = (nM - fm) < WGM ? (nM - fm) : WGM;
        pm = fm + ((wgid % nig) % gsz); pn = (wgid % nig) / gsz; return true;
    }
};

typedef int v8i32 __attribute__((ext_vector_type(8)));
template <class Epi, class Sched, bool GATHER, bool FP8 = false>
__device__ __forceinline__ void gemm_phase(LAS unsigned char* lds, const int K, const int lda, const int ldb, const Sched& S, const Epi& E, const int tid, const int kstepb = BK * 2) {
    constexpr int ES = FP8 ? 1 : 2;
    const int wid = __builtin_amdgcn_readfirstlane(tid >> 6), lane = tid & 63, wr = wid >> 2, wc = wid & 3, fr = lane & 15, fq = lane >> 4;
    const int nt = K / (FP8 ? 2 * BK : BK);
    unsigned cvA[2][2], nvA[2][2], voffB[2]; int stR[2], stC[2];
#pragma unroll
    for (int i = 0; i < 2; ++i) { int R, C; stage_rc(tid * 16 + i * 8192, R, C); stR[i] = R; stC[i] = C; const int Rb = Epi::PERM ? ((R & ~31) + perm32(R & 31)) : R;
        voffB[i] = (unsigned)(Rb * ldb * ES + C * 2);
#pragma unroll
        for (int h = 0; h < 2; ++h) { cvA[h][i] = (unsigned)((R + HALF * h) * lda * ES + C * 2); nvA[h][i] = cvA[h][i]; } }
    const size_t kstep = (size_t)kstepb;
    const size_t hstepB = (size_t)HALF * ldb * ES;
    const unsigned ldsw = (unsigned)wid * 1024u;
    const int aoff0 = lds_byte(wr * 64 + fr, fq * 8), aoff1 = aoff0 + 1024;
    const int boff0 = lds_byte(wc * 32 + fr, fq * 8), boff1 = boff0 + 1024;
    LAS unsigned char* pA = lds + aoff0; LAS unsigned char* pB = lds + 4 * HTB + boff0;
    asm volatile("" : "+v"(pA), "+v"(pB));
#define PG8_SA(b, h) (((b) * 2 + (h)) * HTB)
#define PG8_SB(b, h) ((4 + (b) * 2 + (h)) * HTB)
#define PG8_STAGE(bufoff, gbase, v0, v1) do { \
        __builtin_amdgcn_global_load_lds((const unsigned*)((const char*)(gbase) + (v0)), (LAS unsigned*)(lds + (bufoff) + ldsw), 16, 0, 0); \
        __builtin_amdgcn_global_load_lds((const unsigned*)((const char*)(gbase) + (v1)), (LAS unsigned*)(lds + (bufoff) + ldsw + 8192), 16, 0, 0); } while (0)
#define PG8_LD32(addr0, addr1) __builtin_bit_cast(v8i32, __builtin_shufflevector(*(const LAS u32x4*)(addr0), *(const LAS u32x4*)(addr1), 0, 1, 2, 3, 4, 5, 6, 7))
#define PG8_LDA(dst, b, h) do { _Pragma("unroll") for (int m = 0; m < 4; ++m) { if constexpr (FP8) dst##8[m] = PG8_LD32(pA + PG8_SA(b, h) + m * 2048, pA + PG8_SA(b, h) + (aoff1 - aoff0) + m * 2048); \
        else { _Pragma("unroll") for (int k = 0; k < 2; ++k) dst[m][k] = *(const LAS bf16x8*)(pA + PG8_SA(b, h) + (k ? aoff1 - aoff0 : 0) + m * 2048); } } } while (0)
#define PG8_LDB(dst, b, h) do { _Pragma("unroll") for (int n = 0; n < 2; ++n) { if constexpr (FP8) dst##8[n] = PG8_LD32(pB + (PG8_SB(b, h) - 4 * HTB) + n * 2048, pB + (PG8_SB(b, h) - 4 * HTB) + (boff1 - boff0) + n * 2048); \
        else { _Pragma("unroll") for (int k = 0; k < 2; ++k) dst[n][k] = *(const LAS bf16x8*)(pB + (PG8_SB(b, h) - 4 * HTB) + (k ? boff1 - boff0 : 0) + n * 2048); } } } while (0)
#define PG8_CAT(x0, x1) __builtin_shufflevector(__builtin_bit_cast(u32x4, x0), __builtin_bit_cast(u32x4, x1), 0, 1, 2, 3, 4, 5, 6, 7)
#define PG8_MMA(ai, bj, At, Bt) do { __builtin_amdgcn_s_setprio(1); _Pragma("unroll") for (int m = 0; m < 4; ++m) _Pragma("unroll") for (int n = 0; n < 2; ++n) { \
        if constexpr (FP8) asm volatile("v_mfma_f32_16x16x128_f8f6f4 %0, %1, %2, %0" : "+v"(acc[ai][bj][m][n]) : "v"(Bt##8[n]), "v"(At##8[m]));   \
        else { _Pragma("unroll") for (int k = 0; k < 2; ++k) acc[ai][bj][m][n] = __builtin_amdgcn_mfma_f32_16x16x32_bf16(Bt[n][k], At[m][k], acc[ai][bj][m][n], 0, 0, 0); } } __builtin_amdgcn_s_setprio(0); } while (0)
#define PG8_WAIT_V(n) asm volatile("s_waitcnt vmcnt(" #n ")" ::: "memory")
#define PG8_WAIT_L(n) asm volatile("s_waitcnt lgkmcnt(" #n ")" ::: "memory")
#define PG8_BAR __builtin_amdgcn_s_barrier()
#define PG8_SCHED __builtin_amdgcn_sched_barrier(0)
#define PG8_GATHER(u, dst) do { _Pragma("unroll") for (int h = 0; h < 2; ++h) _Pragma("unroll") for (int i = 0; i < 2; ++i) { const int rr = h * HALF + stR[i]; \
        const int tok = (rr < (u).nvalid) ? (u).gat[rr] : 0; dst[h][i] = kstepb == BK * 2 ? (unsigned)(tok * lda * ES + stC[i] * 2) : (unsigned)((tok >> 8) * (256 * 1024) + (tok & 255) * 128 + stC[i] * 2); } } while (0)
    Unit cur, nxt; int ui = 0;
    if (!S.next(0, cur)) return;
    f32x4 acc[2][2][4][2];
#pragma unroll
    for (int a = 0; a < 2; ++a)
#pragma unroll
        for (int b = 0; b < 2; ++b)
#pragma unroll
            for (int m = 0; m < 4; ++m)
#pragma unroll
                for (int n = 0; n < 2; ++n) acc[a][b][m][n] = (f32x4){0.f, 0.f, 0.f, 0.f};
    bf16x8 At[4][2], B0[2][2], B1[2][2]; v8i32 At8[4], B08[2], B18[2];
    if constexpr (GATHER) { PG8_GATHER(cur, cvA); }
    const char* cA = cur.A; const char* cB = cur.B;
    PG8_STAGE(PG8_SB(0, 0), cB, voffB[0], voffB[1]); PG8_STAGE(PG8_SB(0, 1), cB + hstepB, voffB[0], voffB[1]); PG8_STAGE(PG8_SA(0, 0), cA, cvA[0][0], cvA[0][1]); PG8_STAGE(PG8_SA(0, 1), cA, cvA[1][0], cvA[1][1]);
    if (wr == 1) PG8_BAR;
    PG8_WAIT_V(2); PG8_BAR;
    PG8_STAGE(PG8_SB(1, 0), cB + kstep, voffB[0], voffB[1]); PG8_STAGE(PG8_SA(1, 0), cA + kstep, cvA[0][0], cvA[0][1]); PG8_STAGE(PG8_SB(1, 1), cB + hstepB + kstep, voffB[0], voffB[1]);
    PG8_WAIT_V(6); PG8_BAR;
    for (;;) {
        const bool has_next = S.next(ui + 1, nxt);
        if constexpr (GATHER) { if (has_next) { PG8_GATHER(nxt, nvA); } else {
#pragma unroll
            for (int h = 0; h < 2; ++h)
#pragma unroll
                for (int i = 0; i < 2; ++i) nvA[h][i] = cvA[h][i]; } }
        const char* nA = has_next ? nxt.A : cA; const char* nB = has_next ? nxt.B : cB;
#pragma unroll 1
        for (int t = 0; t < nt; t += 2) {
            const bool last = (t == nt - 2);
            const char* a1 = cA + (size_t)(t + 1) * kstep;
            const char* a2 = last ? nA : cA + (size_t)(t + 2) * kstep; const char* b2 = last ? nB : cB + (size_t)(t + 2) * kstep;
            asm volatile("" : "+s"(a1), "+s"(a2), "+s"(b2));
            asm volatile("" : "+v"(voffB[0]), "+v"(voffB[1]), "+v"(cvA[0][0]), "+v"(cvA[0][1]), "+v"(cvA[1][0]), "+v"(cvA[1][1]));
            const char* a3 = a2 + kstep; const char* b3 = b2 + kstep;
            unsigned x00 = cvA[0][0], x01 = cvA[0][1], x10 = cvA[1][0], x11 = cvA[1][1];
            if constexpr (GATHER) { if (last) { x00 = nvA[0][0]; x01 = nvA[0][1]; x10 = nvA[1][0]; x11 = nvA[1][1]; } }
            PG8_LDB(B0, 0, 0); PG8_LDB(B1, 0, 1); PG8_SCHED; PG8_LDA(At, 0, 0); PG8_STAGE(PG8_SA(1, 1), a1, cvA[1][0], cvA[1][1]);
            PG8_WAIT_V(8); PG8_WAIT_L(0); PG8_BAR; PG8_MMA(0, 0, At, B0); PG8_MMA(0, 1, At, B1); PG8_BAR; PG8_SCHED;
            PG8_LDA(At, 0, 1); PG8_STAGE(PG8_SB(0, 0), b2, voffB[0], voffB[1]); PG8_STAGE(PG8_SB(0, 1), b2 + hstepB, voffB[0], voffB[1]); PG8_STAGE(PG8_SA(0, 0), a2, x00, x01);
            PG8_WAIT_V(8); PG8_WAIT_L(0); PG8_BAR; PG8_MMA(1, 0, At, B0); PG8_MMA(1, 1, At, B1); PG8_BAR; PG8_SCHED;
            PG8_LDB(B0, 1, 0); PG8_LDB(B1, 1, 1); PG8_SCHED; PG8_LDA(At, 1, 0); PG8_STAGE(PG8_SA(0, 1), a2, x10, x11);
            PG8_WAIT_V(8); PG8_WAIT_L(0); PG8_BAR; PG8_MMA(0, 0, At, B0); PG8_MMA(0, 1, At, B1); PG8_BAR; PG8_SCHED;
            PG8_LDA(At, 1, 1); PG8_STAGE(PG8_SB(1, 0), b3, voffB[0], voffB[1]); PG8_STAGE(PG8_SB(1, 1), b3 + hstepB, voffB[0], voffB[1]); PG8_STAGE(PG8_SA(1, 0), a3, x00, x01);
            PG8_WAIT_V(8); PG8_WAIT_L(0); PG8_BAR; PG8_MMA(1, 0, At, B0); PG8_MMA(1, 1, At, B1); PG8_BAR; PG8_SCHED;
        }
        if constexpr (FP8) asm volatile("s_nop 15\n\ts_nop 15\n\ts_nop 7" ::: "memory");
        if (wr == 0) PG8_BAR;
        { Unit eu = cur; asm volatile("" : "+s"(eu.r0), "+s"(eu.c0), "+s"(eu.e));
          E(acc, eu, wr, wc, fr, fq); }
        if (!has_next) break;
#pragma unroll
        for (int a = 0; a < 2; ++a)
#pragma unroll
            for (int b = 0; b < 2; ++b)
#pragma unroll
                for (int m = 0; m < 4; ++m)
#pragma unroll
                    for (int n = 0; n < 2; ++n) acc[a][b][m][n] = (f32x4){0.f, 0.f, 0.f, 0.f};
        cur = nxt; cA = nA; cB = nB; ++ui;
        if constexpr (GATHER) {
#pragma unroll
            for (int h = 0; h < 2; ++h)
#pragma unroll
                for (int i = 0; i < 2; ++i) cvA[h][i] = nvA[h][i]; }
        if (wr == 1) PG8_BAR;
    }
    PG8_WAIT_V(0);
    PG8_BAR;
#undef PG8_SA
#undef PG8_SB
#undef PG8_STAGE
#undef PG8_LDA
#undef PG8_LD32
#undef PG8_LDB
#undef PG8_MMA
#undef PG8_CAT
#undef PG8_WAIT_V
#undef PG8_WAIT_L
#undef PG8_BAR
#undef PG8_SCHED
#undef PG8_GATHER
}
}
using pg8::Unit;

struct Params { const float* in[NIN]; float* out; unsigned char* ws; };
constexpr int LDS_PARAMS = LDS_BYTES - 1024 + 256;
__device__ __forceinline__ int opaque0() { int z; asm volatile("s_mov_b32 %0, 0" : "=s"(z)); return z; }
struct PL {
    LAS unsigned char* lds; int z; int w0;
    __device__ __forceinline__ unsigned long long word(int i) const { const LAS unsigned* w = (const LAS unsigned*)(lds + LDS_PARAMS) + 2 * i;
        const unsigned lo = __builtin_amdgcn_readfirstlane(w[0]), hi = __builtin_amdgcn_readfirstlane(w[1]); return ((unsigned long long)hi << 32) | lo; }
    __device__ __forceinline__ const float* in(int i) const { return (const float*)(__attribute__((address_space(1))) const float*)word(i); }
    __device__ __forceinline__ float* out() const { return (float*)(__attribute__((address_space(1))) float*)word(NIN); }
    __device__ __forceinline__ unsigned char* ws() const { return (unsigned char*)(__attribute__((address_space(1))) unsigned char*)word(NIN + 1); }
};

struct EpiBf16 {
    static constexpr bool PERM = true;
    bf16_t* O; int ldc; const float* bias; int bias_estride; float ascale = 1.0f;
    __device__ __forceinline__ void operator()(const f32x4 (&acc)[2][2][4][2], const Unit& u, int wr, int wc, int fr, int fq) const {
        const int row0 = u.r0 + wr * 64 + fr, col0 = u.c0 * 256 + wc * 32 + 8 * fq;
        f32x4 bv[2][2];
#pragma unroll
        for (int bj = 0; bj < 2; ++bj)
#pragma unroll
            for (int n = 0; n < 2; ++n) bv[bj][n] = bias ? *(const f32x4*)(bias + (size_t)u.e * bias_estride + col0 + bj * 128 + 4 * n) : (f32x4){0.f, 0.f, 0.f, 0.f};
#pragma unroll
        for (int ai = 0; ai < 2; ++ai)
#pragma unroll
            for (int m = 0; m < 4; ++m) { bf16_t* rowp = O + (size_t)(row0 + ai * 128 + m * 16) * ldc + col0;
#pragma unroll
                for (int bj = 0; bj < 2; ++bj) { const f32x4 v0 = acc[ai][bj][m][0] * ascale + bv[bj][0], v1 = acc[ai][bj][m][1] * ascale + bv[bj][1];
                    u32x4 w; w.x = cvt_pk_bf16(v0[0], v0[1]); w.y = cvt_pk_bf16(v0[2], v0[3]); w.z = cvt_pk_bf16(v1[0], v1[1]); w.w = cvt_pk_bf16(v1[2], v1[3]);
                    *(u32x4*)(rowp + bj * 128) = w; } }
    }
};
struct EpiFp8 {
    static constexpr bool PERM = true;
    unsigned char* O; int ldc; const float* bias; int bias_estride; float ascale;
    __device__ __forceinline__ void operator()(const f32x4 (&acc)[2][2][4][2], const Unit& u, int wr, int wc, int fr, int fq) const {
        const int row0 = u.r0 + wr * 64 + fr, col0 = u.c0 * 256 + wc * 32 + 8 * fq;
        f32x4 bv[2][2];
#pragma unroll
        for (int bj = 0; bj < 2; ++bj)
#pragma unroll
            for (int n = 0; n < 2; ++n) bv[bj][n] = *(const f32x4*)(bias + (size_t)u.e * bias_estride + col0 + bj * 128 + 4 * n);
#pragma unroll
        for (int ai = 0; ai < 2; ++ai)
#pragma unroll
            for (int m = 0; m < 4; ++m) { unsigned char* rowp = O + (size_t)(row0 + ai * 128 + m * 16) * ldc + col0;
#pragma unroll
                for (int bj = 0; bj < 2; ++bj) { const f32x4 v0 = acc[ai][bj][m][0] * ascale + bv[bj][0], v1 = acc[ai][bj][m][1] * ascale + bv[bj][1];
                    u32x2 q; q.x = pack4_fp8(v0[0], v0[1], v0[2], v0[3]); q.y = pack4_fp8(v1[0], v1[1], v1[2], v1[3]); *(u32x2*)(rowp + bj * 128) = q; } }
    }
};
__device__ __forceinline__ void epi_cols32(const f32x4 (&acc)[2][2][4][2], float* dst, const float* bias, int r0, int wr, int wc, int fr, int fq, float ascale) {
    if (wc != 0) return;
    const int row0 = r0 + wr * 64 + fr, c = 8 * fq;
    f32x4 b0 = (f32x4){0.f, 0.f, 0.f, 0.f}, b1 = b0;
    if (bias) { b0 = *(const f32x4*)(bias + c); b1 = *(const f32x4*)(bias + c + 4); }
#pragma unroll
    for (int ai = 0; ai < 2; ++ai)
#pragma unroll
        for (int m = 0; m < 4; ++m) { float* p = dst + (size_t)(row0 + ai * 128 + m * 16) * 32 + c;
            *(f32x4*)p = acc[ai][0][m][0] * ascale + b0; *(f32x4*)(p + 4) = acc[ai][0][m][1] * ascale + b1; }
}
struct EpiInProj {
    static constexpr bool PERM = true;
    bf16_t *ca, *cb, *z; float* gate; int f8 = 0;
    __device__ __forceinline__ void operator()(const f32x4 (&acc)[2][2][4][2], const Unit& u, int wr, int wc, int fr, int fq) const {
        const int ct = f8 ? u.c0 : u.c0 + 10; const float ascale = f8 ? 1.0f / W8_SCALE : 1.0f;
        if (ct == 14) { epi_cols32(acc, gate, nullptr, u.r0, wr, wc, fr, fq, 1.0f); return; }
        bf16_t* O; int ldc, c0;
        if (ct < 6) { O = ca; ldc = 1536; c0 = ct; } else if (ct < 10) { O = cb; ldc = 1024; c0 = ct - 6; } else { O = z; ldc = 1024; c0 = ct - 10; }
        const bool odd = (fr & 1) != 0;
        const int col = c0 * 256 + wc * 64 + (odd ? 32 : 0) + 8 * fq, rowb = u.r0 + wr * 64 + (fr & ~1);
#pragma unroll
        for (int ai = 0; ai < 2; ++ai)
#pragma unroll
            for (int m = 0; m < 4; ++m) { unsigned p0[4], p1[4], s0[4], s1[4];
#pragma unroll
                for (int n = 0; n < 2; ++n) { const f32x4 v0 = acc[ai][0][m][n] * ascale, v1 = acc[ai][1][m][n] * ascale;
                    p0[2 * n] = cvt_pk_bf16(v0[0], v0[1]); p0[2 * n + 1] = cvt_pk_bf16(v0[2], v0[3]); p1[2 * n] = cvt_pk_bf16(v1[0], v1[1]); p1[2 * n + 1] = cvt_pk_bf16(v1[2], v1[3]); }
#pragma unroll
                for (int i = 0; i < 4; ++i) { const unsigned x = odd ? p0[i] : p1[i]; const unsigned rcv = (unsigned)__builtin_amdgcn_update_dpp(0, (int)x, 0xB1, 0xF, 0xF, false);
                    s0[i] = odd ? rcv : p0[i]; s1[i] = odd ? p1[i] : rcv; }
                bf16_t* rp = O + (size_t)(rowb + ai * 128 + m * 16) * ldc + col;
                *(u32x4*)rp = (u32x4){s0[0], s0[1], s0[2], s0[3]}; *(u32x4*)(rp + ldc) = (u32x4){s1[0], s1[1], s1[2], s1[3]}; }
    }
};
struct EpiSwiGLU {
    static constexpr bool PERM = true;
    unsigned char* H; const float* bg; const float* bu;
    __device__ __forceinline__ void operator()(const f32x4 (&acc)[2][2][4][2], const Unit& u, int wr, int wc, int fr, int fq) const {
        const int row0 = u.r0 + wr * 64 + fr, colf = u.c0 * 128 + wc * 32 + 8 * fq;
        f32x4 gv[2], uv[2];
#pragma unroll
        for (int n = 0; n < 2; ++n) { gv[n] = *(const f32x4*)(bg + (size_t)u.e * 1024 + colf + 4 * n); uv[n] = (*(const f32x4*)(bu + (size_t)u.e * 1024 + colf + 4 * n) + 1.0f) * H8_SCALE; }
#pragma unroll
        for (int ai = 0; ai < 2; ++ai)
#pragma unroll
            for (int m = 0; m < 4; ++m) { float o[8];
#pragma unroll
                for (int n = 0; n < 2; ++n) { const f32x4 g = acc[ai][0][m][n] * (1.0f / W8_SCALE) + gv[n], l = acc[ai][1][m][n] * (H8_SCALE / W8_SCALE) + uv[n];
#pragma unroll
                    for (int j = 0; j < 4; ++j) { const float gl = fminf(g[j], 7.0f), lp = fminf(fmaxf(l[j], -6.0f * H8_SCALE), 8.0f * H8_SCALE);
                        o[4 * n + j] = gl * __builtin_amdgcn_rcpf(1.0f + __builtin_amdgcn_exp2f(gl * (-1.702f * 1.4426950408889634f))) * lp; } }
                u32x2 q; q.x = pack4_fp8(o[0], o[1], o[2], o[3]); q.y = pack4_fp8(o[4], o[5], o[6], o[7]);
                *(u32x2*)(H + blk_off8(row0 + ai * 128 + m * 16, colf)) = q; }
    }
};
struct EpiGLU {
    static constexpr bool PERM = true;
    bf16_t* O;
    __device__ __forceinline__ void operator()(const f32x4 (&acc)[2][2][4][2], const Unit& u, int wr, int wc, int fr, int fq) const {
        const int row0 = u.r0 + wr * 64 + fr, colf = u.c0 * 128 + wc * 32 + 8 * fq;
#pragma unroll
        for (int ai = 0; ai < 2; ++ai)
#pragma unroll
            for (int m = 0; m < 4; ++m) { float o[8];
#pragma unroll
                for (int n = 0; n < 2; ++n) { const f32x4 a = acc[ai][0][m][n], b = acc[ai][1][m][n];
#pragma unroll
                    for (int j = 0; j < 4; ++j) o[4 * n + j] = a[j] * (1.0f / W8_SCALE) * sigmoidf_(b[j] * (1.0f / W8_SCALE)); }
                *(u32x4*)(O + (size_t)(row0 + ai * 128 + m * 16) * 1024 + colf) = pack8(o); }
    }
};
__device__ __forceinline__ void s5_rowmap(int r, int& crow, int& t) {
    if (r < TL) { const int b = r >> 11, l = r & 2047; crow = b * 64 + (l >> 5); t = l & 31; }
    else { const int rc = r - TL, b = rc >> 8, l = rc & 255; crow = 2048 + b * 8 + (l >> 5); t = l & 31; }
}
struct EpiS5U {
    static constexpr bool PERM = true;
    bf16_t* UL;
    __device__ __forceinline__ void operator()(const f32x4 (&acc)[2][2][4][2], const Unit& u, int wr, int wc, int fr, int fq) const {
        const int row0 = u.r0 + wr * 64 + fr, col0 = u.c0 * 256 + wc * 32 + 8 * fq;
#pragma unroll
        for (int ai = 0; ai < 2; ++ai)
#pragma unroll
            for (int m = 0; m < 4; ++m) { int crow, t; s5_rowmap(row0 + ai * 128 + m * 16, crow, t);
#pragma unroll
                for (int bj = 0; bj < 2; ++bj) { const int c = col0 + bj * 128, g = c >> 4; const f32x4 v0 = acc[ai][bj][m][0] * (1.0f / W8_SCALE), v1 = acc[ai][bj][m][1] * (1.0f / W8_SCALE);
                    u32x4 w; w.x = cvt_pk_bf16(v0[0], v0[1]); w.y = cvt_pk_bf16(v0[2], v0[3]); w.z = cvt_pk_bf16(v1[0], v1[1]); w.w = cvt_pk_bf16(v1[2], v1[3]);
                    *(u32x4*)(UL + ((size_t)g * S5ROWS + crow) * S5K + t * 16 + (c & 15)) = w; } }
    }
};
struct EpiS5S {
    static constexpr bool PERM = false;
    float* S;
    __device__ __forceinline__ void operator()(const f32x4 (&acc)[2][2][4][2], const Unit& u, int wr, int wc, int fr, int fq) const {
        const int row0 = u.r0 + wr * 64 + fr, col0 = wc * 32 + 4 * fq;
#pragma unroll
        for (int ai = 0; ai < 2; ++ai)
#pragma unroll
            for (int m = 0; m < 4; ++m) { float* rowp = S + ((size_t)u.e * S5ROWS + row0 + ai * 128 + m * 16) * 256 + col0;
#pragma unroll
                for (int bj = 0; bj < 2; ++bj)
#pragma unroll
                    for (int n = 0; n < 2; ++n) *(f32x4*)(rowp + bj * 128 + n * 16) = acc[ai][bj][m][n]; }
    }
};
__device__ __forceinline__ float gelu_tanh(float x) { const float u = 0.7978845608f * (x + 0.044715f * x * x * x); return x * sigmoidf_(2.0f * u); }
struct EpiS5Y {
    static constexpr bool PERM = true;
    unsigned char* OG;
    __device__ __forceinline__ void operator()(const f32x4 (&acc)[2][2][4][2], const Unit& u, int wr, int wc, int fr, int fq) const {
        const int row0 = u.r0 + wr * 64 + fr, n0 = u.c0 * 256 + wc * 32 + 8 * fq;
#pragma unroll
        for (int ai = 0; ai < 2; ++ai)
#pragma unroll
            for (int m = 0; m < 4; ++m) { const int crow = row0 + ai * 128 + m * 16;
#pragma unroll
                for (int bj = 0; bj < 2; ++bj) { const int n = n0 + bj * 128, t = n >> 4, h0 = n & 15; float o[8];
#pragma unroll
                    for (int j = 0; j < 4; ++j) { o[j] = gelu_tanh(acc[ai][bj][m][0][j]); o[4 + j] = gelu_tanh(acc[ai][bj][m][1][j]); }
                    u32x2 q; q.x = pack4_fp8(o[0], o[1], o[2], o[3]); q.y = pack4_fp8(o[4], o[5], o[6], o[7]);
                    *(u32x2*)(OG + ((size_t)crow * 32 + t) * 1024 + u.e * 16 + h0) = q; } }
    }
};

struct DenseSched {
    pg8::TileOrder T; const char* A; const char* B; size_t astep, bstep;
    __device__ void init(const void* A_, const void* B_, int nM, int nN, int lda, int ldb, int z, int es = 2) { T.init(nM, nN, (int)gridDim.x + z, (int)blockIdx.x + z); A = (const char*)A_; B = (const char*)B_; astep = (size_t)256 * lda * es; bstep = (size_t)256 * ldb * es; }
    __device__ __forceinline__ bool next(int i, Unit& u) const { int pm, pn; if (!T.next(i, pm, pn)) return false;
        u.A = A + pm * astep; u.B = B + pn * bstep; u.gat = nullptr; u.nvalid = 256; u.r0 = pm * 256; u.c0 = pn; u.e = 0; return true; }
};
struct GroupSched {
    const char* A; const char* B; size_t agstep, bgstep, astep, bstep; int nG, nM, nN, G, c;
    __device__ __forceinline__ bool next(int i, Unit& u) const { const long L = (long)i * G + c; if (L >= (long)nG * nM * nN) return false;
        const int per = nM * nN, g = (int)(L / per), rem = (int)(L % per), pm = rem / nN, pn = rem % nN;
        u.A = A + g * agstep + pm * astep; u.B = B + g * bgstep + pn * bstep; u.gat = nullptr; u.nvalid = 256; u.r0 = pm * 256; u.c0 = pn; u.e = g; return true; }
};
struct MoeSched {
    const LAS int* tp; const LAS int* cnt; const LAS int* te  ; int NC, ntiles; bool gather;
    const char* A; const char* B; size_t bestep  ; const int* tok; int CT, G, c; int rowbytes  ; int xrot  ;
    __device__ __forceinline__ bool next(int i, Unit& u) const {
        int rt, ct;
        if (G == 256) { const int xcd = ((c & 7) + 8 - xrot) & 7, j = c >> 3, RPS = 32 / NC; rt = (i * 8 + xcd) * RPS + j / NC; ct = j % NC; }
        else { const long L = (long)i * G + c; rt = (int)(L / NC); ct = (int)(L % NC); }
        if (rt >= ntiles) return false;
        const int e = __builtin_amdgcn_readfirstlane(te[rt]), lt = rt - __builtin_amdgcn_readfirstlane(tp[e]);
        u.e = e; u.r0 = rt * 256; u.c0 = ct; u.nvalid = cnt[e] - lt * 256; u.gat = tok + (size_t)e * CT + lt * 256;
        u.A = gather ? A : A + (size_t)rt * 256 * rowbytes; u.B = B + (size_t)e * bestep + (size_t)ct * 256 * rowbytes; return true;
    }
};

#define TID (P.w0 * 64 + lane_id(P.z))
#define BID ((int)blockIdx.x + P.z)
#define GDIM ((int)gridDim.x + P.z)
#define wave_id() __builtin_amdgcn_readfirstlane(TID >> 6)
__device__ __forceinline__ bf16_t* hbrow(unsigned char* ws, int r) { return r < TL ? (bf16_t*)(ws + WS_HBL) + (size_t)r * D : (bf16_t*)(ws + WS_HBC) + (size_t)(r - TL) * D; }
__device__ __forceinline__ const float* xrow(const float* x, const float* ctx, int r) { return r < TL ? x + (size_t)r * D : ctx + (size_t)(r - TL) * D; }
__device__ __forceinline__ const float* modp(const unsigned char* ws, int layer, int r, int which) { const int mb = r < TL ? (r >> 11) : 32; return (const float*)(ws + WS_MOD) + ((size_t)(layer * 33 + mb) * 6 + which) * D; }

__device__ __forceinline__ void phase_mod(const PL& P, LAS unsigned char* lds) {
    LAS float* sT = (LAS float*)lds; LAS float* red = (LAS float*)(lds + 17 * 1024 * 4);
    const int tid = TID, lane = tid & 63, wave = wave_id();
    float* MOD = (float*)(P.ws() + WS_MOD); const float* cc = P.in(IC); const float* cctx = P.in(ICCTX); const float* adaw = P.in(IADAW); const float* adab = P.in(IADAB);
    for (int rg = 0; rg < 2; ++rg) {
        const int r0 = rg * 17, nr = rg == 0 ? 17 : 16;
        __syncthreads();
        for (int i = tid; i < nr * 1024; i += 512) { const int r = r0 + (i >> 10), k = i & 1023; const float x = r < 32 ? cc[r * 1024 + k] : cctx[k]; sT[i] = x / (1.0f + expf(-x)); }
        __syncthreads();
        for (int cb = BID; cb < 256; cb += GDIM) {
            const int col0 = cb * 48, layer = col0 / 6144, cl0 = col0 % 6144;
            const float* W = adaw + (size_t)layer * 1024 * 6144 + cl0;
            float acc[17];
#pragma unroll
            for (int r = 0; r < 17; ++r) acc[r] = 0.f;
            if (lane < 48) {
#pragma unroll 1
                for (int k = wave * 128; k < wave * 128 + 128; k += 16) {
                    float wk[16];
#pragma unroll
                    for (int q = 0; q < 16; ++q) wk[q] = W[(size_t)(k + q) * 6144 + lane];
#pragma unroll
                    for (int q = 0; q < 16; q += 4)
#pragma unroll
                        for (int r = 0; r < 17; ++r) { if (r < nr) { const f32x4 s4 = *(const LAS f32x4*)(sT + r * 1024 + k + q); PFMA(acc[r], s4.x, wk[q]); PFMA(acc[r], s4.y, wk[q + 1]); PFMA(acc[r], s4.z, wk[q + 2]); PFMA(acc[r], s4.w, wk[q + 3]); }
                            if (r == 16) asm volatile("" ::: "memory"); }
                }
#pragma unroll
                for (int r = 0; r < 17; ++r) red[(wave * 17 + r) * 48 + lane] = acc[r];
            }
            __syncthreads();
            for (int o = tid; o < nr * 48; o += 512) { const int r = o / 48, c = o % 48; float s = 0.f;
#pragma unroll
                for (int w = 0; w < 8; ++w) s += red[(w * 17 + r) * 48 + c];
                MOD[(size_t)(layer * 33 + r0 + r) * 6144 + cl0 + c] = s + adab[layer * 6144 + cl0 + c]; }
            __syncthreads();
        }
    }
}

__device__ __forceinline__ void cvt_item(const float* W, int K, int N, bf16_t* WT, int drow0, LAS float* scr, int kb, int nb, int lane, bool blk = false) {
    const int k0 = 64 * kb, n0 = 32 * nb;
#pragma unroll 8
    for (int i = 0; i < 32; ++i) { const int kk = 2 * i + (lane >> 5); scr[kk * 33 + (lane & 31)] = W[(size_t)(k0 + kk) * N + n0 + (lane & 31)]; }
    LDS_WAIT(); asm volatile("" ::: "memory");
    const int c = lane & 7;
#pragma unroll
    for (int j = 0; j < 4; ++j) { const int n = (lane >> 3) + 8 * j; const LAS float* s = scr + (8 * c) * 33 + n;
        u32x4 o; o.x = cvt_pk_bf16(s[0 * 33], s[1 * 33]); o.y = cvt_pk_bf16(s[2 * 33], s[3 * 33]); o.z = cvt_pk_bf16(s[4 * 33], s[5 * 33]); o.w = cvt_pk_bf16(s[6 * 33], s[7 * 33]);
        *(u32x4*)(WT + (blk ? blk_off(inproj_row(drow0 + n), k0 + 8 * c) : (size_t)(drow0 + n) * K + k0 + 8 * c)) = o; }
    LDS_WAIT(); asm volatile("" ::: "memory");
}
__device__ __forceinline__ void cvt_item8(const float* W, int K, int N, unsigned char* WT, int drow0, LAS float* scr, int kb, int nb, int lane, bool blkperm = false) {
    const int k0 = 64 * kb, n0 = 32 * nb;
#pragma unroll 8
    for (int i = 0; i < 32; ++i) { const int kk = 2 * i + (lane >> 5); scr[kk * 33 + (lane & 31)] = W[(size_t)(k0 + kk) * N + n0 + (lane & 31)]; }
    LDS_WAIT(); asm volatile("" ::: "memory");
    const int n = lane >> 1, kh = (lane & 1) * 32; const LAS float* sp = scr + kh * 33 + n; unsigned w[8];
#pragma unroll
    for (int q = 0; q < 8; ++q) w[q] = pack4_fp8(sp[(4 * q) * 33] * W8_SCALE, sp[(4 * q + 1) * 33] * W8_SCALE, sp[(4 * q + 2) * 33] * W8_SCALE, sp[(4 * q + 3) * 33] * W8_SCALE);
    unsigned char* dst = WT + (blkperm ? blk_off8(inproj_row(drow0 + n), k0 + kh) : (size_t)(drow0 + n) * K + k0 + kh);
    *(u32x4*)dst = (u32x4){w[0], w[1], w[2], w[3]}; *(u32x4*)(dst + 16) = (u32x4){w[4], w[5], w[6], w[7]};
    LDS_WAIT(); asm volatile("" ::: "memory");
}
__device__ __forceinline__ void cvt_matrix_item(const float* W, int N, bf16_t* WT, int mode, LAS float* scr, int item, int lane, bool f8 = false, bool blk = false) {
    const int nblk = N / 32, kb = item / nblk, nb = item % nblk, n0 = nb * 32;
    const int drow0 = mode == 0 ? n0 : ((n0 >> 7) * 256 + (n0 & 127) + (mode == 2 ? 128 : 0));
    if (f8) cvt_item8(W, 1024, N, (unsigned char*)WT, drow0, scr, kb, nb, lane); else cvt_item(W, 1024, N, WT, drow0, scr, kb, nb, lane, blk);
}
__device__ __forceinline__ void phase_cvt_dense(const PL& P, LAS unsigned char* lds) {
    const int lane = TID & 63, wave = wave_id(), gw = BID * 8 + wave, NGW = GDIM * 8;
    LAS float* scr = (LAS float*)(lds + wave * 16384);
    constexpr int I_IN = 16 * 113, I_SQ = 16 * 32, I_R = 16;
    constexpr int NIT = I_IN + 4 * I_SQ + 2 * I_R;
    unsigned char* ws = P.ws(); const float* w_in = P.in(IHYIN); const float* w_out = P.in(IHYOUT); const float* w_s5 = P.in(IS5IN); const float* w_ga = P.in(IGLUA); const float* w_gb = P.in(IGLUB); const float* w_r = P.in(IRW);
    for (int it = gw; it < NIT; it += NGW) { int r = it;
        if (r < I_IN) { const int kb = r / 113, nb = r % 113, ct = nb >> 3;
            if (ct < 10) cvt_item8(w_in, 1024, INW, ws + WS_WIN8, nb * 32, scr, kb, nb, lane, true);
            else cvt_item(w_in, 1024, INW, (bf16_t*)(ws + WS_WIN), nb * 32 - 2560, scr, kb, nb, lane, true);
            continue; } r -= I_IN;
        if (r < I_SQ) { cvt_matrix_item(w_out, 1024, (bf16_t*)(ws + WS_WOUT), 0, scr, r, lane, true); continue; } r -= I_SQ;
        if (r < I_SQ) { cvt_matrix_item(w_s5, 1024, (bf16_t*)(ws + WS_WS5IN), 0, scr, r, lane, true); continue; } r -= I_SQ;
        if (r < I_SQ) { cvt_matrix_item(w_ga, 1024, (bf16_t*)(ws + WS_WGLU), 1, scr, r, lane, true); continue; } r -= I_SQ;
        if (r < I_SQ) { cvt_matrix_item(w_gb, 1024, (bf16_t*)(ws + WS_WGLU), 2, scr, r, lane, true); continue; } r -= I_SQ;
        const int l = r / I_R; r -= l * I_R;
        cvt_matrix_item(w_r + (size_t)l * 1024 * 32, 32, (bf16_t*)(ws + WS_RB) + (size_t)l * 256 * 1024, 0, scr, r, lane);
    }
    const int gt = BID * 512 + TID, NT = GDIM * 512; const u32x4 z = (u32x4){0u, 0u, 0u, 0u};
    for (int i = gt; i < (INWP - INW) * 128; i += NT) *(u32x4*)((bf16_t*)(ws + WS_WIN) + blk_off(inproj_row(1024 + 32 + (i >> 7)), (i & 127) * 8)) = z;
    for (int i = gt; i < 2 * 224 * 128; i += NT) { const int l = i / (224 * 128), j = i % (224 * 128); *((u32x4*)((bf16_t*)(ws + WS_RB) + ((size_t)l * 256 + 32) * 1024) + j) = z; }
}
struct CvtJob { const float* W; unsigned char* WT; int drow0, k0, n0; };
__device__ __forceinline__ void cvt_load128(const CvtJob& j, float (&v)[32], int tid) {
#pragma unroll
    for (int u = 0; u < 8; ++u) { const int idx = tid + 512 * u, n = idx & 127, kq = idx >> 7; const float* src = j.W + (size_t)(j.k0 + 4 * kq) * 1024 + j.n0 + n;
#pragma unroll
        for (int r = 0; r < 4; ++r) v[4 * u + r] = src[(size_t)r * 1024]; }
}
__device__ __forceinline__ void cvt_store128(const CvtJob& j, const float (&v)[32], LAS unsigned* T32, int tid) {
#pragma unroll
    for (int u = 0; u < 8; ++u) { const int idx = tid + 512 * u, n = idx & 127, kq = idx >> 7;
        T32[n * 33 + kq] = pack4_fp8(v[4 * u] * W8_SCALE, v[4 * u + 1] * W8_SCALE, v[4 * u + 2] * W8_SCALE, v[4 * u + 3] * W8_SCALE); }
    LDS_BAR();
#pragma unroll
    for (int u = 0; u < 2; ++u) { const int idx = tid + 512 * u, n = idx >> 3, q = (idx & 7) * 4; const LAS unsigned* sp = T32 + n * 33 + q;
        u32x4 w; w.x = sp[0]; w.y = sp[1]; w.z = sp[2]; w.w = sp[3];
        *(u32x4*)(j.WT + blk_off8(j.drow0 + n, j.k0 + 4 * q)) = w; }
    LDS_BAR();
}
__device__ __forceinline__ CvtJob cvt_moe_job(int it, int layer, const float* wg, const float* wu, const float* wd, unsigned char* WGU, unsigned char* WDN) {
    const int mat = it >> 6, r = it & 63, e = mat / 3, w = mat % 3, kb = r >> 3, nb = r & 7; const size_t eo = ((size_t)layer * 32 + e) * 1024 * 1024; CvtJob j;
    j.W = (w == 0 ? wg : (w == 1 ? wu : wd)) + eo; j.WT = w == 2 ? WDN + (size_t)e * 1024 * 1024 : WGU + (size_t)e * 2048 * 1024; j.drow0 = w == 2 ? nb * 128 : nb * 256 + (w == 1 ? 128 : 0); j.k0 = kb * 128; j.n0 = nb * 128; return j;
}
__device__ __forceinline__ void phase_cvt_moe(const PL& P, LAS unsigned char* lds, int layer) {
    const int tid = TID;
    LAS unsigned* T = (LAS unsigned*)lds;
    unsigned char* WGU = P.ws() + WS_WMOE; unsigned char* WDN = WGU + (size_t)32 * 2048 * 1024; const float* wg = P.in(IWG); const float* wu = P.in(IWU); const float* wd = P.in(IWD);
    __syncthreads();
    int it = BID;
    if (it < 96 * 64) {
        float v[32], vn[32]; CvtJob cur = cvt_moe_job(it, layer, wg, wu, wd, WGU, WDN); cvt_load128(cur, v, tid);
        for (;;) { const int nx = it + GDIM; const bool has = nx < 96 * 64; CvtJob nj = cur; if (has) { nj = cvt_moe_job(nx, layer, wg, wu, wd, WGU, WDN); cvt_load128(nj, vn, tid); }
            cvt_store128(cur, v, T, tid);
            if (!has) break;
#pragma unroll
            for (int u = 0; u < 32; ++u) v[u] = vn[u];
            cur = nj; it = nx; }
    }
}

__device__ __forceinline__ void phase_s5_tables(const PL& P, LAS unsigned char* lds) {
    LAS float* ar = (LAS float*)lds; LAS float* ai = ar + 64; LAS float* fre = ai + 64; LAS float* fim = fre + 64;
    LAS float* Bb = fim + 64;
    LAS float* Cc = Bb + 2048;
    LAS float* lj = Cc + 2048;
    const int tid = TID;
    float* LP = (float*)(P.ws() + WS_LP); float* BB = (float*)(P.ws() + WS_BB); float* KT = (float*)(P.ws() + WS_KT);
    const float* i_ls = P.in(IS5LS); const float* i_are = P.in(IS5ARE); const float* i_aim = P.in(IS5AIM); const float* i_bre = P.in(IS5BRE); const float* i_bim = P.in(IS5BIM); const float* i_cre = P.in(IS5CRE); const float* i_cim = P.in(IS5CIM);
    for (int it = BID; it < 128; it += GDIM) { const int d = it >> 6, g = it & 63, dg = d * 64 + g;
        __syncthreads();
        if (tid < 64) { const float step = expf(i_ls[dg]), are = i_are[dg * 64 + tid], aim = i_aim[dg * 64 + tid];
            const float a_r = are * step, a_i = aim * step, mag = expf(a_r); float sn, cs; sincosf(a_i, &sn, &cs); const float lr = mag * cs, li = mag * sn, den = are * are + aim * aim;
            ar[tid] = a_r; ai[tid] = a_i; fre[tid] = ((lr - 1.0f) * are + li * aim) / den; fim[tid] = (li * are - (lr - 1.0f) * aim) / den; }
        __syncthreads();
        for (int i = tid; i < 1024; i += 512) { const int p = i >> 4; const float br = i_bre[(size_t)dg * 1024 + i], bi = i_bim[(size_t)dg * 1024 + i];
            const float re = fre[p] * br - fim[p] * bi, im = fre[p] * bi + fim[p] * br; Bb[2 * i] = re; Bb[2 * i + 1] = im; BB[((size_t)dg * 1024 + i) * 2] = re; BB[((size_t)dg * 1024 + i) * 2 + 1] = im;
            Cc[2 * i] = i_cre[(size_t)dg * 1024 + i]; Cc[2 * i + 1] = i_cim[(size_t)dg * 1024 + i]; }
        __syncthreads();
        if (tid < 64) {
            for (int j = 0; j <= 32; ++j) { const float m = expf(ar[tid] * (float)j); float sn, cs; sincosf(ai[tid] * (float)j, &sn, &cs);
                LP[(((size_t)dg * 33 + j) * 64 + tid) * 2] = m * cs; LP[(((size_t)dg * 33 + j) * 64 + tid) * 2 + 1] = m * sn; }
            { const float m = expf(ar[tid]); float sn, cs; sincosf(ai[tid], &sn, &cs); lj[2 * tid] = m * cs; lj[2 * tid + 1] = m * sn; }
        }
        __syncthreads();
        if (tid < 256) { const int h = tid >> 4, h2 = tid & 15; float acc[32];
#pragma unroll
            for (int j = 0; j < 32; ++j) acc[j] = 0.f;
            for (int p = 0; p < 64; ++p) { const float cr = Cc[2 * (h * 64 + p)], ci = Cc[2 * (h * 64 + p) + 1], br = Bb[2 * (p * 16 + h2)], bi = Bb[2 * (p * 16 + h2) + 1], lr = lj[2 * p], li = lj[2 * p + 1];
                float zr = cr * br - ci * bi, zi = cr * bi + ci * br;
#pragma unroll
                for (int j = 0; j < 32; ++j) { acc[j] += zr; const float nr = zr * lr - zi * li, ni = zr * li + zi * lr; zr = nr; zi = ni; } }
#pragma unroll
            for (int j = 0; j < 32; ++j) KT[(((size_t)g * 2 + d) * 32 + j) * 256 + tid] = acc[j]; }
    }
}
__device__ __forceinline__ void phase_s5_mats(const PL& P) {
    unsigned char* ws = P.ws(); const float* i_d = P.in(IS5D); const float* i_cre = P.in(IS5CRE); const float* i_cim = P.in(IS5CIM);
    const float* LP = (const float*)(ws + WS_LP); const float* BB = (const float*)(ws + WS_BB); const float* KT = (const float*)(ws + WS_KT);
    bf16_t* MPm = (bf16_t*)(ws + WS_MP); bf16_t* Em = (bf16_t*)(ws + WS_E);
    const int gt = BID * 512 + TID, NT = GDIM * 512;
    for (int idx = gt; idx < 64 * 512 * 96; idx += NT) { const int k8 = idx % 96, n = (idx / 96) & 511, g = idx / (96 * 512), t = n >> 4, h = n & 15; float v[8];
        if (k8 < 64) { const int s = k8 >> 1, h0 = (k8 & 1) * 8;
#pragma unroll
            for (int i = 0; i < 8; ++i) v[i] = 0.f;
            if (s <= t) { const float* kp = KT + (((size_t)g * 2 + 0) * 32 + (t - s)) * 256 + h * 16 + h0;
#pragma unroll
                for (int i = 0; i < 8; ++i) v[i] += kp[i]; }
            if (s >= t) { const float* kp = KT + (((size_t)g * 2 + 1) * 32 + (s - t)) * 256 + h * 16 + h0;
#pragma unroll
                for (int i = 0; i < 8; ++i) v[i] += kp[i]; }
            if (s == t && (h >> 3) == (k8 & 1)) v[h & 7] += i_d[g * 16 + h];
        } else { const int q = (k8 - 64) * 8, seg = q >> 6, p0 = q & 63, d = seg >> 1, im = seg & 1, e = d == 0 ? t + 1 : 32 - t, dg = d * 64 + g;
#pragma unroll
            for (int i = 0; i < 8; ++i) { const int p = p0 + i; const float cr = i_cre[(size_t)dg * 1024 + h * 64 + p], ci = i_cim[(size_t)dg * 1024 + h * 64 + p];
                const float lr = LP[(((size_t)dg * 33 + e) * 64 + p) * 2], li = LP[(((size_t)dg * 33 + e) * 64 + p) * 2 + 1];
                v[i] = im ? -(cr * li + ci * lr) : (cr * lr - ci * li); } }
        *(u32x4*)(MPm + ((size_t)g * 512 + n) * S5K + k8 * 8) = pack8(v); }
    for (int idx = gt; idx < 64 * 256 * 64; idx += NT) { const int k8 = idx & 63, n = (idx >> 6) & 255, g = idx >> 14, seg = n >> 6, p = n & 63, d = seg >> 1, im = seg & 1, s = k8 >> 1, h0 = (k8 & 1) * 8, e = d == 0 ? 31 - s : s, dg = d * 64 + g;
        const float lr = LP[(((size_t)dg * 33 + e) * 64 + p) * 2], li = LP[(((size_t)dg * 33 + e) * 64 + p) * 2 + 1]; float v[8];
#pragma unroll
        for (int i = 0; i < 8; ++i) { const float br = BB[((size_t)dg * 1024 + p * 16 + h0 + i) * 2], bi = BB[((size_t)dg * 1024 + p * 16 + h0 + i) * 2 + 1]; v[i] = im ? (lr * bi + li * br) : (lr * br - li * bi); }
        *(u32x4*)(Em + ((size_t)g * 256 + n) * 512 + k8 * 8) = pack8(v); }
}

__device__ __forceinline__ void norm_mod_row(const float (&x)[16], const float* w, const float* shift, const float* scale, bf16_t* dst, int lane, unsigned char* dst8 = nullptr) {
    float ss = 0.f;
#pragma unroll
    for (int i = 0; i < 16; ++i) ss += x[i] * x[i];
    const float rs = rsqrtf(wave_sum(ss) * (1.0f / 1024.0f) + RMS_EPS);
    float wv[16], sh[16], sc[16], o[16]; ld_row_f32(w, lane, wv); ld_row_f32(shift, lane, sh); ld_row_f32(scale, lane, sc);
#pragma unroll
    for (int i = 0; i < 16; ++i) o[i] = x[i] * rs * wv[i] * (1.0f + sc[i]) + sh[i];
    if (dst) st_row_bf16(dst, lane, o);
    if (dst8) {
#pragma unroll
        for (int j = 0; j < 2; ++j) { u32x2 q; q.x = pack4_fp8(o[8 * j], o[8 * j + 1], o[8 * j + 2], o[8 * j + 3]); q.y = pack4_fp8(o[8 * j + 4], o[8 * j + 5], o[8 * j + 6], o[8 * j + 7]); *(u32x2*)(dst8 + 8 * lane + 512 * j) = q; } }
}
__device__ __forceinline__ void norm_mod_pre(const float (&x)[16], const float (&wv)[16], const float (&sh)[16], const float (&sc)[16], bf16_t* dst, int lane, unsigned char* dst8) {
    float ss = 0.f;
#pragma unroll
    for (int i = 0; i < 16; ++i) ss += x[i] * x[i];
    const float rs = rsqrtf(wave_sum(ss) * (1.0f / 1024.0f) + RMS_EPS); float o[16];
#pragma unroll
    for (int i = 0; i < 16; ++i) o[i] = x[i] * rs * wv[i] * (1.0f + sc[i]) + sh[i];
    if (dst) st_row_bf16(dst, lane, o);
    if (dst8) {
#pragma unroll
        for (int j = 0; j < 2; ++j) { u32x2 q; q.x = pack4_fp8(o[8 * j], o[8 * j + 1], o[8 * j + 2], o[8 * j + 3]); q.y = pack4_fp8(o[8 * j + 4], o[8 * j + 5], o[8 * j + 6], o[8 * j + 7]); *(u32x2*)(dst8 + 8 * lane + 512 * j) = q; } }
}
__device__ __forceinline__ void norm_mod_blk(const float (&x)[16], const float (&wv)[16], const float (&sh)[16], const float (&sc)[16], bf16_t* base, unsigned char* base8, int r, int lane) {
    float ss = 0.f;
#pragma unroll
    for (int i = 0; i < 16; ++i) ss += x[i] * x[i];
    const float rs = rsqrtf(wave_sum(ss) * (1.0f / 1024.0f) + RMS_EPS); float o[16];
#pragma unroll
    for (int i = 0; i < 16; ++i) o[i] = x[i] * rs * wv[i] * (1.0f + sc[i]) + sh[i];
#pragma unroll
    for (int j = 0; j < 2; ++j) *(u32x4*)(base + blk_off(r, 8 * lane + 512 * j)) = pack8(&o[8 * j]);
#pragma unroll
    for (int j = 0; j < 2; ++j) { u32x2 q; q.x = pack4_fp8(o[8 * j], o[8 * j + 1], o[8 * j + 2], o[8 * j + 3]); q.y = pack4_fp8(o[8 * j + 4], o[8 * j + 5], o[8 * j + 6], o[8 * j + 7]); *(u32x2*)(base8 + blk_off8(r, 8 * lane + 512 * j)) = q; }
}
__device__ __forceinline__ void phase_pre0(const PL& P) {
    const int lane = TID & 63, gw = BID * 8 + wave_id(), NGW = GDIM * 8;
    unsigned char* ws = P.ws(); const float* xin = P.in(IX); const float* cin = P.in(ICTX); const float* nw = P.in(IMNPRE);
    bf16_t* A0 = (bf16_t*)(ws + WS_R2); unsigned char* A08 = ws + WS_A2Q;
    float wv[16]; ld_row_f32(nw, lane, wv);
    for (int r = gw; r < TT; r += 2 * NGW) { const int r2 = r + NGW; const bool has2 = r2 < TT;
        float xa[16], sha[16], sca[16], xb[16], shb[16], scb[16];
        ld_row_f32(xrow(xin, cin, r), lane, xa); ld_row_f32(modp(ws, 0, r, 0), lane, sha); ld_row_f32(modp(ws, 0, r, 1), lane, sca);
        if (has2) { ld_row_f32(xrow(xin, cin, r2), lane, xb); ld_row_f32(modp(ws, 0, r2, 0), lane, shb); ld_row_f32(modp(ws, 0, r2, 1), lane, scb); }
        norm_mod_blk(xa, wv, sha, sca, A0, A08, r, lane);
        if (has2) norm_mod_blk(xb, wv, shb, scb, A0, A08, r2, lane); }
}

template <int I0, int NI>
__device__ __forceinline__ void conv_finish(float (&acc)[NI][8], int r, int lane, const LAS float* cbias, float gc0, float gc1, unsigned char* ws) {
    static_assert(NI == 1, "one chunk per pass");
#pragma unroll
    for (int j = 0; j < 8; ++j) { float a = acc[0][j]; if (I0 >= 3) a += cbias[8 * (lane + 64 * (I0 - 3)) + j]; acc[0][j] = siluf(a); }
    if (I0 < 2) { float ss = 0.f;
#pragma unroll
        for (int j = 0; j < 8; ++j) ss += acc[0][j] * acc[0][j];
        ss += __shfl_xor(ss, 1); ss += __shfl_xor(ss, 2); ss += __shfl_xor(ss, 4); ss += __shfl_xor(ss, 8);
        const float sc = rsqrtf(ss + RMS_EPS);
#pragma unroll
        for (int j = 0; j < 8; ++j) acc[0][j] *= sc; }
    if (I0 < 4) { bf16_t* dst = (bf16_t*)(ws + (I0 == 0 ? WS_Q : (I0 == 1 ? WS_K : (I0 == 2 ? WS_V : WS_XS)))); *(u32x4*)(dst + (size_t)r * 512 + 8 * lane) = pack8(acc[0]); }
    else {
        bf16_t* BMm = (bf16_t*)(ws + WS_BM); bf16_t* CMm = (bf16_t*)(ws + WS_CM);
        const float* GATE = (const float*)(ws + WS_GATE); float* G = (float*)(ws + WS_GPOST); float* BETA = G + (size_t)TT * 8; float* DT = BETA + (size_t)TT * 8; float* DA = DT + (size_t)TT * 16;
        if (lane < 32) *(u32x4*)(BMm + (size_t)r * 256 + 8 * lane) = pack8(acc[0]); else *(u32x4*)(CMm + (size_t)r * 256 + 8 * (lane - 32)) = pack8(acc[0]);
        if (lane < 32) { const float raw = GATE[(size_t)r * 32 + lane];
            if (lane < 8) { G[(size_t)r * 8 + lane] = gc0 * softplusf_(raw + gc1); }
            else if (lane < 16) { BETA[(size_t)r * 8 + lane - 8] = 1.0f / (1.0f + expf(-raw)); }
            else { const int j = lane - 16; const float dt = softplusf_(raw + gc1); DT[(size_t)r * 16 + j] = dt; DA[(size_t)r * 16 + j] = gc0 * dt; } }
    }
}
template <int I>
__device__ __forceinline__ void conv_step1(float (&Am)[1][8], float (&Az)[1][8], float (&Ap)[1][8], const u32x4 (&x)[3], const float (&wr)[9][8], int cn, int c0, int rowbase, int lane,
                                           const LAS float* cbias, float gc0, float gc1, unsigned char* ws) {
#pragma unroll
    for (int d = 0; d < 3; ++d) { float xv[8]; unpack8(x[d], xv);
#pragma unroll
        for (int j = 0; j < 8; ++j) { Am[0][j] += xv[j] * wr[d * 3 + 2][j]; Az[0][j] += xv[j] * wr[d * 3 + 1][j]; Ap[0][j] += xv[j] * wr[d * 3 + 0][j]; } }
    const int co = cn - 1;
    if (co >= c0 && co < c0 + 32) conv_finish<I, 1>(Am, rowbase + co, lane, cbias, gc0, gc1, ws);
#pragma unroll
    for (int j = 0; j < 8; ++j) Am[0][j] = 0.f;
}
template <int I>
__device__ __forceinline__ void conv_walk1(int c0, int rr, int nrows, int ncols, int rowbase, int lane, const bf16_t* CA, const bf16_t* CB, const LAS float* cw, const LAS float* cbias, float gc0, float gc1, unsigned char* ws) {
    const int ch = 8 * (lane + 64 * I), pitch = I < 3 ? 1536 : 1024; const bf16_t* src = I < 3 ? CA + ch : CB + ch - 1536;
    float wr[9][8];
#pragma unroll
    for (int tap = 0; tap < 9; ++tap) { const f32x4 w0 = *(const LAS f32x4*)(cw + tap * 2560 + ch), w1 = *(const LAS f32x4*)(cw + tap * 2560 + ch + 4); wr[tap][0] = w0.x; wr[tap][1] = w0.y; wr[tap][2] = w0.z; wr[tap][3] = w0.w; wr[tap][4] = w1.x; wr[tap][5] = w1.y; wr[tap][6] = w1.z; wr[tap][7] = w1.w; }
    const bool rup = rr - 1 >= 0, rdn = rr + 1 < nrows;
#define CONV_LDCOL(cn_, x_) do { const int cq_ = (cn_) < 0 ? 0 : ((cn_) >= ncols ? ncols - 1 : (cn_)); const bool cok_ = (cn_) >= 0 && (cn_) < ncols; \
        const u32x4 z_ = (u32x4){0u, 0u, 0u, 0u}; \
        const u32x4 a_ = *(const u32x4*)(src + (size_t)(rowbase + (rup ? -ncols : 0) + cq_) * pitch), b_ = *(const u32x4*)(src + (size_t)(rowbase + cq_) * pitch), c_ = *(const u32x4*)(src + (size_t)(rowbase + (rdn ? ncols : 0) + cq_) * pitch); \
        x_[0] = (cok_ && rup) ? a_ : z_; x_[1] = cok_ ? b_ : z_; x_[2] = (cok_ && rdn) ? c_ : z_; } while (0)
    float A0[1][8], A1[1][8], A2[1][8];
#pragma unroll
    for (int j = 0; j < 8; ++j) { A0[0][j] = 0.f; A1[0][j] = 0.f; A2[0][j] = 0.f; }
    u32x4 X0[3], X1[3], X2[3], X3[3];
    CONV_LDCOL(c0 - 1, X0); CONV_LDCOL(c0, X1); CONV_LDCOL(c0 + 1, X2); CONV_LDCOL(c0 + 2, X3);
#define CONV_ST(k_, Am_, Az_, Ap_, X_) do { conv_step1<I>(Am_, Az_, Ap_, X_, wr, cn + (k_), c0, rowbase, lane, cbias, gc0, gc1, ws); CONV_LDCOL(cn + (k_) + 4, X_); } while (0)
#pragma unroll 1
    for (int st = 0; st < 36; st += 12) { const int cn = c0 - 1 + st;
        CONV_ST(0, A0, A1, A2, X0); CONV_ST(1, A1, A2, A0, X1); CONV_ST(2, A2, A0, A1, X2); CONV_ST(3, A0, A1, A2, X3);
        CONV_ST(4, A1, A2, A0, X0); CONV_ST(5, A2, A0, A1, X1); CONV_ST(6, A0, A1, A2, X2); CONV_ST(7, A1, A2, A0, X3);
        CONV_ST(8, A2, A0, A1, X0); CONV_ST(9, A0, A1, A2, X1); CONV_ST(10, A1, A2, A0, X2); CONV_ST(11, A2, A0, A1, X3); }
#undef CONV_ST
#undef CONV_LDCOL
}
__device__ __forceinline__ void phase_conv2(const PL& P, LAS unsigned char* lds) {
    LAS float* cw = (LAS float*)lds;
    LAS float* cbias = cw + 9 * 2560;
    const int tid = TID, lane = tid & 63, gw = BID * 8 + wave_id(), NGW = GDIM * 8;
    unsigned char* ws = P.ws();
    { const float* gcw = P.in(IGCW); const float* scw = P.in(ISCW); const float* scb = P.in(ISCB);
    for (int i = tid; i < 9 * 2560; i += 512) { const int tap = i / 2560, c = i % 2560; cw[i] = c < 1536 ? gcw[tap * 1536 + c] : scw[tap * 1024 + c - 1536]; }
    for (int i = tid; i < 1024; i += 512) cbias[i] = scb[i]; }
    float gc0 = 0.f, gc1 = 0.f;
    if (lane < 8) { gc0 = -expf(P.in(IGALOG)[lane]); gc1 = P.in(IGDTB)[lane]; } else if (lane >= 16 && lane < 32) { gc0 = -expf(P.in(ISALOG)[lane - 16]); gc1 = P.in(ISDTB)[lane - 16]; }
    __syncthreads();
    const bf16_t* CA = (const bf16_t*)(ws + WS_CONVA); const bf16_t* CB = (const bf16_t*)(ws + WS_CONVB);
    for (int it2 = gw; it2 < 5 * 2304; it2 += NGW) { const int pass = it2 / 2304, item = it2 - pass * 2304;
        int rr, nrows, ncols, rowbase, c0;
        if (item < 2048) { const int b = item >> 6; rr = (item >> 1) & 31; c0 = (item & 1) * 32; nrows = 32; ncols = 64; rowbase = b * 2048 + rr * 64; }
        else { const int j = item - 2048, b = j >> 3; rr = 0; c0 = (j & 7) * 32; nrows = 1; ncols = 256; rowbase = TL + b * 256; }
        if (pass == 0) conv_walk1<0>(c0, rr, nrows, ncols, rowbase, lane, CA, CB, cw, cbias, gc0, gc1, ws);
        else if (pass == 1) conv_walk1<1>(c0, rr, nrows, ncols, rowbase, lane, CA, CB, cw, cbias, gc0, gc1, ws);
        else if (pass == 2) conv_walk1<2>(c0, rr, nrows, ncols, rowbase, lane, CA, CB, cw, cbias, gc0, gc1, ws);
        else if (pass == 3) conv_walk1<3>(c0, rr, nrows, ncols, rowbase, lane, CA, CB, cw, cbias, gc0, gc1, ws);
        else conv_walk1<4>(c0, rr, nrows, ncols, rowbase, lane, CA, CB, cw, cbias, gc0, gc1, ws);
    }
}

__device__ __forceinline__ int seq_row(int b, int d, int s) { if (s < 256) { const int l = d ? 255 - s : s; return TL + b * 256 + l; } const int l0 = s - 256, l = d ? 2047 - l0 : l0; return b * 2048 + l; }

#define NFMA(r, a, b) asm("v_fma_f32 %0, -%1, %2, %0" : "+v"(r) : "v"(a), "v"(b))
#define MFMA16(a, b, c) __builtin_amdgcn_mfma_f32_16x16x32_bf16((a), (b), (c), 0, 0, 0)
__device__ __forceinline__ bf16x8 fragl(const LAS bf16_t* M, int pitch, int row0, int k0, int lane) { return *(const LAS bf16x8*)(M + (row0 + (lane & 15)) * pitch + k0 + 8 * (lane >> 4)); }
typedef short s16x4 __attribute__((ext_vector_type(4)));
__device__ __forceinline__ bf16x8 fragt(const LAS bf16_t* M, int pitch, int r0, int c0, int lane) {
    const LAS bf16_t* p = M + (r0 + 8 * (lane >> 4) + ((lane & 15) >> 2)) * pitch + c0 + 4 * (lane & 3);
    const s16x4 lo = __builtin_amdgcn_ds_read_tr16_b64_v4i16((LAS s16x4*)p), hi = __builtin_amdgcn_ds_read_tr16_b64_v4i16((LAS s16x4*)(p + 4 * pitch));
    return (bf16x8){lo[0], lo[1], lo[2], lo[3], hi[0], hi[1], hi[2], hi[3]};
}
constexpr int GDN_NCHUNK = 36, GDN_NINST = 256 * GDN_NCHUNK;
constexpr size_t WS_GUT = WS_OGDN, WS_GWT = WS_R2, WS_GQK = 672 * MiB, WS_GEG = WS_GATE;

__device__ __forceinline__ void phase_gdn1m(const PL& P, LAS unsigned char* lds, size_t ut_off) {
    unsigned char* ws = P.ws();
    const bf16_t* Q = (const bf16_t*)(ws + WS_Q); const bf16_t* Kk = (const bf16_t*)(ws + WS_K); const bf16_t* V = (const bf16_t*)(ws + WS_V);
    const float* G = (const float*)(ws + WS_GPOST); const float* BETA = G + (size_t)TT * 8;
    bf16_t* UT = (bf16_t*)(ws + ut_off); bf16_t* WT = (bf16_t*)(ws + WS_GWT); bf16_t* QKo = (bf16_t*)(ws + WS_GQK);
    float* EG = (float*)(ws + WS_GEG); float* EGL = EG + (size_t)GDN_NINST * 64; float* GL = EGL + (size_t)GDN_NINST * 64;
    LAS bf16_t* Kl = (LAS bf16_t*)lds; LAS bf16_t* Ql = Kl + 64 * 136; LAS bf16_t* Vl = Ql + 64 * 136;
    LAS bf16_t* Mb = Vl + 64 * 136;
    LAS float* Md = (LAS float*)(Mb + 64 * 72);
    LAS bf16_t* Tb = (LAS bf16_t*)(Md + 4 * 16 * 20);
    LAS bf16_t* XT = Tb + 4 * 16 * 40;
    LAS bf16_t* YT = XT + 256 * 72;
    LAS float* gcs = (LAS float*)(YT + 256 * 40); LAS float* bet = gcs + 64; LAS float* betw = bet + 64;
    { const int t0 = TID; __syncthreads();
      for (int i = t0; i < (64 * 72 + 4 * 16 * 20 * 2 + 4 * 16 * 40 + 256 * 72 + 256 * 40) / 8; i += 512) *(LAS u32x4*)((LAS unsigned char*)Mb + i * 16) = (u32x4){0u, 0u, 0u, 0u};
      __syncthreads(); }
    u32x4 pf[6]; float pg = 0.f, pbeta = 0.f;
#define GDN1M_PREFETCH(id_) do { const int tid_ = TID + opaque0(), chain_ = (id_) / GDN_NCHUNK, c_ = (id_) % GDN_NCHUNK, d_ = chain_ & 1, h_ = (chain_ >> 1) & 3, b_ = chain_ >> 3; \
        _Pragma("unroll") for (int u_ = 0; u_ < 6; ++u_) { const int idx = tid_ + 512 * u_, wh = idx >> 10, rem = idx & 1023, i = rem >> 4, off = (rem & 15) * 8; const int row = seq_row(b_, d_, c_ * 64 + i); \
            const bf16_t* src = wh == 0 ? Kk : (wh == 1 ? Q : V); pf[u_] = *(const u32x4*)(src + (size_t)row * 512 + h_ * 128 + off); } \
        if (tid_ < 64) { const int row = seq_row(b_, d_, c_ * 64 + tid_); pg = G[(size_t)row * 8 + d_ * 4 + h_]; pbeta = BETA[(size_t)row * 8 + d_ * 4 + h_]; } } while (0)
    if (BID < GDN_NINST) GDN1M_PREFETCH(BID);
    for (int id = BID; id < GDN_NINST; id += GDIM) {
        const int tid = TID + opaque0(), lane = tid & 63, wave = __builtin_amdgcn_readfirstlane(tid >> 6), q4 = lane >> 4, l15 = lane & 15;
        LDS_BAR();
#pragma unroll
        for (int u_ = 0; u_ < 6; ++u_) { const int idx = tid + 512 * u_, wh = idx >> 10, rem = idx & 1023, i = rem >> 4, off = (rem & 15) * 8;
            LAS bf16_t* dst = wh == 0 ? Kl : (wh == 1 ? Ql : Vl); *(LAS u32x4*)(dst + i * 136 + off) = pf[u_]; }
        if (wave == 0) { float gc = pg; const float be = pbeta;
#pragma unroll
            for (int o = 1; o < 64; o <<= 1) { const float t = __shfl_up(gc, o); if (lane >= o) gc += t; }
            const float gl = __shfl(gc, 63);
            gcs[lane] = gc; bet[lane] = be; betw[lane] = be * expf(gc); EG[(size_t)id * 64 + lane] = expf(gc); EGL[(size_t)id * 64 + lane] = expf(gl - gc); if (lane == 0) GL[id] = expf(gl); }
        LDS_BAR();
        if (id + GDIM < GDN_NINST) GDN1M_PREFETCH(id + GDIM);
#pragma unroll 1
        for (int tl = wave; tl < 10; tl += 8) { const int it = tl < 1 ? 0 : (tl < 3 ? 1 : (tl < 6 ? 2 : 3)), jt = tl - (it * (it + 1)) / 2;
            const int i0 = it * 16, i = i0 + l15, j0 = jt * 16 + 4 * q4; const float gci = gcs[i], bi = bet[i]; f32x4 a = (f32x4){0.f, 0.f, 0.f, 0.f}, a2 = a;
#pragma unroll
            for (int k0 = 0; k0 < 128; k0 += 32) { const bf16x8 fj = fragl(Kl, 136, jt * 16, k0, lane); a = MFMA16(fj, fragl(Kl, 136, i0, k0, lane), a); a2 = MFMA16(fj, fragl(Ql, 136, i0, k0, lane), a2); }
            float mv[4], qv[4];
#pragma unroll
            for (int jj = 0; jj < 4; ++jj) { const int j = j0 + jj; const float ex = __expf(fminf(gci - gcs[j], 0.f)); const float dec = (j <= i) ? ex : 0.f; mv[jj] = (j < i) ? bi * a[jj] * dec : 0.f; qv[jj] = a2[jj] * 0.08838834764831845f * dec; }
            if (it == jt) *(LAS f32x4*)(Md + (it * 16 + l15) * 20 + 4 * q4) = (f32x4){mv[0], mv[1], mv[2], mv[3]};
            else { u32x2 w; w.x = cvt_pk_bf16(-mv[0], -mv[1]); w.y = cvt_pk_bf16(-mv[2], -mv[3]); *(LAS u32x2*)(Mb + i * 72 + j0) = w; }
            u32x2 w; w.x = cvt_pk_bf16(qv[0], qv[1]); w.y = cvt_pk_bf16(qv[2], qv[3]); *(u32x2*)(QKo + ((size_t)id * 64 + i) * 64 + j0) = w; }
        if (wave >= 2) { const int tz = wave - 2;
            const int it = tz < 3 ? 0 : (tz < 5 ? 1 : 2), jt = tz < 3 ? tz + 1 : (tz < 5 ? tz - 1 : 3);
            *(u32x2*)(QKo + ((size_t)id * 64 + it * 16 + l15) * 64 + jt * 16 + 4 * q4) = (u32x2){0u, 0u}; }
        LDS_BAR();
        if (tid < 64) { const int I = tid >> 4, c = tid & 15; const LAS float* md = Md + I * 16 * 20; float t[16];
#pragma unroll
            for (int i = 0; i < 16; ++i) { float r = (i == c) ? 1.0f : 0.0f;
#pragma unroll
                for (int j4 = 0; j4 < (i + 3) / 4; ++j4) { const f32x4 m = *(const LAS f32x4*)(md + i * 20 + 4 * j4);
                    NFMA(r, m.x, t[4 * j4]); if (4 * j4 + 1 < i) NFMA(r, m.y, t[4 * j4 + 1]); if (4 * j4 + 2 < i) NFMA(r, m.z, t[4 * j4 + 2]); if (4 * j4 + 3 < i) NFMA(r, m.w, t[4 * j4 + 3]); }
                t[i] = r; Tb[(I * 16 + i) * 40 + c] = f2bf(r); } }
        LDS_BAR();
#pragma unroll
        for (int I = 0; I < 4; ++I) {
            f32x4 acc[2];
#pragma unroll
            for (int tt = 0; tt < 2; ++tt) { const int ct = 2 * wave + tt, c0 = ct * 16, col = (c0 & 127) + l15; const LAS bf16_t* src = ct < 8 ? Vl : Kl; const LAS float* rsc = ct < 8 ? bet : betw;
#pragma unroll
                for (int jj = 0; jj < 4; ++jj) { const int i = 16 * I + 4 * q4 + jj; acc[tt][jj] = rsc[i] * bf1(src[i * 136 + col]); }
                if (I >= 1) { acc[tt] = MFMA16(fragl(Mb, 72, 16 * I, 0, lane), fragl(XT, 72, c0, 0, lane), acc[tt]); if (I == 3) acc[tt] = MFMA16(fragl(Mb, 72, 48, 32, lane), fragl(XT, 72, c0, 32, lane), acc[tt]); }
                u32x2 w; w.x = cvt_pk_bf16(acc[tt][0], acc[tt][1]); w.y = cvt_pk_bf16(acc[tt][2], acc[tt][3]); *(LAS u32x2*)(YT + (c0 + l15) * 40 + 4 * q4) = w; }
#pragma unroll
            for (int tt = 0; tt < 2; ++tt) { const int ct = 2 * wave + tt, c0 = ct * 16, col = (c0 & 127) + l15;
                const f32x4 zero4 = {0.f, 0.f, 0.f, 0.f}; const f32x4 x = MFMA16(fragl(Tb + I * 16 * 40, 40, 0, 0, lane), fragl(YT, 40, c0, 0, lane), zero4);
                u32x2 w; w.x = cvt_pk_bf16(x[0], x[1]); w.y = cvt_pk_bf16(x[2], x[3]);
                *(LAS u32x2*)(XT + (c0 + l15) * 72 + 16 * I + 4 * q4) = w;
                *(u32x2*)((ct < 8 ? UT : WT) + ((size_t)id * 128 + col) * 64 + 16 * I + 4 * q4) = w; }
        }
    }
#undef GDN1M_PREFETCH
}

__device__ __forceinline__ void phase_gdn2(const PL& P, LAS unsigned char* lds, size_t ut_off) {
    const int tid = TID + opaque0(), lane = tid & 63, wave = __builtin_amdgcn_readfirstlane(tid >> 6), q4 = lane >> 4, l15 = lane & 15;
    LAS bf16_t* WTl = (LAS bf16_t*)lds;
    LAS bf16_t* Ql = WTl + 128 * 72;
    LAS bf16_t* Kdl = Ql + 64 * 136;
    LAS bf16_t* QKl = Kdl + 64 * 136;
    LAS bf16_t* VnT = QKl + 64 * 72;
    LAS bf16_t* St = VnT + 128 * 72;
    unsigned char* ws = P.ws();
    const bf16_t* Q = (const bf16_t*)(ws + WS_Q); const bf16_t* Kk = (const bf16_t*)(ws + WS_K);
    bf16_t* UT = (bf16_t*)(ws + ut_off); const bf16_t* WT = (const bf16_t*)(ws + WS_GWT); const bf16_t* QKo = (const bf16_t*)(ws + WS_GQK);
    const float* EG = (const float*)(ws + WS_GEG); const float* EGL = EG + (size_t)GDN_NINST * 64; const float* GL = EGL + (size_t)GDN_NINST * 64;
    const int dv0 = wave * 16;
    for (int chain = BID; chain < 256; chain += GDIM) { const int d = chain & 1, h = (chain >> 1) & 3, b = chain >> 3;
        f32x4 S[8];
#pragma unroll
        for (int t = 0; t < 8; ++t) S[t] = (f32x4){0.f, 0.f, 0.f, 0.f};
        for (int i = lane; i < 16 * 136 / 8; i += 64) *(LAS u32x4*)(St + dv0 * 136 + i * 8) = (u32x4){0u, 0u, 0u, 0u};
        u32x4 pw[2], pq[2], pk[2], pqk; float peg[2], pegl[2]; u32x2 uu[4]; float pgl;
#define GDN2_PREFETCH(c_) do { const size_t id_ = (size_t)chain * GDN_NCHUNK + (c_); _Pragma("unroll") for (int u_ = 0; u_ < 2; ++u_) { const int idx = tid + 512 * u_; \
            { const int dk_ = idx >> 3, i8_ = (idx & 7) * 8; pw[u_] = *(const u32x4*)(WT + (id_ * 128 + dk_) * 64 + i8_); } \
            { const int i_ = idx >> 4, off_ = (idx & 15) * 8; const int row_ = seq_row(b, d, (c_) * 64 + i_); pq[u_] = *(const u32x4*)(Q + (size_t)row_ * 512 + h * 128 + off_); pk[u_] = *(const u32x4*)(Kk + (size_t)row_ * 512 + h * 128 + off_); \
              peg[u_] = EG[id_ * 64 + i_]; pegl[u_] = EGL[id_ * 64 + i_]; } } \
            pqk = *(const u32x4*)(QKo + id_ * 4096 + tid * 8); pgl = GL[id_]; \
            _Pragma("unroll") for (int it_ = 0; it_ < 4; ++it_) uu[it_] = *(const u32x2*)(UT + (id_ * 128 + dv0 + l15) * 64 + it_ * 16 + 4 * q4); } while (0)
        GDN2_PREFETCH(0);
        for (int c = 0; c < GDN_NCHUNK; ++c) { const size_t id = (size_t)chain * GDN_NCHUNK + c;
            __syncthreads();
#pragma unroll
            for (int u_ = 0; u_ < 2; ++u_) { const int idx = tid + 512 * u_;
                { const int dk_ = idx >> 3, i8_ = (idx & 7) * 8; *(LAS u32x4*)(WTl + dk_ * 72 + i8_) = (u32x4){pw[u_].x ^ 0x80008000u, pw[u_].y ^ 0x80008000u, pw[u_].z ^ 0x80008000u, pw[u_].w ^ 0x80008000u}; }
                { const int i_ = idx >> 4, off_ = (idx & 15) * 8; float qv[8], kv[8]; unpack8(pq[u_], qv); unpack8(pk[u_], kv); const float sq = peg[u_] * 0.08838834764831845f, sk = pegl[u_];
#pragma unroll
                  for (int e = 0; e < 8; ++e) { qv[e] *= sq; kv[e] *= sk; }
                  *(LAS u32x4*)(Ql + i_ * 136 + off_) = pack8(qv); *(LAS u32x4*)(Kdl + i_ * 136 + off_) = pack8(kv); } }
            { const int i_ = tid >> 3, j8_ = (tid & 7) * 8; *(LAS u32x4*)(QKl + i_ * 72 + j8_) = pqk; }
            const float glast = pgl;
            f32x4 vn[4], o[4];
#pragma unroll
            for (int it = 0; it < 4; ++it) { vn[it] = (f32x4){bflo(uu[it].x), bfhi(uu[it].x), bflo(uu[it].y), bfhi(uu[it].y)}; o[it] = (f32x4){0.f, 0.f, 0.f, 0.f}; }
            LDS_BAR();
            if (c + 1 < GDN_NCHUNK) GDN2_PREFETCH(c + 1);
#pragma unroll
            for (int k0 = 0; k0 < 128; k0 += 32) { const bf16x8 fs = fragl(St, 136, dv0, k0, lane);
#pragma unroll
                for (int it = 0; it < 4; ++it) { vn[it] = MFMA16(fragt(WTl, 72, k0, it * 16, lane), fs, vn[it]); o[it] = MFMA16(fs, fragl(Ql, 136, it * 16, k0, lane), o[it]); } }
#pragma unroll
            for (int it = 0; it < 4; ++it) { u32x2 w; w.x = cvt_pk_bf16(vn[it][0], vn[it][1]); w.y = cvt_pk_bf16(vn[it][2], vn[it][3]); *(LAS u32x2*)(VnT + (dv0 + l15) * 72 + it * 16 + 4 * q4) = w; }
#pragma unroll
            for (int t = 0; t < 8; ++t) S[t] = S[t] * glast;
#pragma unroll
            for (int j0 = 0; j0 < 64; j0 += 32) { const bf16x8 fv = fragl(VnT, 72, dv0, j0, lane);
#pragma unroll
                for (int it = 0; it < 4; ++it) o[it] = MFMA16(fv, fragl(QKl, 72, it * 16, j0, lane), o[it]);
#pragma unroll
                for (int t = 0; t < 8; ++t) S[t] = MFMA16(fragt(Kdl, 136, j0, t * 16, lane), fv, S[t]); }
#pragma unroll
            for (int it = 0; it < 4; ++it) { u32x2 w; w.x = cvt_pk_bf16(o[it][0], o[it][1]); w.y = cvt_pk_bf16(o[it][2], o[it][3]); *(u32x2*)(UT + (id * 64 + it * 16 + l15) * 128 + dv0 + 4 * q4) = w; }
#pragma unroll
            for (int t = 0; t < 8; ++t) { u32x2 w; w.x = cvt_pk_bf16(S[t][0], S[t][1]); w.y = cvt_pk_bf16(S[t][2], S[t][3]); *(LAS u32x2*)(St + (dv0 + l15) * 136 + t * 16 + 4 * q4) = w; }
        }
#undef GDN2_PREFETCH
        __syncthreads();
    }
}

__device__ __forceinline__ void phase_ssd_chunked(const PL& P, LAS unsigned char* lds, size_t out_off) {
    const int tid = TID + opaque0(), lane = tid & 63, wave = __builtin_amdgcn_readfirstlane(tid >> 6), q4 = lane >> 4, l15 = lane & 15, hl = wave >> 2, pt = wave & 3;
    LAS bf16_t* Cl = (LAS bf16_t*)lds;
    LAS bf16_t* Bl = Cl + 64 * 136;
    LAS bf16_t* HD = Bl + 64 * 136;
    constexpr int HDSZ = 3 * 64 * 72 + 64 * 136;
    LAS float* scal = (LAS float*)(HD + 2 * HDSZ);
    LAS bf16_t* XT1 = HD + hl * HDSZ; LAS bf16_t* XT2 = XT1 + 64 * 72; LAS bf16_t* Sc = XT2 + 64 * 72; LAS bf16_t* Hb = Sc + 64 * 72;
    unsigned char* ws = P.ws();
    const bf16_t* XS = (const bf16_t*)(ws + WS_XS); const bf16_t* BMm = (const bf16_t*)(ws + WS_BM); const bf16_t* CMm = (const bf16_t*)(ws + WS_CM);
    const float* DT = (const float*)(ws + WS_GPOST) + (size_t)TT * 16; const float* DA = DT + (size_t)TT * 16;
    bf16_t* OUT = (bf16_t*)(ws + out_off);
    const int p0 = pt * 16;
    for (int unit = BID; unit < 256; unit += GDIM) { const int hp = unit & 1, d = (unit >> 1) & 1, grp = (unit >> 2) & 1, b = unit >> 3, head = grp * 4 + hp * 2 + hl;
        f32x4 H[8];
#pragma unroll
        for (int t = 0; t < 8; ++t) H[t] = (f32x4){0.f, 0.f, 0.f, 0.f};
        for (int i = lane; i < 16 * 136 / 8; i += 64) *(LAS u32x4*)(Hb + p0 * 136 + i * 8) = (u32x4){0u, 0u, 0u, 0u};
        u32x4 pc[2], pb[2], px[2]; float pdt = 0.f, pda = 0.f;
#define SSD_PREFETCH(c_) do { _Pragma("unroll") for (int u_ = 0; u_ < 2; ++u_) { const int idx = tid + 512 * u_; \
            { const int j_ = idx >> 4, off_ = (idx & 15) * 8; const size_t row_ = (size_t)seq_row(b, d, (c_) * 64 + j_); pc[u_] = *(const u32x4*)(CMm + row_ * 256 + grp * 128 + off_); pb[u_] = *(const u32x4*)(BMm + row_ * 256 + grp * 128 + off_); } \
            { const int h2_ = idx >> 9, rem_ = idx & 511, j_ = rem_ >> 3, off_ = (rem_ & 7) * 8; const size_t row_ = (size_t)seq_row(b, d, (c_) * 64 + j_); px[u_] = *(const u32x4*)(XS + row_ * 512 + (grp * 4 + hp * 2 + h2_) * 64 + off_); } } \
            if (tid < 128) { const int h2_ = tid >> 6, j_ = tid & 63; const size_t row_ = (size_t)seq_row(b, d, (c_) * 64 + j_); pdt = DT[row_ * 16 + d * 8 + grp * 4 + hp * 2 + h2_]; pda = DA[row_ * 16 + d * 8 + grp * 4 + hp * 2 + h2_]; } } while (0)
        SSD_PREFETCH(0);
        for (int c = 0; c < 36; ++c) {
            LDS_BAR();
#pragma unroll
            for (int u_ = 0; u_ < 2; ++u_) { const int idx = tid + 512 * u_, j_ = idx >> 4, off_ = (idx & 15) * 8;
                *(LAS u32x4*)(Cl + j_ * 136 + off_) = pc[u_]; *(LAS u32x4*)(Bl + j_ * 136 + off_) = pb[u_]; }
            if (tid < 128) { const int h2_ = tid >> 6; float acs = pda;
#pragma unroll
                for (int o = 1; o < 64; o <<= 1) { const float t = __shfl_up(acs, o); if (lane >= o) acs += t; }
                const float al = __shfl(acs, 63);
                LAS float* sp = scal + h2_ * 256; sp[lane] = acs; sp[64 + lane] = __expf(acs); sp[128 + lane] = __expf(al - acs); sp[192 + lane] = pdt; if (lane == 0) scal[512 + h2_] = __expf(al); }
            LDS_BAR();
#pragma unroll
            for (int u_ = 0; u_ < 2; ++u_) { const int idx = tid + 512 * u_, h2_ = idx >> 9, rem_ = idx & 511, j_ = rem_ >> 3, off_ = (rem_ & 7) * 8; float xv[8]; unpack8(px[u_], xv);
                const float s1 = scal[h2_ * 256 + 192 + j_], s2 = s1 * scal[h2_ * 256 + 128 + j_]; LAS bf16_t* x1 = HD + h2_ * HDSZ; LAS bf16_t* x2 = x1 + 64 * 72; float x2v[8];
#pragma unroll
                for (int e = 0; e < 8; ++e) { x2v[e] = xv[e] * s2; xv[e] *= s1; }
                *(LAS u32x4*)(x1 + j_ * 72 + off_) = pack8(xv); *(LAS u32x4*)(x2 + j_ * 72 + off_) = pack8(x2v); }
            if (c + 1 < 36) SSD_PREFETCH(c + 1);
            { const LAS float* sp = scal + hl * 256; const int i0 = pt * 16, i = i0 + l15; const float ai = sp[i];
#pragma unroll 1
              for (int jt = 0; jt < 4; ++jt) { const int j0 = jt * 16 + 4 * q4; f32x4 g = (f32x4){0.f, 0.f, 0.f, 0.f};
                  if (jt <= pt) {
#pragma unroll
                      for (int k0 = 0; k0 < 128; k0 += 32) g = MFMA16(fragl(Bl, 136, jt * 16, k0, lane), fragl(Cl, 136, i0, k0, lane), g); }
                  float sv[4];
#pragma unroll
                  for (int jj = 0; jj < 4; ++jj) { const int j = j0 + jj; const float ex = __expf(fminf(ai - sp[j], 0.f)); sv[jj] = (j <= i) ? g[jj] * ex : 0.f; }
                  u32x2 w; w.x = cvt_pk_bf16(sv[0], sv[1]); w.y = cvt_pk_bf16(sv[2], sv[3]); *(LAS u32x2*)(Sc + i * 72 + j0) = w; } }
            LDS_BAR();
            { const LAS float* sp = scal + hl * 256; f32x4 y[4];
#pragma unroll
              for (int it = 0; it < 4; ++it) y[it] = (f32x4){0.f, 0.f, 0.f, 0.f};
#pragma unroll
              for (int n0 = 0; n0 < 128; n0 += 32) { const bf16x8 fh = fragl(Hb, 136, p0, n0, lane);
#pragma unroll
                  for (int it = 0; it < 4; ++it) y[it] = MFMA16(fh, fragl(Cl, 136, it * 16, n0, lane), y[it]); }
#pragma unroll
              for (int it = 0; it < 4; ++it) y[it] = y[it] * sp[64 + it * 16 + l15];
#pragma unroll
              for (int j0 = 0; j0 < 64; j0 += 32) { const bf16x8 fx = fragt(XT1, 72, j0, p0, lane);
#pragma unroll
                  for (int it = 0; it < 4; ++it) y[it] = MFMA16(fx, fragl(Sc, 72, it * 16, j0, lane), y[it]); }
#pragma unroll
              for (int it = 0; it < 4; ++it) { const size_t row = (size_t)seq_row(b, d, c * 64 + it * 16 + l15); u32x2 w; w.x = cvt_pk_bf16(y[it][0], y[it][1]); w.y = cvt_pk_bf16(y[it][2], y[it][3]);
                  *(u32x2*)(OUT + ((size_t)d * TT + row) * 512 + head * 64 + p0 + 4 * q4) = w; } }
            { const float gl = scal[512 + hl];
#pragma unroll
              for (int t = 0; t < 8; ++t) H[t] = H[t] * gl;
#pragma unroll
              for (int j0 = 0; j0 < 64; j0 += 32) { const bf16x8 fx = fragt(XT2, 72, j0, p0, lane);
#pragma unroll
                  for (int t = 0; t < 8; ++t) H[t] = MFMA16(fragt(Bl, 136, j0, t * 16, lane), fx, H[t]); }
#pragma unroll
              for (int t = 0; t < 8; ++t) { u32x2 w; w.x = cvt_pk_bf16(H[t][0], H[t][1]); w.y = cvt_pk_bf16(H[t][2], H[t][3]); *(LAS u32x2*)(Hb + (p0 + l15) * 136 + t * 16 + 4 * q4) = w; } }
        }
#undef SSD_PREFETCH
        __syncthreads();
    }
}

__device__ __forceinline__ void phase_merge(const PL& P) {
    const int lane = TID & 63, gw = BID * 8 + wave_id(), NGW = GDIM * 8;
    const bf16_t* OG = (const bf16_t*)(P.ws() + WS_OGDN); const bf16_t* OS = (const bf16_t*)(P.ws() + WS_OSSD); const bf16_t* Z = (const bf16_t*)(P.ws() + WS_Z); const bf16_t* XS = (const bf16_t*)(P.ws() + WS_XS);
    bf16_t* MIX = (bf16_t*)(P.ws() + WS_R2);
    float gw8[8], sw8[8]; { const float* a = P.in(IGNW) + (8 * lane) % 128; const float* s = P.in(ISNW) + 8 * lane;
#pragma unroll
        for (int j = 0; j < 8; ++j) { gw8[j] = a[j]; sw8[j] = s[j]; } }
    const float dsk = P.in(ISD)[lane >> 3];
    for (int r = gw; r < TT; r += NGW) {
        float of[8], orv[8], za[8], o[8];
        { int bb, sf, sr; if (r < TL) { bb = r >> 11; const int l = r & 2047; sf = 256 + l; sr = 256 + 2047 - l; } else { bb = (r - TL) >> 8; const int l = (r - TL) & 255; sf = l; sr = 255 - l; }
          const size_t chf = (size_t)((bb * 4 + (lane >> 4)) * 2);
          unpack8(*(const u32x4*)(OG + ((chf * 2304 + sf) * 128) + 8 * (lane & 15)), of); unpack8(*(const u32x4*)(OG + (((chf + 1) * 2304 + sr) * 128) + 8 * (lane & 15)), orv); }
        unpack8(*(const u32x4*)(Z + (size_t)r * 1024 + 8 * lane), za);
        float ss = 0.f;
#pragma unroll
        for (int j = 0; j < 8; ++j) { o[j] = of[j] + orv[j]; ss += o[j] * o[j]; }
        ss += __shfl_xor(ss, 1); ss += __shfl_xor(ss, 2); ss += __shfl_xor(ss, 4); ss += __shfl_xor(ss, 8);
        float rs = rsqrtf(ss * (1.0f / 128.0f) + RMS_EPS);
#pragma unroll
        for (int j = 0; j < 8; ++j) o[j] = o[j] * rs * gw8[j] * siluf(za[j]);
        { u32x2 q; q.x = pack4_fp8(o[0], o[1], o[2], o[3]); q.y = pack4_fp8(o[4], o[5], o[6], o[7]); *(u32x2*)((unsigned char*)MIX + (size_t)r * 1024 + 8 * lane) = q; }
        float yf[8], yr[8], xs[8], zb[8], y[8]; unpack8(*(const u32x4*)(OS + (size_t)r * 512 + 8 * lane), yf); unpack8(*(const u32x4*)(OS + ((size_t)TT + r) * 512 + 8 * lane), yr);
        unpack8(*(const u32x4*)(XS + (size_t)r * 512 + 8 * lane), xs); unpack8(*(const u32x4*)(Z + (size_t)r * 1024 + 512 + 8 * lane), zb);
        ss = 0.f;
#pragma unroll
        for (int j = 0; j < 8; ++j) { y[j] = (yf[j] + yr[j] + dsk * xs[j]) * siluf(zb[j]); ss += y[j] * y[j]; }
        ss += __shfl_xor(ss, 1); ss += __shfl_xor(ss, 2); ss += __shfl_xor(ss, 4); ss += __shfl_xor(ss, 8); ss += __shfl_xor(ss, 16);
        rs = rsqrtf(ss * (1.0f / 256.0f) + RMS_EPS);
#pragma unroll
        for (int j = 0; j < 8; ++j) y[j] = y[j] * rs * sw8[j];
        { u32x2 q; q.x = pack4_fp8(y[0], y[1], y[2], y[3]); q.y = pack4_fp8(y[4], y[5], y[6], y[7]); *(u32x2*)((unsigned char*)MIX + (size_t)r * 1024 + 512 + 8 * lane) = q; }
    }
}

__device__ __forceinline__ void phase_post2(const PL& P, LAS unsigned char* lds, int layer, const bf16_t* YM, int nrows, int CT) {
    const int tid = TID, lane = tid & 63, gw = BID * 8 + wave_id(), NGW = GDIM * 8;
    unsigned char* ws = P.ws(); const float* xin = P.in(IX); const float* cin = P.in(ICTX); const float* nwpost = P.in(IMNPOST) + layer * D; const float* nwpre = P.in(IFNPRE) + layer * D;
    LAS bf16_t* Wl = (LAS bf16_t*)lds;
    { const float* rw = P.in(IRW) + (size_t)layer * 1024 * 32; __syncthreads();
      for (int idx = tid; idx < 1024 * 32; idx += 512) { const int c = idx >> 5, e = idx & 31, l = (c & 511) >> 3, j = c >> 9, i = c & 7; Wl[(((e * 2 + j) * 64) + l) * 8 + i] = __builtin_bit_cast(unsigned short, (_Float16)rw[idx]); }
      __syncthreads(); }
    const float rbias = P.in(IRB)[layer * 32 + (lane >> 1)];
    int* RE = (int*)(ws + WS_RE); int* RP = RE + (size_t)TT * 4; float* RG = (float*)(RP + (size_t)TT * 4);
    int* TOK = (int*)(ws + WS_TOK); unsigned* CNT = (unsigned*)(ws + WS_CTL) + CW_CNT + layer * NCH * 32;
    float w[16], wp[16]; ld_row_f32(nwpost, lane, w); ld_row_f32(nwpre, lane, wp);
    const int rpw = (nrows + NGW - 1) / NGW, rbeg = gw * rpw, rend = (rbeg + rpw < nrows) ? rbeg + rpw : nrows;
    float m2v[16], shv[16], scv[16]; int curb = -1;
    u32x4 yq0, yq1; f32x4 xq0, xq1, xq2, xq3;
#define P2_LOAD(rr) do { const bf16_t* yp_ = YM + (size_t)(rr) * D + 8 * lane; yq0 = *(const u32x4*)yp_; yq1 = *(const u32x4*)(yp_ + 512); \
        if (layer == 0) { const float* xp_ = xrow(xin, cin, (rr)) + 8 * lane; xq0 = *(const f32x4*)xp_; xq1 = *(const f32x4*)(xp_ + 4); xq2 = *(const f32x4*)(xp_ + 512); xq3 = *(const f32x4*)(xp_ + 516); } \
        else { const bf16_t* hp_ = hbrow(ws, (rr)) + 8 * lane; xq0 = __builtin_bit_cast(f32x4, *(const u32x4*)hp_); xq1 = __builtin_bit_cast(f32x4, *(const u32x4*)(hp_ + 512)); } } while (0)
    if (rbeg < rend) P2_LOAD(rbeg);
    int pr = -1, pek = 0, ppos = 0, pch = 0;
    for (int r = rbeg; r < rend; ++r) {
        float y[16], x[16]; unpack8(yq0, &y[0]); unpack8(yq1, &y[8]);
        if (layer == 0) { x[0] = xq0.x; x[1] = xq0.y; x[2] = xq0.z; x[3] = xq0.w; x[4] = xq1.x; x[5] = xq1.y; x[6] = xq1.z; x[7] = xq1.w; x[8] = xq2.x; x[9] = xq2.y; x[10] = xq2.z; x[11] = xq2.w; x[12] = xq3.x; x[13] = xq3.y; x[14] = xq3.z; x[15] = xq3.w; }
        else { unpack8(__builtin_bit_cast(u32x4, xq0), &x[0]); unpack8(__builtin_bit_cast(u32x4, xq1), &x[8]); }
        if (r + 1 < rend) P2_LOAD(r + 1);
        const int bb = r < TL ? (r >> 11) : 32;
        if (bb != curb) { curb = bb; ld_row_f32(modp(ws, layer, r, 2), lane, m2v); ld_row_f32(modp(ws, layer, r, 3), lane, shv); ld_row_f32(modp(ws, layer, r, 4), lane, scv); }
        float ss = 0.f;
#pragma unroll
        for (int i = 0; i < 16; ++i) ss += y[i] * y[i];
        float rs = rsqrtf(wave_sum(ss) * (1.0f / 1024.0f) + RMS_EPS);
#pragma unroll
        for (int i = 0; i < 16; ++i) x[i] += m2v[i] * (y[i] * rs * w[i]);
        st_row_bf16(hbrow(ws, r), lane, x);
        ss = 0.f;
#pragma unroll
        for (int i = 0; i < 16; ++i) ss += x[i] * x[i];
        rs = rsqrtf(wave_sum(ss) * (1.0f / 1024.0f) + RMS_EPS);
        float o[16];
#pragma unroll
        for (int i = 0; i < 16; ++i) o[i] = x[i] * rs * wp[i] * (1.0f + scv[i]) + shv[i];
        { unsigned char* dst8 = ws + WS_A2Q;
#pragma unroll
          for (int j = 0; j < 2; ++j) { u32x2 q; q.x = pack4_fp8(o[8 * j], o[8 * j + 1], o[8 * j + 2], o[8 * j + 3]); q.y = pack4_fp8(o[8 * j + 4], o[8 * j + 5], o[8 * j + 6], o[8 * j + 7]); *(u32x2*)(dst8 + blk_off8(r, 8 * lane + 512 * j)) = q; } }
        typedef _Float16 h2v __attribute__((ext_vector_type(2)));
        h2v op[8];
#pragma unroll
        for (int q = 0; q < 8; ++q) { op[q].x = (_Float16)o[2 * q]; op[q].y = (_Float16)o[2 * q + 1]; }
        float pl[32];
        { typedef unsigned short u16x8 __attribute__((ext_vector_type(8))); u32x4 wb[2][8];
#define P2_LDG(buf, g) do { _Pragma("unroll") for (int q = 0; q < 8; ++q) wb[buf][q] = __builtin_bit_cast(u32x4, *(const LAS u16x8*)(Wl + ((((4 * (g) + (q >> 1)) * 2 + (q & 1)) * 64) + lane) * 8)); } while (0)
          P2_LDG(0, 0);
#pragma unroll
          for (int g = 0; g < 8; ++g) { if (g < 7) P2_LDG((g + 1) & 1, g + 1);
#pragma unroll
              for (int ee = 0; ee < 4; ++ee) { float acc = 0.f;
#pragma unroll
                  for (int j = 0; j < 2; ++j) { const u32x4 wv = wb[g & 1][2 * ee + j]; const unsigned w0 = wv.x, w1 = wv.y, w2 = wv.z, w3 = wv.w;
                      acc = __builtin_amdgcn_fdot2(op[4 * j + 0], __builtin_bit_cast(h2v, w0), acc, false); acc = __builtin_amdgcn_fdot2(op[4 * j + 1], __builtin_bit_cast(h2v, w1), acc, false);
                      acc = __builtin_amdgcn_fdot2(op[4 * j + 2], __builtin_bit_cast(h2v, w2), acc, false); acc = __builtin_amdgcn_fdot2(op[4 * j + 3], __builtin_bit_cast(h2v, w3), acc, false); }
                  pl[4 * g + ee] = acc; }
              __builtin_amdgcn_sched_barrier(0); }
#undef P2_LDG
        }
#pragma unroll
        for (int n = 32, m = 32; n >= 2; n >>= 1, m >>= 1) { const bool up = (lane & m) != 0;
#pragma unroll
            for (int k = 0; k < n / 2; ++k) { const float a = pl[k], b = pl[k + n / 2]; const float snd = up ? a : b, keep = up ? b : a; pl[k] = keep + __shfl_xor(snd, m); } }
        float lg = pl[0] + __shfl_xor(pl[0], 1) + rbias;
        const int myexp = lane >> 1;
        const int lgb = __builtin_bit_cast(int, lg); int rank = 0;
#pragma unroll
        for (int e = 0; e < 32; ++e) { const float L = __builtin_bit_cast(float, __builtin_amdgcn_readlane(lgb, 2 * e)); rank += (L > lg || (L == lg && e < myexp)) ? 1 : 0; }
        int sel[4]; float sv[4];
#pragma unroll
        for (int k = 0; k < 4; ++k) { const unsigned long long m = __builtin_amdgcn_ballot_w64(rank == k); const int l = m ? (int)__builtin_ctzll(m) : 0; sel[k] = l >> 1; sv[k] = __builtin_bit_cast(float, __builtin_amdgcn_readlane(lgb, l)); }
        const float e1 = expf(sv[1] - sv[0]), e2 = expf(sv[2] - sv[0]), e3 = expf(sv[3] - sv[0]), inv = 1.0f / (1.0f + e1 + e2 + e3);
        if (lane < 4) { const int ek = lane == 0 ? sel[0] : (lane == 1 ? sel[1] : (lane == 2 ? sel[2] : sel[3])); const float gk = (lane == 0 ? 1.0f : (lane == 1 ? e1 : (lane == 2 ? e2 : e3))) * inv;
            if (pr >= 0) { RP[(size_t)pr * 4 + lane] = ppos; TOK[((size_t)pch * 32 + pek) * CT + ppos] = pr; }
            const int ch = r / CT; ppos = (int)atomicAdd(&CNT[ch * 32 + ek], 1u); pek = ek; pch = ch;
            RE[(size_t)r * 4 + lane] = ek; RG[(size_t)r * 4 + lane] = gk; }
        pr = r;
    }
    if (pr >= 0 && lane < 4) { RP[(size_t)pr * 4 + lane] = ppos; TOK[((size_t)pch * 32 + pek) * CT + ppos] = pr; }
#undef P2_LOAD
}

__device__ __forceinline__ void moe_tables(const PL& P, LAS unsigned char* lds, int layer, int ch) {
    LAS int* cnt = (LAS int*)(lds + LDS_X + (ch & 1) * 512); LAS int* tp = cnt + 32;
    __syncthreads();
    if (TID == 0) { const unsigned* CNT = (const unsigned*)(P.ws() + WS_CTL) + CW_CNT + (layer * NCH + ch) * 32; int acc = 0;
        for (int e = 0; e < 32; ++e) { const int c = (int)__hip_atomic_load(CNT + e, __ATOMIC_RELAXED, __HIP_MEMORY_SCOPE_AGENT); cnt[e] = c; tp[e] = acc; acc += (c + 255) >> 8; } tp[32] = acc; }
    __syncthreads();
    { const int t = TID; LAS int* te = (LAS int*)(lds + LDS_X + 1024 + (ch & 1) * 2048); if (t < 32) { const int t1 = tp[t + 1]; for (int i = tp[t]; i < t1; ++i) te[i] = t; } }
    __syncthreads();
}
__device__ __forceinline__ void combine_acc(const u32x2 (&yq)[8], const u32x4 (&hq)[2], const float (&g)[4], float (&f)[16], float (&x)[16]) {
#pragma unroll
    for (int i = 0; i < 16; ++i) f[i] = 0.f;
#pragma unroll
    for (int k = 0; k < 4; ++k)
#pragma unroll
        for (int j = 0; j < 2; ++j) { const u32x2 w = yq[2 * k + j];
            const f32x2 a = __builtin_amdgcn_cvt_pk_f32_fp8((int)w.x, false), b = __builtin_amdgcn_cvt_pk_f32_fp8((int)w.x, true), c = __builtin_amdgcn_cvt_pk_f32_fp8((int)w.y, false), d = __builtin_amdgcn_cvt_pk_f32_fp8((int)w.y, true);
            f[8 * j] += g[k] * a.x; f[8 * j + 1] += g[k] * a.y; f[8 * j + 2] += g[k] * b.x; f[8 * j + 3] += g[k] * b.y; f[8 * j + 4] += g[k] * c.x; f[8 * j + 5] += g[k] * c.y; f[8 * j + 6] += g[k] * d.x; f[8 * j + 7] += g[k] * d.y; }
    unpack8(hq[0], &x[0]); unpack8(hq[1], &x[8]);
}
__device__ __forceinline__ void phase_combine(const PL& P, LAS unsigned char* lds, int layer, int ch, int CT) {
    const LAS int* tp = (const LAS int*)(lds + LDS_X + (ch & 1) * 512) + 32;
    const int lane = TID & 63, gw = BID * 8 + wave_id(), NGW = GDIM * 8;
    unsigned char* ws = P.ws(); float* outp = P.out(); const float* nwpost = P.in(IFNPOST) + layer * D; const float* nwpre1 = P.in(IMNPRE) + D;
    const int* RE = (const int*)(ws + WS_RE); const int* RP = RE + (size_t)TT * 4; const float* RG = (const float*)(RP + (size_t)TT * 4);
    const unsigned char* Y = ws + WS_Y + (size_t)(ch & 1) * (160 * MiB); unsigned char* A1 = ws + WS_A1;
    const int rpw = (CT + NGW - 1) / NGW, rlim = (ch + 1) * CT, rbeg = ch * CT + gw * rpw, rend = rbeg + rpw < rlim ? rbeg + rpw : rlim;
    float w[16], wv[16], m5[16], sh[16], sc[16]; ld_row_f32(nwpost, lane, w);
#pragma unroll
    for (int i = 0; i < 16; ++i) { wv[i] = 0.f; m5[i] = 0.f; sh[i] = 0.f; sc[i] = 0.f; }
    if (layer == 0) ld_row_f32(nwpre1, lane, wv);
    int curb = -1;
#define CB_LOAD(set, j) do { _Pragma("unroll") for (int k_ = 0; k_ < 4; ++k_) { const int slot_ = __builtin_amdgcn_readlane(slotL, 4 * (j) + k_); const unsigned char* yp_ = Y + (size_t)slot_ * D + 8 * lane; \
            yq[set][2 * k_] = *(const u32x2*)yp_; yq[set][2 * k_ + 1] = *(const u32x2*)(yp_ + 512); } \
        const bf16_t* hp_ = hbrow(ws, g0 + (j)) + 8 * lane; hq[set][0] = *(const u32x4*)hp_; hq[set][1] = *(const u32x4*)(hp_ + 512); } while (0)
#define CB_ROW(set, j) do { const int r = g0 + (j); float f[16], x[16], g_[4]; \
        _Pragma("unroll") for (int k_ = 0; k_ < 4; ++k_) g_[k_] = __builtin_bit_cast(float, __builtin_amdgcn_readlane(gLb, 4 * (j) + k_)); \
        combine_acc(yq[set], hq[set], g_, f, x); \
        if ((j) + 2 < gn) CB_LOAD(set, (j) + 2); \
        const int bb = r < TL ? (r >> 11) : 32; \
        if (bb != curb) { curb = bb; ld_row_f32(modp(ws, layer, r, 5), lane, m5); if (layer == 0) { ld_row_f32(modp(ws, 1, r, 0), lane, sh); ld_row_f32(modp(ws, 1, r, 1), lane, sc); } } \
        float ss = 0.f; \
        _Pragma("unroll") for (int i = 0; i < 16; ++i) ss += f[i] * f[i]; \
        const float rs = rsqrtf(wave_sum(ss) * (1.0f / 1024.0f) + RMS_EPS); \
        _Pragma("unroll") for (int i = 0; i < 16; ++i) x[i] += m5[i] * (f[i] * rs * w[i]); \
        if (layer == 0) { st_row_bf16(hbrow(ws, r), lane, x); norm_mod_pre(x, wv, sh, sc, nullptr, lane, A1 + (size_t)r * D); } else st_row_f32(outp + (size_t)r * D, lane, x); } while (0)
    for (int g0 = rbeg; g0 < rend; g0 += 16) {
        const int gn = rend - g0 < 16 ? rend - g0 : 16;
        int slotL = 0; float gL = 0.f;
        if (lane < 4 * gn) { const int e = RE[(size_t)g0 * 4 + lane], pos = RP[(size_t)g0 * 4 + lane]; gL = RG[(size_t)g0 * 4 + lane]; slotL = tp[e] * 256 + pos; }
        const int gLb = __builtin_bit_cast(int, gL);
        u32x2 yq[2][8]; u32x4 hq[2][2];
        CB_LOAD(0, 0); if (gn > 1) CB_LOAD(1, 1);
        for (int j = 0; j < gn; j += 2) { CB_ROW(0, j); if (j + 1 < gn) CB_ROW(1, j + 1); }
    }
#undef CB_LOAD
#undef CB_ROW
}

__device__ __forceinline__ void phase_s5_scan(const PL& P) {
    const float* S = (const float*)(P.ws() + WS_S5S); const float* LP = (const float*)(P.ws() + WS_LP); bf16_t* UL = (bf16_t*)(P.ws() + WS_UL);
    for (int idx = BID * 512 + TID; idx < 32 * 64 * 2 * 64; idx += GDIM * 512) { const int p = idx & 63, d = (idx >> 6) & 1, g = (idx >> 7) & 63, b = idx >> 13, dg = d * 64 + g;
        const float lr = LP[(((size_t)dg * 33 + 32) * 64 + p) * 2], li = LP[(((size_t)dg * 33 + 32) * 64 + p) * 2 + 1];
        const float* Sg = S + (size_t)g * S5ROWS * 256 + d * 128 + p; bf16_t* Ug = UL + (size_t)g * S5ROWS * S5K + 512 + d * 128 + p;
        float xr = 0.f, xi = 0.f;
        for (int c = 0; c < 8; ++c) { const int cc = d ? 7 - c : c, row = 2048 + b * 8 + cc; const float sr = Sg[(size_t)row * 256], si = Sg[(size_t)row * 256 + 64];
            const float nr = lr * xr - li * xi + sr, ni = lr * xi + li * xr + si; xr = nr; xi = ni; }
#pragma unroll 8
        for (int c = 0; c < 64; ++c) { const int cc = d ? 63 - c : c, row = b * 64 + cc; const float sr = Sg[(size_t)row * 256], si = Sg[(size_t)row * 256 + 64];
            Ug[(size_t)row * S5K] = f2bf(xr); Ug[(size_t)row * S5K + 64] = f2bf(xi);
            const float nr = lr * xr - li * xi + sr, ni = lr * xi + li * xr + si; xr = nr; xi = ni; }
    }
}

__global__ void __launch_bounds__(512, 2) hybrid_fwd(Params Pk) {
    extern __shared__ __attribute__((aligned(16))) unsigned char lds_raw[];
    LAS unsigned char* lds = (LAS unsigned char*)lds_raw;
    volatile LAS unsigned* MISC = (volatile LAS unsigned*)(lds + LDS_MISC);
    for (int u = threadIdx.x; u < 256; u += 512) MISC[u] = 0u;
    __syncthreads();
    if (threadIdx.x < (NIN + 2) * 2) ((LAS unsigned*)(lds + LDS_PARAMS))[threadIdx.x] = ((const unsigned*)&Pk)[threadIdx.x];
    __syncthreads();
    const int w0_ = __builtin_amdgcn_readfirstlane((int)threadIdx.x >> 6); const PL P0{lds, 0, w0_};
    (void)xcd_barrier_post((unsigned*)(P0.ws() + WS_CTL) + CW_BAR, MISC + 8);
#define GRID_BAR() do { SITE; xcd_barrier(P, MISC + 8); } while (0)
#define SITE const int z_ = opaque0(); const PL P{lds + z_, z_, w0_}

    { SITE; phase_mod(P, lds); __syncthreads(); phase_cvt_dense(P, lds); __syncthreads(); phase_s5_tables(P, lds); }
    GRID_BAR();
    { SITE; phase_pre0(P); }
    GRID_BAR();
    { SITE; unsigned char* ws = P.ws(); DenseSched S; S.init(ws + WS_R2, ws + WS_WIN, TT / 256, 5, 1024, 1024, P.z);
      EpiInProj E{(bf16_t*)(ws + WS_CONVA), (bf16_t*)(ws + WS_CONVB), (bf16_t*)(ws + WS_Z), (float*)(ws + WS_GATE), 0};
      pg8::gemm_phase<EpiInProj, DenseSched, false>(lds, 1024, 64, 64, S, E, TID, 256 * 128); }
    { SITE; unsigned char* ws = P.ws(); DenseSched S; S.init(ws + WS_A2Q, ws + WS_WIN8, TT / 256, 10, 1024, 1024, P.z, 1);
      EpiInProj E{(bf16_t*)(ws + WS_CONVA), (bf16_t*)(ws + WS_CONVB), (bf16_t*)(ws + WS_Z), (float*)(ws + WS_GATE), 1};
      pg8::gemm_phase<EpiInProj, DenseSched, false, true>(lds, 1024, 128, 128, S, E, TID, 256 * 128); }
    GRID_BAR();
    { SITE; phase_conv2(P, lds); }
    GRID_BAR();
    { SITE; phase_gdn1m(P, lds, WS_OGDN); }
    GRID_BAR();
    { SITE; phase_gdn2(P, lds, WS_OGDN); __syncthreads(); phase_ssd_chunked(P, lds, WS_OSSD); }
    GRID_BAR();
    { SITE; phase_merge(P); phase_cvt_moe(P, lds, 0); }
    GRID_BAR();
    { SITE; unsigned char* ws = P.ws(); DenseSched S; S.init(ws + WS_R2, ws + WS_WOUT, TT / 256, 4, 1024, 1024, P.z, 1);
      EpiBf16 E{(bf16_t*)(ws + WS_YMIX), 1024, nullptr, 0, 1.0f / W8_SCALE};
      pg8::gemm_phase<EpiBf16, DenseSched, false, true>(lds, 1024, 1024, 1024, S, E, TID);
      }
    GRID_BAR();

#pragma unroll 1
    for (int layer = 0; layer < 2; ++layer) {
        const int ntok = layer == 0 ? TT : TL, CT = ntok / NCH;
        if (layer == 1) {
            { SITE; phase_s5_mats(P); }
            { SITE; unsigned char* ws = P.ws(); DenseSched S; S.init(ws + WS_A1, ws + WS_WS5IN, TT / 256, 4, 1024, 1024, P.z, 1);
              EpiS5U E{(bf16_t*)(ws + WS_UL)};
              pg8::gemm_phase<EpiS5U, DenseSched, false, true>(lds, 1024, 1024, 1024, S, E, TID);
              }
            GRID_BAR();
            { SITE; unsigned char* ws = P.ws(); GroupSched S{(const char*)(ws + WS_UL), (const char*)(ws + WS_E), (size_t)S5ROWS * S5K * 2, (size_t)256 * 512 * 2, (size_t)256 * S5K * 2, 0, 64, S5ROWS / 256, 1, GDIM, BID};
              EpiS5S E{(float*)(ws + WS_S5S)};
              pg8::gemm_phase<EpiS5S, GroupSched, false>(lds, 512, S5K, 512, S, E, TID);
              }
            GRID_BAR();
            { SITE; phase_s5_scan(P); }
            GRID_BAR();
            { SITE; unsigned char* ws = P.ws(); GroupSched S{(const char*)(ws + WS_UL), (const char*)(ws + WS_MP), (size_t)S5ROWS * S5K * 2, (size_t)512 * S5K * 2, (size_t)256 * S5K * 2, (size_t)256 * S5K * 2, 64, 8, 2, GDIM, BID};
              EpiS5Y E{ws + WS_R2};
              pg8::gemm_phase<EpiS5Y, GroupSched, false>(lds, S5K, S5K, S5K, S, E, TID);
              }
            GRID_BAR();
            { SITE; unsigned char* ws = P.ws(); DenseSched S; S.init(ws + WS_R2, ws + WS_WGLU, TL / 256, 8, 1024, 1024, P.z, 1);
              EpiGLU E{(bf16_t*)(ws + WS_YMIX1)};
              pg8::gemm_phase<EpiGLU, DenseSched, false, true>(lds, 1024, 1024, 1024, S, E, TID);
              }
            GRID_BAR();
        }
        { SITE; phase_post2(P, lds, layer, (const bf16_t*)(P.ws() + (layer == 0 ? WS_YMIX : WS_YMIX1)), ntok, CT); }
        GRID_BAR();
#pragma unroll 1
        for (int k = 0; k < NCH + 2; ++k) {
            if (k >= 2) { SITE; phase_combine(P, lds, layer, k - 2, CT); if (layer == 0 && k == NCH + 1) phase_cvt_moe(P, lds, 1); }
            if (k < NCH) { SITE; moe_tables(P, lds, layer, k); }
            int xrot = 0;
            if (k >= 1 && k <= NCH) { SITE; const int ch = k - 1; const LAS int* cnt = (const LAS int*)(lds + LDS_X + (ch & 1) * 512); const LAS int* tp = cnt + 32; unsigned char* ws = P.ws();
              MoeSched S{tp, cnt, (const LAS int*)(lds + LDS_X + 1024 + (ch & 1) * 2048), 4, tp[32], false, (const char*)(ws + WS_H + (size_t)(ch & 1) * (80 * MiB)), (const char*)(ws + WS_WMOE) + (size_t)32 * 2048 * 1024, (size_t)1024 * 1024, nullptr, CT, GDIM, BID, 1024, 0};
              EpiFp8 E{ws + WS_Y + (size_t)(ch & 1) * (160 * MiB), 1024, P.in(IBD) + (size_t)layer * 32 * 1024, 1024, 1.0f / (W8_SCALE * H8_SCALE)};
              pg8::gemm_phase<EpiFp8, MoeSched, false, true>(lds, 1024, 128, 128, S, E, TID, 256 * 128);
              xrot = __builtin_amdgcn_readfirstlane(((tp[32] + 7) >> 3) & 7); }
            if (k < NCH) { SITE; const int ch = k; const LAS int* cnt = (const LAS int*)(lds + LDS_X + (ch & 1) * 512); const LAS int* tp = cnt + 32; unsigned char* ws = P.ws();
              MoeSched S{tp, cnt, (const LAS int*)(lds + LDS_X + 1024 + (ch & 1) * 2048), 8, tp[32], true, (const char*)(ws + WS_A2Q), (const char*)(ws + WS_WMOE), (size_t)2048 * 1024, (const int*)(ws + WS_TOK) + (size_t)ch * 32 * CT, CT, GDIM, BID, 1024, xrot};
              EpiSwiGLU E{ws + WS_H + (size_t)(ch & 1) * (80 * MiB), P.in(IBG) + (size_t)layer * 32 * 1024, P.in(IBU) + (size_t)layer * 32 * 1024};
              pg8::gemm_phase<EpiSwiGLU, MoeSched, true, true>(lds, 1024, 128, 128, S, E, TID, 256 * 128);
              }
            GRID_BAR();
        }
    }
#undef GRID_BAR
}

extern "C" void kernel_launch(void* const* d_in, const int* in_sizes, int n_in, void* d_out, int out_size, void* d_ws, size_t ws_size, hipStream_t stream) {
    static int grid = 0;
    if (grid == 0) {
        if (n_in != NIN || in_sizes[IX] != TL * D || out_size != TL * D || ws_size < WS_END) { fprintf(stderr, "kernel_launch: unexpected shapes (n_in %d, x %d, out %d, ws %zu < %zu); nothing launched\n", n_in, n_in > 0 ? in_sizes[0] : -1, out_size, ws_size, (size_t)WS_END); grid = -1; return; }
        int dev = 0, cus = 0, per_cu = 0;
        if (hipGetDevice(&dev) != hipSuccess || hipDeviceGetAttribute(&cus, hipDeviceAttributeMultiprocessorCount, dev) != hipSuccess) { grid = -1; return; }
        if (hipFuncSetAttribute((const void*)hybrid_fwd, hipFuncAttributeMaxDynamicSharedMemorySize, LDS_BYTES) != hipSuccess) { fprintf(stderr, "kernel_launch: hipFuncSetAttribute failed\n"); grid = -1; return; }
        if (hipOccupancyMaxActiveBlocksPerMultiprocessor(&per_cu, (const void*)hybrid_fwd, 512, LDS_BYTES) != hipSuccess || per_cu < 1) fprintf(stderr, "kernel_launch: occupancy query reports %d\n", per_cu);
        (void)hipGetLastError();
        grid = cus;
    }
    if (grid < 0) return;
    if (hipMemsetAsync((char*)d_ws + WS_CTL, 0, CTL_ZERO_BYTES, stream) != hipSuccess) return;
    Params p; memset(&p, 0, sizeof(p));
    for (int i = 0; i < NIN; ++i) p.in[i] = (const float*)d_in[i];
    p.out = (float*)d_out; p.ws = (unsigned char*)d_ws;
    hipLaunchKernelGGL(hybrid_fwd, dim3(grid), dim3(512), LDS_BYTES, stream, p);
}
```

```cpp
#include <hip/hip_runtime.h>
#include <cstdio>
#include <cstdint>
#include <cstring>

#define LAS __attribute__((address_space(3)))
typedef unsigned short bf16_t;
typedef short bf16x8 __attribute__((ext_vector_type(8)));
typedef float f32x4 __attribute__((ext_vector_type(4)));
typedef float f32x2 __attribute__((ext_vector_type(2)));
typedef unsigned u32x4 __attribute__((ext_vector_type(4)));
typedef unsigned u32x2 __attribute__((ext_vector_type(2)));

constexpr int D = 1024, NBATCH = 32, SEQ = 2048, CTXL = 256;
constexpr int TL = NBATCH * SEQ, TC = NBATCH * CTXL, TT = TL + TC;
constexpr int NEXP = 32;
constexpr int INW = 3616, INWP = 3840;
constexpr float RMS_EPS = 1e-6f;
constexpr int NCH = 4;
constexpr int S5T = 32, S5ROWS = 2304, S5K = 768;

enum { IX = 0, IC, ICTX, ICCTX, IADAW, IADAB, IMNPRE, IMNPOST, IFNPRE, IFNPOST, IRW, IRB, IWG, IBG, IWU, IBU, IWD, IBD, IHYIN, IGCW, IGALOG, IGDTB, IGNW,
       ISCW, ISCB, ISALOG, ISDTB, ISD, ISNW, IHYOUT, IS5IN, IS5ARE, IS5AIM, IS5LS, IS5BRE, IS5BIM, IS5CRE, IS5CIM, IS5D, IGLUA, IGLUB, NIN };

constexpr size_t MiB = 1u << 20;
constexpr size_t WS_CTL = 0, CTL_ZERO_BYTES = 65536;
constexpr size_t WS_R2 = 1 * MiB;
constexpr size_t WS_Z = 145 * MiB;
constexpr size_t WS_H = 145 * MiB;
constexpr size_t WS_Y = 305 * MiB;
constexpr size_t WS_UL = 145 * MiB;
constexpr size_t WS_YMIX1 = 145 * MiB;
constexpr size_t WS_XS = 289 * MiB;
constexpr size_t WS_GATE = 361 * MiB;
constexpr size_t WS_S5S = 361 * MiB;
constexpr size_t WS_GPOST = 370 * MiB;
constexpr size_t WS_CONVA = 384 * MiB;
constexpr size_t WS_OGDN = 384 * MiB;
constexpr size_t WS_YMIX = 384 * MiB;
constexpr size_t WS_MP = 505 * MiB;
constexpr size_t WS_E = 553 * MiB;
constexpr size_t WS_OSSD = 528 * MiB;
constexpr size_t WS_CONVB = 600 * MiB;
constexpr size_t WS_A1 = 625 * MiB;
constexpr size_t WS_Q = 744 * MiB, WS_K = 816 * MiB, WS_V = 888 * MiB;
constexpr size_t WS_WMOE = 768 * MiB;
constexpr size_t WS_A2Q = 864 * MiB;
constexpr float W8_SCALE = 32.0f, H8_SCALE = 4.0f;

constexpr size_t WS_BM = 960 * MiB, WS_CM = 996 * MiB;
constexpr size_t WS_HCTX = 1032 * MiB;
constexpr size_t WS_MOD = 1064 * MiB;
constexpr size_t WS_WIN = 1066 * MiB;
constexpr size_t WS_WOUT = 1074 * MiB;
constexpr size_t WS_RB = 1076 * MiB;
constexpr size_t WS_WS5IN = 1077 * MiB;
constexpr size_t WS_WGLU = 1079 * MiB;
constexpr size_t WS_KT = 1083 * MiB;
constexpr size_t WS_LP = 1087 * MiB;
constexpr size_t WS_BB = 1090 * MiB;
constexpr size_t WS_WIN8 = 1091 * MiB;
constexpr size_t WS_RE = 1100 * MiB;
constexpr size_t WS_TOK = 1104 * MiB;
constexpr size_t WS_HBL = 936 * MiB;
constexpr size_t WS_HBC = 1113 * MiB;
constexpr size_t WS_END = 1129 * MiB;
constexpr int CW_BAR = 4096, CW_CNT = 8192;

constexpr int LDS_BYTES = 147456, LDS_X = 131072  , LDS_MISC = LDS_BYTES - 1024;

__device__ __forceinline__ float bflo(unsigned w) { return __uint_as_float(w << 16); }
__device__ __forceinline__ float bfhi(unsigned w) { return __uint_as_float(w & 0xffff0000u); }
__device__ __forceinline__ float bf1(bf16_t b) { return __uint_as_float(((unsigned)b) << 16); }
typedef __bf16 bf16n2 __attribute__((ext_vector_type(2)));
__device__ __forceinline__ unsigned cvt_pk_bf16(float lo, float hi) { bf16n2 v; v.x = (__bf16)lo; v.y = (__bf16)hi; return __builtin_bit_cast(unsigned, v); }
__device__ __forceinline__ bf16_t f2bf(float f) { return (bf16_t)(cvt_pk_bf16(f, 0.f) & 0xffffu); }
__device__ __forceinline__ unsigned pack4_fp8(float a, float b, float c, float d) { int w = 0; w = __builtin_amdgcn_cvt_pk_fp8_f32(a, b, w, false); w = __builtin_amdgcn_cvt_pk_fp8_f32(c, d, w, true); return (unsigned)w; }
template <int CTRL, int RM = 0xF, int BM = 0xF> __device__ __forceinline__ float dppmov(float old, float src) { return __builtin_bit_cast(float, __builtin_amdgcn_update_dpp(__builtin_bit_cast(int, old), __builtin_bit_cast(int, src), CTRL, RM, BM, false)); }
__device__ __forceinline__ float wave_sum(float v) {
    v += dppmov<0xB1>(v, v); v += dppmov<0x4E>(v, v); v += dppmov<0x141>(v, v); v += dppmov<0x140>(v, v);
    const int b = __builtin_bit_cast(int, v);
    return (__builtin_bit_cast(float, __builtin_amdgcn_readlane(b, 0)) + __builtin_bit_cast(float, __builtin_amdgcn_readlane(b, 16))) + (__builtin_bit_cast(float, __builtin_amdgcn_readlane(b, 32)) + __builtin_bit_cast(float, __builtin_amdgcn_readlane(b, 48)));
}
__device__ __forceinline__ float siluf(float x) { return x * __builtin_amdgcn_rcpf(1.0f + __expf(-x)); }
__device__ __forceinline__ float sigmoidf_(float x) { return __builtin_amdgcn_rcpf(1.0f + __expf(-x)); }
__device__ __forceinline__ float softplusf_(float x) { return x > 20.f ? x : log1pf(expf(x)); }
#define PFMA(r, a, b) asm("v_fmac_f32 %0, %1, %2" : "+v"(r) : "v"(a), "v"(b))
#define LDS_WAIT() asm volatile("s_waitcnt lgkmcnt(0)" ::: "memory")
#define VM_WAIT() asm volatile("s_waitcnt vmcnt(0)" ::: "memory")
#define LDS_BAR() do { asm volatile("s_waitcnt lgkmcnt(0)" ::: "memory"); __builtin_amdgcn_s_barrier(); asm volatile("" ::: "memory"); } while (0)

__device__ __forceinline__ void ld_row_f32(const float* p, int lane, float (&v)[16]) {
#pragma unroll
    for (int j = 0; j < 2; ++j) { const f32x4 a = *(const f32x4*)(p + 8 * lane + 512 * j), b = *(const f32x4*)(p + 8 * lane + 512 * j + 4);
        v[8 * j + 0] = a.x; v[8 * j + 1] = a.y; v[8 * j + 2] = a.z; v[8 * j + 3] = a.w; v[8 * j + 4] = b.x; v[8 * j + 5] = b.y; v[8 * j + 6] = b.z; v[8 * j + 7] = b.w; }
}
__device__ __forceinline__ void st_row_f32(float* p, int lane, const float (&v)[16]) {
#pragma unroll
    for (int j = 0; j < 2; ++j) { *(f32x4*)(p + 8 * lane + 512 * j) = (f32x4){v[8 * j], v[8 * j + 1], v[8 * j + 2], v[8 * j + 3]}; *(f32x4*)(p + 8 * lane + 512 * j + 4) = (f32x4){v[8 * j + 4], v[8 * j + 5], v[8 * j + 6], v[8 * j + 7]}; }
}
__device__ __forceinline__ void unpack8(const u32x4 w, float* v) { v[0] = bflo(w.x); v[1] = bfhi(w.x); v[2] = bflo(w.y); v[3] = bfhi(w.y); v[4] = bflo(w.z); v[5] = bfhi(w.z); v[6] = bflo(w.w); v[7] = bfhi(w.w); }
__device__ __forceinline__ u32x4 pack8(const float* v) { u32x4 w; w.x = cvt_pk_bf16(v[0], v[1]); w.y = cvt_pk_bf16(v[2], v[3]); w.z = cvt_pk_bf16(v[4], v[5]); w.w = cvt_pk_bf16(v[6], v[7]); return w; }
__device__ __forceinline__ size_t blk_off(int r, int c) { return (size_t)(r >> 8) * (256 * 1024) + (size_t)(c >> 6) * (256 * 64) + (size_t)(r & 255) * 64 + (c & 63); }
__device__ __forceinline__ int inproj_row(int n) { const int c = n & 255; return (n & ~255) + 128 * ((c >> 5) & 1) + 32 * (c >> 6) + (c & 31); }
__device__ __forceinline__ size_t blk_off8(int r, int c) { return (size_t)(r >> 8) * (256 * 1024) + (size_t)(c >> 7) * (256 * 128) + (size_t)(r & 255) * 128 + (c & 127); }
__device__ __forceinline__ void ld_row_bf16(const bf16_t* p, int lane, float (&v)[16]) {
#pragma unroll
    for (int j = 0; j < 2; ++j) { const u32x4 w = *(const u32x4*)(p + 8 * lane + 512 * j); unpack8(w, &v[8 * j]); }
}
__device__ __forceinline__ void ld_row_fp8(const unsigned char* p, int lane, float (&v)[16]) {
#pragma unroll
    for (int j = 0; j < 2; ++j) { const u32x2 w = *(const u32x2*)(p + 8 * lane + 512 * j);
        const f32x2 a = __builtin_amdgcn_cvt_pk_f32_fp8((int)w.x, false), b = __builtin_amdgcn_cvt_pk_f32_fp8((int)w.x, true), c = __builtin_amdgcn_cvt_pk_f32_fp8((int)w.y, false), d = __builtin_amdgcn_cvt_pk_f32_fp8((int)w.y, true);
        v[8 * j] = a.x; v[8 * j + 1] = a.y; v[8 * j + 2] = b.x; v[8 * j + 3] = b.y; v[8 * j + 4] = c.x; v[8 * j + 5] = c.y; v[8 * j + 6] = d.x; v[8 * j + 7] = d.y; }
}
__device__ __forceinline__ void st_row_bf16(bf16_t* p, int lane, const float (&v)[16]) {
#pragma unroll
    for (int j = 0; j < 2; ++j) *(u32x4*)(p + 8 * lane + 512 * j) = pack8(&v[8 * j]);
}

__device__ __forceinline__ int lane_id(int z) { return (int)__builtin_amdgcn_mbcnt_hi(~0u, __builtin_amdgcn_mbcnt_lo(~0u, (unsigned)z)); }
#define XB_TMO      128
#define XB_XCNT(j)  (256  + 64 * (j))
#define XB_XSUB(j)  (1280 + 64 * (j))
#define XB_XGEN(j)  (2304 + 64 * (j))
#define XB_TOP      3328
#define XB_TOPGEN   3392
#define XCD_BAR_WORDS 3456
#define XB_SPIN_CAP (1u << 22)
__device__ __forceinline__ unsigned xb_ld(unsigned* p)              { return __hip_atomic_load(p, __ATOMIC_RELAXED, __HIP_MEMORY_SCOPE_AGENT); }
__device__ __forceinline__ unsigned xb_add(unsigned* p, unsigned v) { return __hip_atomic_fetch_add(p, v, __ATOMIC_RELAXED, __HIP_MEMORY_SCOPE_AGENT); }
__device__ __forceinline__ unsigned xb_xcc_id() { return (unsigned)__builtin_amdgcn_s_getreg((3 << 11) | 20) & 0xFu; }
#define XB_SPIN(cond, bar) do { unsigned _sp = 0; while (cond) { __builtin_amdgcn_s_sleep(1); \
    if ((++_sp & 255u) == 0u) { if (xb_ld(&(bar)[XB_TMO])) break; if (_sp > XB_SPIN_CAP) { atomicAdd(&(bar)[XB_TMO], 1u); break; } } } } while (0)
struct XcdBarrier { unsigned* bar; unsigned x; volatile LAS unsigned* st; };
__device__ __forceinline__ XcdBarrier xcd_barrier_post(unsigned* bar, volatile LAS unsigned* st) {
    XcdBarrier b; b.bar = bar; b.x = xb_xcc_id(); b.st = st;
    if (threadIdx.x == 0) (void)xb_add(&bar[XB_XCNT(b.x)], 1u);
    return b;
}
__device__ __forceinline__ void xcd_barrier_complete(unsigned* bar, unsigned x, unsigned& nloc, unsigned& nx) {
    const unsigned G = gridDim.x * gridDim.y * gridDim.z;
    unsigned sum, cnt, mine, sp = 0u;
    for (;;) {
        sum = 0u; cnt = 0u; mine = 0u;
#pragma unroll
        for (unsigned j = 0; j < 16; ++j) { const unsigned c = xb_ld(&bar[XB_XCNT(j)]); sum += c; cnt += (c > 0u) ? 1u : 0u; mine = (j == x) ? c : mine; }
        if (sum == G) break;
        __builtin_amdgcn_s_sleep(1);
        if ((++sp & 255u) == 0u) { if (xb_ld(&bar[XB_TMO])) break; if (sp > XB_SPIN_CAP) { atomicAdd(&bar[XB_TMO], 1u); break; } }
    }
    nloc = mine > 0u ? mine : 1u; nx = cnt > 0u ? cnt : 1u;
}
template <class PLT> __device__ __forceinline__ void xcd_barrier(const PLT& P, volatile LAS unsigned* st) {
    asm volatile("s_waitcnt vmcnt(0)" ::: "memory");
    __syncthreads();
    if (P.w0 == 0 && lane_id(P.z) == 0) {
        XcdBarrier b; b.bar = (unsigned*)(P.ws() + WS_CTL) + CW_BAR; b.x = xb_xcc_id(); b.st = st;
        unsigned* bar = b.bar;
        __builtin_amdgcn_s_waitcnt(0);
        unsigned nloc = b.st[0], nx = b.st[1];
        if (nloc == 0u) { xcd_barrier_complete(bar, b.x, nloc, nx); b.st[0] = nloc; b.st[1] = nx; }
        const unsigned old = xb_add(&bar[XB_XSUB(b.x)], 1u);
        const unsigned gen = old / nloc;
        if (old + 1u == (gen + 1u) * nloc) {
            __builtin_amdgcn_fence(__ATOMIC_RELEASE, "agent");
            asm volatile("s_waitcnt vmcnt(0)" ::: "memory");
            const unsigned og = xb_add(&bar[XB_TOP], 1u);
            const unsigned tg = og / nx;
            if (og + 1u == (tg + 1u) * nx) xb_add(&bar[XB_TOPGEN], 1u);
            else XB_SPIN(xb_ld(&bar[XB_TOPGEN]) == tg, bar);
            __builtin_amdgcn_fence(__ATOMIC_ACQUIRE, "agent");
            xb_add(&bar[XB_XGEN(b.x)], 1u);
            asm volatile("s_waitcnt vmcnt(0)" ::: "memory");
        } else {
            XB_SPIN(xb_ld(&bar[XB_XGEN(b.x)]) == gen, bar);
            __builtin_amdgcn_fence(__ATOMIC_ACQUIRE, "agent");
            asm volatile("s_waitcnt vmcnt(0)" ::: "memory");
        }
    }
    __syncthreads();
}

namespace pg8 {
constexpr int BM = 256, BK = 64, HALF = 128, HTB = HALF * BK * 2, STAGE_BYTES = 8 * HTB, NXCD = 8, WGM = 8;
__device__ __forceinline__ int lds_byte(int r, int c) { const int st = (r >> 4) * 2 + (c >> 5), rr = r & 15, cc = c & 31, ob = rr * 64 + cc * 2; return st * 1024 + (ob ^ (((ob >> 9) & 1) << 5)); }
__device__ __forceinline__ void stage_rc(int b, int& R, int& C) { const int st = b / 1024, sb = b % 1024, swz = sb ^ (((sb >> 9) & 1) << 5); R = (st >> 1) * 16 + swz / 64; C = (st & 1) * 32 + (swz % 64) / 2; }
__device__ __forceinline__ int perm32(int rho) { const int n = rho >> 4, i = rho & 15; return 8 * (i >> 2) + 4 * n + (i & 3); }

struct Unit { const char* A; const char* B; const int* gat; int nvalid; int r0, c0, e; };

struct TileOrder {
    int nM, nN, nwg, G, c;
    __device__ void init(int nM_, int nN_, int G_, int c_) { nM = nM_; nN = nN_; nwg = nM * nN; G = G_; c = c_; }
    __device__ bool next(int i, int& pm, int& pn) const {
        const long L = (long)i * G + c; if (L >= nwg) return false;
        int wgid = (int)L; { const int q = nwg / NXCD, r = nwg % NXCD, xcd = wgid % NXCD, off = wgid / NXCD; wgid = (xcd < r ? xcd * (q + 1) : r * (q + 1) + (xcd - r) * q) + off; }
        const int nig = WGM * nN, gid = wgid / nig, fm = gid * WGM, gsz = (nM - fm) < WGM ? (nM - fm) : WGM;
        pm = fm + ((wgid % nig) % gsz); pn = (wgid % nig) / gsz; return true;
    }
};

typedef int v8i32 __attribute__((ext_vector_type(8)));
template <class Epi, class Sched, bool GATHER, bool FP8 = false>
__device__ __forceinline__ void gemm_phase(LAS unsigned char* lds, const int K, const int lda, const int ldb, const Sched& S, const Epi& E, const int tid, const int kstepb = BK * 2) {
    constexpr int ES = FP8 ? 1 : 2;
    const int wid = __builtin_amdgcn_readfirstlane(tid >> 6), lane = tid & 63, wr = wid >> 2, wc = wid & 3, fr = lane & 15, fq = lane >> 4;
    const int nt = K / (FP8 ? 2 * BK : BK);
    unsigned cvA[2][2], nvA[2][2], voffB[2]; int stR[2], stC[2];
#pragma unroll
    for (int i = 0; i < 2; ++i) { int R, C; stage_rc(tid * 16 + i * 8192, R, C); stR[i] = R; stC[i] = C; const int Rb = Epi::PERM ? ((R & ~31) + perm32(R & 31)) : R;
        voffB[i] = (unsigned)(Rb * ldb * ES + C * 2);
#pragma unroll
        for (int h = 0; h < 2; ++h) { cvA[h][i] = (unsigned)((R + HALF * h) * lda * ES + C * 2); nvA[h][i] = cvA[h][i]; } }
    const size_t kstep = (size_t)kstepb;
    const size_t hstepB = (size_t)HALF * ldb * ES;
    const unsigned ldsw = (unsigned)wid * 1024u;
    const int aoff0 = lds_byte(wr * 64 + fr, fq * 8), aoff1 = aoff0 + 1024;
    const int boff0 = lds_byte(wc * 32 + fr, fq * 8), boff1 = boff0 + 1024;
    LAS unsigned char* pA = lds + aoff0; LAS unsigned char* pB = lds + 4 * HTB + boff0;
    asm volatile("" : "+v"(pA), "+v"(pB));
#define PG8_SA(b, h) (((b) * 2 + (h)) * HTB)
#define PG8_SB(b, h) ((4 + (b) * 2 + (h)) * HTB)
#define PG8_STAGE(bufoff, gbase, v0, v1) do { \
        __builtin_amdgcn_global_load_lds((const unsigned*)((const char*)(gbase) + (v0)), (LAS unsigned*)(lds + (bufoff) + ldsw), 16, 0, 0); \
        __builtin_amdgcn_global_load_lds((const unsigned*)((const char*)(gbase) + (v1)), (LAS unsigned*)(lds + (bufoff) + ldsw + 8192), 16, 0, 0); } while (0)
#define PG8_LD32(addr0, addr1) __builtin_bit_cast(v8i32, __builtin_shufflevector(*(const LAS u32x4*)(addr0), *(const LAS u32x4*)(addr1), 0, 1, 2, 3, 4, 5, 6, 7))
#define PG8_LDA(dst, b, h) do { _Pragma("unroll") for (int m = 0; m < 4; ++m) { if constexpr (FP8) dst##8[m] = PG8_LD32(pA + PG8_SA(b, h) + m * 2048, pA + PG8_SA(b, h) + (aoff1 - aoff0) + m * 2048); \
        else { _Pragma("unroll") for (int k = 0; k < 2; ++k) dst[m][k] = *(const LAS bf16x8*)(pA + PG8_SA(b, h) + (k ? aoff1 - aoff0 : 0) + m * 2048); } } } while (0)
#define PG8_LDB(dst, b, h) do { _Pragma("unroll") for (int n = 0; n < 2; ++n) { if constexpr (FP8) dst##8[n] = PG8_LD32(pB + (PG8_SB(b, h) - 4 * HTB) + n * 2048, pB + (PG8_SB(b, h) - 4 * HTB) + (boff1 - boff0) + n * 2048); \
        else { _Pragma("unroll") for (int k = 0; k < 2; ++k) dst[n][k] = *(const LAS bf16x8*)(pB + (PG8_SB(b, h) - 4 * HTB) + (k ? boff1 - boff0 : 0) + n * 2048); } } } while (0)
#define PG8_CAT(x0, x1) __builtin_shufflevector(__builtin_bit_cast(u32x4, x0), __builtin_bit_cast(u32x4, x1), 0, 1, 2, 3, 4, 5, 6, 7)
#define PG8_MMA(ai, bj, At, Bt) do { __builtin_amdgcn_s_setprio(1); _Pragma("unroll") for (int m = 0; m < 4; ++m) _Pragma("unroll") for (int n = 0; n < 2; ++n) { \
        if constexpr (FP8) asm volatile("v_mfma_f32_16x16x128_f8f6f4 %0, %1, %2, %0" : "+v"(acc[ai][bj][m][n]) : "v"(Bt##8[n]), "v"(At##8[m]));   \
        else { _Pragma("unroll") for (int k = 0; k < 2; ++k) acc[ai][bj][m][n] = __builtin_amdgcn_mfma_f32_16x16x32_bf16(Bt[n][k], At[m][k], acc[ai][bj][m][n], 0, 0, 0); } } __builtin_amdgcn_s_setprio(0); } while (0)
#define PG8_WAIT_V(n) asm volatile("s_waitcnt vmcnt(" #n ")" ::: "memory")
#define PG8_WAIT_L(n) asm volatile("s_waitcnt lgkmcnt(" #n ")" ::: "memory")
#define PG8_BAR __builtin_amdgcn_s_barrier()
#define PG8_SCHED __builtin_amdgcn_sched_barrier(0)
#define PG8_GATHER(u, dst) do { _Pragma("unroll") for (int h = 0; h < 2; ++h) _Pragma("unroll") for (int i = 0; i < 2; ++i) { const int rr = h * HALF + stR[i]; \
        const int tok = (rr < (u).nvalid) ? (u).gat[rr] : 0; dst[h][i] = kstepb == BK * 2 ? (unsigned)(tok * lda * ES + stC[i] * 2) : (unsigned)((tok >> 8) * (256 * 1024) + (tok & 255) * 128 + stC[i] * 2); } } while (0)
    Unit cur, nxt; int ui = 0;
    if (!S.next(0, cur)) return;
    f32x4 acc[2][2][4][2];
#pragma unroll
    for (int a = 0; a < 2; ++a)
#pragma unroll
        for (int b = 0; b < 2; ++b)
#pragma unroll
            for (int m = 0; m < 4; ++m)
#pragma unroll
                for (int n = 0; n < 2; ++n) acc[a][b][m][n] = (f32x4){0.f, 0.f, 0.f, 0.f};
    bf16x8 At[4][2], B0[2][2], B1[2][2]; v8i32 At8[4], B08[2], B18[2];
    if constexpr (GATHER) { PG8_GATHER(cur, cvA); }
    const char* cA = cur.A; const char* cB = cur.B;
    PG8_STAGE(PG8_SB(0, 0), cB, voffB[0], voffB[1]); PG8_STAGE(PG8_SB(0, 1), cB + hstepB, voffB[0], voffB[1]); PG8_STAGE(PG8_SA(0, 0), cA, cvA[0][0], cvA[0][1]); PG8_STAGE(PG8_SA(0, 1), cA, cvA[1][0], cvA[1][1]);
    if (wr == 1) PG8_BAR;
    PG8_WAIT_V(2); PG8_BAR;
    PG8_STAGE(PG8_SB(1, 0), cB + kstep, voffB[0], voffB[1]); PG8_STAGE(PG8_SA(1, 0), cA + kstep, cvA[0][0], cvA[0][1]); PG8_STAGE(PG8_SB(1, 1), cB + hstepB + kstep, voffB[0], voffB[1]);
    PG8_WAIT_V(6); PG8_BAR;
    for (;;) {
        const bool has_next = S.next(ui + 1, nxt);
        if constexpr (GATHER) { if (has_next) { PG8_GATHER(nxt, nvA); } else {
#pragma unroll
            for (int h = 0; h < 2; ++h)
#pragma unroll
                for (int i = 0; i < 2; ++i) nvA[h][i] = cvA[h][i]; } }
        const char* nA = has_next ? nxt.A : cA; const char* nB = has_next ? nxt.B : cB;
#pragma unroll 1
        for (int t = 0; t < nt; t += 2) {
            const bool last = (t == nt - 2);
            const char* a1 = cA + (size_t)(t + 1) * kstep;
            const char* a2 = last ? nA : cA + (size_t)(t + 2) * kstep; const char* b2 = last ? nB : cB + (size_t)(t + 2) * kstep;
            asm volatile("" : "+s"(a1), "+s"(a2), "+s"(b2));
            asm volatile("" : "+v"(voffB[0]), "+v"(voffB[1]), "+v"(cvA[0][0]), "+v"(cvA[0][1]), "+v"(cvA[1][0]), "+v"(cvA[1][1]));
            const char* a3 = a2 + kstep; const char* b3 = b2 + kstep;
            unsigned x00 = cvA[0][0], x01 = cvA[0][1], x10 = cvA[1][0], x11 = cvA[1][1];
            if constexpr (GATHER) { if (last) { x00 = nvA[0][0]; x01 = nvA[0][1]; x10 = nvA[1][0]; x11 = nvA[1][1]; } }
            PG8_LDB(B0, 0, 0); PG8_LDB(B1, 0, 1); PG8_SCHED; PG8_LDA(At, 0, 0); PG8_STAGE(PG8_SA(1, 1), a1, cvA[1][0], cvA[1][1]);
            PG8_WAIT_V(8); PG8_WAIT_L(0); PG8_BAR; PG8_MMA(0, 0, At, B0); PG8_MMA(0, 1, At, B1); PG8_BAR; PG8_SCHED;
            PG8_LDA(At, 0, 1); PG8_STAGE(PG8_SB(0, 0), b2, voffB[0], voffB[1]); PG8_STAGE(PG8_SB(0, 1), b2 + hstepB, voffB[0], voffB[1]); PG8_STAGE(PG8_SA(0, 0), a2, x00, x01);
            PG8_WAIT_V(8); PG8_WAIT_L(0); PG8_BAR; PG8_MMA(1, 0, At, B0); PG8_MMA(1, 1, At, B1); PG8_BAR; PG8_SCHED;
            PG8_LDB(B0, 1, 0); PG8_LDB(B1, 1, 1); PG8_SCHED; PG8_LDA(At, 1, 0); PG8_STAGE(PG8_SA(0, 1), a2, x10, x11);
            PG8_WAIT_V(8); PG8_WAIT_L(0); PG8_BAR; PG8_MMA(0, 0, At, B0); PG8_MMA(0, 1, At, B1); PG8_BAR; PG8_SCHED;
            PG8_LDA(At, 1, 1); PG8_STAGE(PG8_SB(1, 0), b3, voffB[0], voffB[1]); PG8_STAGE(PG8_SB(1, 1), b3 + hstepB, voffB[0], voffB[1]); PG8_STAGE(PG8_SA(1, 0), a3, x00, x01);
            PG8_WAIT_V(8); PG8_WAIT_L(0); PG8_BAR; PG8_MMA(1, 0, At, B0); PG8_MMA(1, 1, At, B1); PG8_BAR; PG8_SCHED;
        }
        if constexpr (FP8) asm volatile("s_nop 15\n\ts_nop 15\n\ts_nop 7" ::: "memory");
        if (wr == 0) PG8_BAR;
        { Unit eu = cur; asm volatile("" : "+s"(eu.r0), "+s"(eu.c0), "+s"(eu.e));
          E(acc, eu, wr, wc, fr, fq); }
        if (!has_next) break;
#pragma unroll
        for (int a = 0; a < 2; ++a)
#pragma unroll
            for (int b = 0; b < 2; ++b)
#pragma unroll
                for (int m = 0; m < 4; ++m)
#pragma unroll
                    for (int n = 0; n < 2; ++n) acc[a][b][m][n] = (f32x4){0.f, 0.f, 0.f, 0.f};
        cur = nxt; cA = nA; cB = nB; ++ui;
        if constexpr (GATHER) {
#pragma unroll
            for (int h = 0; h < 2; ++h)
#pragma unroll
                for (int i = 0; i < 2; ++i) cvA[h][i] = nvA[h][i]; }
        if (wr == 1) PG8_BAR;
    }
    PG8_WAIT_V(0);
    PG8_BAR;
#undef PG8_SA
#undef PG8_SB
#undef PG8_STAGE
#undef PG8_LDA
#undef PG8_LD32
#undef PG8_LDB
#undef PG8_MMA
#undef PG8_CAT
#undef PG8_WAIT_V
#undef PG8_WAIT_L
#undef PG8_BAR
#undef PG8_SCHED
#undef PG8_GATHER
}
}
using pg8::Unit;

struct Params { const float* in[NIN]; float* out; unsigned char* ws; };
constexpr int LDS_PARAMS = LDS_BYTES - 1024 + 256;
__device__ __forceinline__ int opaque0() { int z; asm volatile("s_mov_b32 %0, 0" : "=s"(z)); return z; }
struct PL {
    LAS unsigned char* lds; int z; int w0;
    __device__ __forceinline__ unsigned long long word(int i) const { const LAS unsigned* w = (const LAS unsigned*)(lds + LDS_PARAMS) + 2 * i;
        const unsigned lo = __builtin_amdgcn_readfirstlane(w[0]), hi = __builtin_amdgcn_readfirstlane(w[1]); return ((unsigned long long)hi << 32) | lo; }
    __device__ __forceinline__ const float* in(int i) const { return (const float*)(__attribute__((address_space(1))) const float*)word(i); }
    __device__ __forceinline__ float* out() const { return (float*)(__attribute__((address_space(1))) float*)word(NIN); }
    __device__ __forceinline__ unsigned char* ws() const { return (unsigned char*)(__attribute__((address_space(1))) unsigned char*)word(NIN + 1); }
};

struct EpiBf16 {
    static constexpr bool PERM = true;
    bf16_t* O; int ldc; const float* bias; int bias_estride; float ascale = 1.0f;
    __device__ __forceinline__ void operator()(const f32x4 (&acc)[2][2][4][2], const Unit& u, int wr, int wc, int fr, int fq) const {
        const int row0 = u.r0 + wr * 64 + fr, col0 = u.c0 * 256 + wc * 32 + 8 * fq;
        f32x4 bv[2][2];
#pragma unroll
        for (int bj = 0; bj < 2; ++bj)
#pragma unroll
            for (int n = 0; n < 2; ++n) bv[bj][n] = bias ? *(const f32x4*)(bias + (size_t)u.e * bias_estride + col0 + bj * 128 + 4 * n) : (f32x4){0.f, 0.f, 0.f, 0.f};
#pragma unroll
        for (int ai = 0; ai < 2; ++ai)
#pragma unroll
            for (int m = 0; m < 4; ++m) { bf16_t* rowp = O + (size_t)(row0 + ai * 128 + m * 16) * ldc + col0;
#pragma unroll
                for (int bj = 0; bj < 2; ++bj) { const f32x4 v0 = acc[ai][bj][m][0] * ascale + bv[bj][0], v1 = acc[ai][bj][m][1] * ascale + bv[bj][1];
                    u32x4 w; w.x = cvt_pk_bf16(v0[0], v0[1]); w.y = cvt_pk_bf16(v0[2], v0[3]); w.z = cvt_pk_bf16(v1[0], v1[1]); w.w = cvt_pk_bf16(v1[2], v1[3]);
                    *(u32x4*)(rowp + bj * 128) = w; } }
    }
};
struct EpiFp8 {
    static constexpr bool PERM = true;
    unsigned char* O; int ldc; const float* bias; int bias_estride; float ascale;
    __device__ __forceinline__ void operator()(const f32x4 (&acc)[2][2][4][2], const Unit& u, int wr, int wc, int fr, int fq) const {
        const int row0 = u.r0 + wr * 64 + fr, col0 = u.c0 * 256 + wc * 32 + 8 * fq;
        f32x4 bv[2][2];
#pragma unroll
        for (int bj = 0; bj < 2; ++bj)
#pragma unroll
            for (int n = 0; n < 2; ++n) bv[bj][n] = *(const f32x4*)(bias + (size_t)u.e * bias_estride + col0 + bj * 128 + 4 * n);
#pragma unroll
        for (int ai = 0; ai < 2; ++ai)
#pragma unroll
            for (int m = 0; m < 4; ++m) { unsigned char* rowp = O + (size_t)(row0 + ai * 128 + m * 16) * ldc + col0;
#pragma unroll
                for (int bj = 0; bj < 2; ++bj) { const f32x4 v0 = acc[ai][bj][m][0] * ascale + bv[bj][0], v1 = acc[ai][bj][m][1] * ascale + bv[bj][1];
                    u32x2 q; q.x = pack4_fp8(v0[0], v0[1], v0[2], v0[3]); q.y = pack4_fp8(v1[0], v1[1], v1[2], v1[3]); *(u32x2*)(rowp + bj * 128) = q; } }
    }
};
__device__ __forceinline__ void epi_cols32(const f32x4 (&acc)[2][2][4][2], float* dst, const float* bias, int r0, int wr, int wc, int fr, int fq, float ascale) {
    if (wc != 0) return;
    const int row0 = r0 + wr * 64 + fr, c = 8 * fq;
    f32x4 b0 = (f32x4){0.f, 0.f, 0.f, 0.f}, b1 = b0;
    if (bias) { b0 = *(const f32x4*)(bias + c); b1 = *(const f32x4*)(bias + c + 4); }
#pragma unroll
    for (int ai = 0; ai < 2; ++ai)
#pragma unroll
        for (int m = 0; m < 4; ++m) { float* p = dst + (size_t)(row0 + ai * 128 + m * 16) * 32 + c;
            *(f32x4*)p = acc[ai][0][m][0] * ascale + b0; *(f32x4*)(p + 4) = acc[ai][0][m][1] * ascale + b1; }
}
struct EpiInProj {
    static constexpr bool PERM = true;
    bf16_t *ca, *cb, *z; float* gate; int f8 = 0;
    __device__ __forceinline__ void operator()(const f32x4 (&acc)[2][2][4][2], const Unit& u, int wr, int wc, int fr, int fq) const {
        const int ct = f8 ? u.c0 : u.c0 + 10; const float ascale = f8 ? 1.0f / W8_SCALE : 1.0f;
        if (ct == 14) { epi_cols32(acc, gate, nullptr, u.r0, wr, wc, fr, fq, 1.0f); return; }
        bf16_t* O; int ldc, c0;
        if (ct < 6) { O = ca; ldc = 1536; c0 = ct; } else if (ct < 10) { O = cb; ldc = 1024; c0 = ct - 6; } else { O = z; ldc = 1024; c0 = ct - 10; }
        const bool odd = (fr & 1) != 0;
        const int col = c0 * 256 + wc * 64 + (odd ? 32 : 0) + 8 * fq, rowb = u.r0 + wr * 64 + (fr & ~1);
#pragma unroll
        for (int ai = 0; ai < 2; ++ai)
#pragma unroll
            for (int m = 0; m < 4; ++m) { unsigned p0[4], p1[4], s0[4], s1[4];
#pragma unroll
                for (int n = 0; n < 2; ++n) { const f32x4 v0 = acc[ai][0][m][n] * ascale, v1 = acc[ai][1][m][n] * ascale;
                    p0[2 * n] = cvt_pk_bf16(v0[0], v0[1]); p0[2 * n + 1] = cvt_pk_bf16(v0[2], v0[3]); p1[2 * n] = cvt_pk_bf16(v1[0], v1[1]); p1[2 * n + 1] = cvt_pk_bf16(v1[2], v1[3]); }
#pragma unroll
                for (int i = 0; i < 4; ++i) { const unsigned x = odd ? p0[i] : p1[i]; const unsigned rcv = (unsigned)__builtin_amdgcn_update_dpp(0, (int)x, 0xB1, 0xF, 0xF, false);
                    s0[i] = odd ? rcv : p0[i]; s1[i] = odd ? p1[i] : rcv; }
                bf16_t* rp = O + (size_t)(rowb + ai * 128 + m * 16) * ldc + col;
                *(u32x4*)rp = (u32x4){s0[0], s0[1], s0[2], s0[3]}; *(u32x4*)(rp + ldc) = (u32x4){s1[0], s1[1], s1[2], s1[3]}; }
    }
};
struct EpiSwiGLU {
    static constexpr bool PERM = true;
    unsigned char* H; const float* bg; const float* bu;
    __device__ __forceinline__ void operator()(const f32x4 (&acc)[2][2][4][2], const Unit& u, int wr, int wc, int fr, int fq) const {
        const int row0 = u.r0 + wr * 64 + fr, colf = u.c0 * 128 + wc * 32 + 8 * fq;
        f32x4 gv[2], uv[2];
#pragma unroll
        for (int n = 0; n < 2; ++n) { gv[n] = *(const f32x4*)(bg + (size_t)u.e * 1024 + colf + 4 * n); uv[n] = (*(const f32x4*)(bu + (size_t)u.e * 1024 + colf + 4 * n) + 1.0f) * H8_SCALE; }
#pragma unroll
        for (int ai = 0; ai < 2; ++ai)
#pragma unroll
            for (int m = 0; m < 4; ++m) { float o[8];
#pragma unroll
                for (int n = 0; n < 2; ++n) { const f32x4 g = acc[ai][0][m][n] * (1.0f / W8_SCALE) + gv[n], l = acc[ai][1][m][n] * (H8_SCALE / W8_SCALE) + uv[n];
#pragma unroll
                    for (int j = 0; j < 4; ++j) { const float gl = fminf(g[j], 7.0f), lp = fminf(fmaxf(l[j], -6.0f * H8_SCALE), 8.0f * H8_SCALE);
                        o[4 * n + j] = gl * __builtin_amdgcn_rcpf(1.0f + __builtin_amdgcn_exp2f(gl * (-1.702f * 1.4426950408889634f))) * lp; } }
                u32x2 q; q.x = pack4_fp8(o[0], o[1], o[2], o[3]); q.y = pack4_fp8(o[4], o[5], o[6], o[7]);
                *(u32x2*)(H + blk_off8(row0 + ai * 128 + m * 16, colf)) = q; }
    }
};
struct EpiGLU {
    static constexpr bool PERM = true;
    bf16_t* O;
    __device__ __forceinline__ void operator()(const f32x4 (&acc)[2][2][4][2], const Unit& u, int wr, int wc, int fr, int fq) const {
        const int row0 = u.r0 + wr * 64 + fr, colf = u.c0 * 128 + wc * 32 + 8 * fq;
#pragma unroll
        for (int ai = 0; ai < 2; ++ai)
#pragma unroll
            for (int m = 0; m < 4; ++m) { float o[8];
#pragma unroll
                for (int n = 0; n < 2; ++n) { const f32x4 a = acc[ai][0][m][n], b = acc[ai][1][m][n];
#pragma unroll
                    for (int j = 0; j < 4; ++j) o[4 * n + j] = a[j] * (1.0f / W8_SCALE) * sigmoidf_(b[j] * (1.0f / W8_SCALE)); }
                *(u32x4*)(O + (size_t)(row0 + ai * 128 + m * 16) * 1024 + colf) = pack8(o); }
    }
};
__device__ __forceinline__ void s5_rowmap(int r, int& crow, int& t) {
    if (r < TL) { const int b = r >> 11, l = r & 2047; crow = b * 64 + (l >> 5); t = l & 31; }
    else { const int rc = r - TL, b = rc >> 8, l = rc & 255; crow = 2048 + b * 8 + (l >> 5); t = l & 31; }
}
struct EpiS5U {
    static constexpr bool PERM = true;
    bf16_t* UL;
    __device__ __forceinline__ void operator()(const f32x4 (&acc)[2][2][4][2], const Unit& u, int wr, int wc, int fr, int fq) const {
        const int row0 = u.r0 + wr * 64 + fr, col0 = u.c0 * 256 + wc * 32 + 8 * fq;
#pragma unroll
        for (int ai = 0; ai < 2; ++ai)
#pragma unroll
            for (int m = 0; m < 4; ++m) { int crow, t; s5_rowmap(row0 + ai * 128 + m * 16, crow, t);
#pragma unroll
                for (int bj = 0; bj < 2; ++bj) { const int c = col0 + bj * 128, g = c >> 4; const f32x4 v0 = acc[ai][bj][m][0] * (1.0f / W8_SCALE), v1 = acc[ai][bj][m][1] * (1.0f / W8_SCALE);
                    u32x4 w; w.x = cvt_pk_bf16(v0[0], v0[1]); w.y = cvt_pk_bf16(v0[2], v0[3]); w.z = cvt_pk_bf16(v1[0], v1[1]); w.w = cvt_pk_bf16(v1[2], v1[3]);
                    *(u32x4*)(UL + ((size_t)g * S5ROWS + crow) * S5K + t * 16 + (c & 15)) = w; } }
    }
};
struct EpiS5S {
    static constexpr bool PERM = false;
    float* S;
    __device__ __forceinline__ void operator()(const f32x4 (&acc)[2][2][4][2], const Unit& u, int wr, int wc, int fr, int fq) const {
        const int row0 = u.r0 + wr * 64 + fr, col0 = wc * 32 + 4 * fq;
#pragma unroll
        for (int ai = 0; ai < 2; ++ai)
#pragma unroll
            for (int m = 0; m < 4; ++m) { float* rowp = S + ((size_t)u.e * S5ROWS + row0 + ai * 128 + m * 16) * 256 + col0;
#pragma unroll
                for (int bj = 0; bj < 2; ++bj)
#pragma unroll
                    for (int n = 0; n < 2; ++n) *(f32x4*)(rowp + bj * 128 + n * 16) = acc[ai][bj][m][n]; }
    }
};
__device__ __forceinline__ float gelu_tanh(float x) { const float u = 0.7978845608f * (x + 0.044715f * x * x * x); return x * sigmoidf_(2.0f * u); }
struct EpiS5Y {
    static constexpr bool PERM = true;
    unsigned char* OG;
    __device__ __forceinline__ void operator()(const f32x4 (&acc)[2][2][4][2], const Unit& u, int wr, int wc, int fr, int fq) const {
        const int row0 = u.r0 + wr * 64 + fr, n0 = u.c0 * 256 + wc * 32 + 8 * fq;
#pragma unroll
        for (int ai = 0; ai < 2; ++ai)
#pragma unroll
            for (int m = 0; m < 4; ++m) { const int crow = row0 + ai * 128 + m * 16;
#pragma unroll
                for (int bj = 0; bj < 2; ++bj) { const int n = n0 + bj * 128, t = n >> 4, h0 = n & 15; float o[8];
#pragma unroll
                    for (int j = 0; j < 4; ++j) { o[j] = gelu_tanh(acc[ai][bj][m][0][j]); o[4 + j] = gelu_tanh(acc[ai][bj][m][1][j]); }
                    u32x2 q; q.x = pack4_fp8(o[0], o[1], o[2], o[3]); q.y = pack4_fp8(o[4], o[5], o[6], o[7]);
                    *(u32x2*)(OG + ((size_t)crow * 32 + t) * 1024 + u.e * 16 + h0) = q; } }
    }
};

struct DenseSched {
    pg8::TileOrder T; const char* A; const char* B; size_t astep, bstep;
    __device__ void init(const void* A_, const void* B_, int nM, int nN, int lda, int ldb, int z, int es = 2) { T.init(nM, nN, (int)gridDim.x + z, (int)blockIdx.x + z); A = (const char*)A_; B = (const char*)B_; astep = (size_t)256 * lda * es; bstep = (size_t)256 * ldb * es; }
    __device__ __forceinline__ bool next(int i, Unit& u) const { int pm, pn; if (!T.next(i, pm, pn)) return false;
        u.A = A + pm * astep; u.B = B + pn * bstep; u.gat = nullptr; u.nvalid = 256; u.r0 = pm * 256; u.c0 = pn; u.e = 0; return true; }
};
struct GroupSched {
    const char* A; const char* B; size_t agstep, bgstep, astep, bstep; int nG, nM, nN, G, c;
    __device__ __forceinline__ bool next(int i, Unit& u) const { const long L = (long)i * G + c; if (L >= (long)nG * nM * nN) return false;
        const int per = nM * nN, g = (int)(L / per), rem = (int)(L % per), pm = rem / nN, pn = rem % nN;
        u.A = A + g * agstep + pm * astep; u.B = B + g * bgstep + pn * bstep; u.gat = nullptr; u.nvalid = 256; u.r0 = pm * 256; u.c0 = pn; u.e = g; return true; }
};
struct MoeSched {
    const LAS int* tp; const LAS int* cnt; const LAS int* te  ; int NC, ntiles; bool gather;
    const char* A; const char* B; size_t bestep  ; const int* tok; int CT, G, c; int rowbytes  ; int xrot  ;
    __device__ __forceinline__ bool next(int i, Unit& u) const {
        int rt, ct;
        if (G == 256) { const int xcd = ((c & 7) + 8 - xrot) & 7, j = c >> 3, RPS = 32 / NC; rt = (i * 8 + xcd) * RPS + j / NC; ct = j % NC; }
        else { const long L = (long)i * G + c; rt = (int)(L / NC); ct = (int)(L % NC); }
        if (rt >= ntiles) return false;
        const int e = __builtin_amdgcn_readfirstlane(te[rt]), lt = rt - __builtin_amdgcn_readfirstlane(tp[e]);
        u.e = e; u.r0 = rt * 256; u.c0 = ct; u.nvalid = cnt[e] - lt * 256; u.gat = tok + (size_t)e * CT + lt * 256;
        u.A = gather ? A : A + (size_t)rt * 256 * rowbytes; u.B = B + (size_t)e * bestep + (size_t)ct * 256 * rowbytes; return true;
    }
};

#define TID (P.w0 * 64 + lane_id(P.z))
#define BID ((int)blockIdx.x + P.z)
#define GDIM ((int)gridDim.x + P.z)
#define wave_id() __builtin_amdgcn_readfirstlane(TID >> 6)
__device__ __forceinline__ bf16_t* hbrow(unsigned char* ws, int r) { return r < TL ? (bf16_t*)(ws + WS_HBL) + (size_t)r * D : (bf16_t*)(ws + WS_HBC) + (size_t)(r - TL) * D; }
__device__ __forceinline__ const float* xrow(const float* x, const float* ctx, int r) { return r < TL ? x + (size_t)r * D : ctx + (size_t)(r - TL) * D; }
__device__ __forceinline__ const float* modp(const unsigned char* ws, int layer, int r, int which) { const int mb = r < TL ? (r >> 11) : 32; return (const float*)(ws + WS_MOD) + ((size_t)(layer * 33 + mb) * 6 + which) * D; }

__device__ __forceinline__ void phase_mod(const PL& P, LAS unsigned char* lds) {
    LAS float* sT = (LAS float*)lds; LAS float* red = (LAS float*)(lds + 17 * 1024 * 4);
    const int tid = TID, lane = tid & 63, wave = wave_id();
    float* MOD = (float*)(P.ws() + WS_MOD); const float* cc = P.in(IC); const float* cctx = P.in(ICCTX); const float* adaw = P.in(IADAW); const float* adab = P.in(IADAB);
    for (int rg = 0; rg < 2; ++rg) {
        const int r0 = rg * 17, nr = rg == 0 ? 17 : 16;
        __syncthreads();
        for (int i = tid; i < nr * 1024; i += 512) { const int r = r0 + (i >> 10), k = i & 1023; const float x = r < 32 ? cc[r * 1024 + k] : cctx[k]; sT[i] = x / (1.0f + expf(-x)); }
        __syncthreads();
        for (int cb = BID; cb < 256; cb += GDIM) {
            const int col0 = cb * 48, layer = col0 / 6144, cl0 = col0 % 6144;
            const float* W = adaw + (size_t)layer * 1024 * 6144 + cl0;
            float acc[17];
#pragma unroll
            for (int r = 0; r < 17; ++r) acc[r] = 0.f;
            if (lane < 48) {
#pragma unroll 1
                for (int k = wave * 128; k < wave * 128 + 128; k += 16) {
                    float wk[16];
#pragma unroll
                    for (int q = 0; q < 16; ++q) wk[q] = W[(size_t)(k + q) * 6144 + lane];
#pragma unroll
                    for (int q = 0; q < 16; q += 4)
#pragma unroll
                        for (int r = 0; r < 17; ++r) { if (r < nr) { const f32x4 s4 = *(const LAS f32x4*)(sT + r * 1024 + k + q); PFMA(acc[r], s4.x, wk[q]); PFMA(acc[r], s4.y, wk[q + 1]); PFMA(acc[r], s4.z, wk[q + 2]); PFMA(acc[r], s4.w, wk[q + 3]); }
                            if (r == 16) asm volatile("" ::: "memory"); }
                }
#pragma unroll
                for (int r = 0; r < 17; ++r) red[(wave * 17 + r) * 48 + lane] = acc[r];
            }
            __syncthreads();
            for (int o = tid; o < nr * 48; o += 512) { const int r = o / 48, c = o % 48; float s = 0.f;
#pragma unroll
                for (int w = 0; w < 8; ++w) s += red[(w * 17 + r) * 48 + c];
                MOD[(size_t)(layer * 33 + r0 + r) * 6144 + cl0 + c] = s + adab[layer * 6144 + cl0 + c]; }
            __syncthreads();
        }
    }
}

__device__ __forceinline__ void cvt_item(const float* W, int K, int N, bf16_t* WT, int drow0, LAS float* scr, int kb, int nb, int lane, bool blk = false) {
    const int k0 = 64 * kb, n0 = 32 * nb;
#pragma unroll 8
    for (int i = 0; i < 32; ++i) { const int kk = 2 * i + (lane >> 5); scr[kk * 33 + (lane & 31)] = W[(size_t)(k0 + kk) * N + n0 + (lane & 31)]; }
    LDS_WAIT(); asm volatile("" ::: "memory");
    const int c = lane & 7;
#pragma unroll
    for (int j = 0; j < 4; ++j) { const int n = (lane >> 3) + 8 * j; const LAS float* s = scr + (8 * c) * 33 + n;
        u32x4 o; o.x = cvt_pk_bf16(s[0 * 33], s[1 * 33]); o.y = cvt_pk_bf16(s[2 * 33], s[3 * 33]); o.z = cvt_pk_bf16(s[4 * 33], s[5 * 33]); o.w = cvt_pk_bf16(s[6 * 33], s[7 * 33]);
        *(u32x4*)(WT + (blk ? blk_off(inproj_row(drow0 + n), k0 + 8 * c) : (size_t)(drow0 + n) * K + k0 + 8 * c)) = o; }
    LDS_WAIT(); asm volatile("" ::: "memory");
}
__device__ __forceinline__ void cvt_item8(const float* W, int K, int N, unsigned char* WT, int drow0, LAS float* scr, int kb, int nb, int lane, bool blkperm = false) {
    const int k0 = 64 * kb, n0 = 32 * nb;
#pragma unroll 8
    for (int i = 0; i < 32; ++i) { const int kk = 2 * i + (lane >> 5); scr[kk * 33 + (lane & 31)] = W[(size_t)(k0 + kk) * N + n0 + (lane & 31)]; }
    LDS_WAIT(); asm volatile("" ::: "memory");
    const int n = lane >> 1, kh = (lane & 1) * 32; const LAS float* sp = scr + kh * 33 + n; unsigned w[8];
#pragma unroll
    for (int q = 0; q < 8; ++q) w[q] = pack4_fp8(sp[(4 * q) * 33] * W8_SCALE, sp[(4 * q + 1) * 33] * W8_SCALE, sp[(4 * q + 2) * 33] * W8_SCALE, sp[(4 * q + 3) * 33] * W8_SCALE);
    unsigned char* dst = WT + (blkperm ? blk_off8(inproj_row(drow0 + n), k0 + kh) : (size_t)(drow0 + n) * K + k0 + kh);
    *(u32x4*)dst = (u32x4){w[0], w[1], w[2], w[3]}; *(u32x4*)(dst + 16) = (u32x4){w[4], w[5], w[6], w[7]};
    LDS_WAIT(); asm volatile("" ::: "memory");
}
__device__ __forceinline__ void cvt_matrix_item(const float* W, int N, bf16_t* WT, int mode, LAS float* scr, int item, int lane, bool f8 = false, bool blk = false) {
    const int nblk = N / 32, kb = item / nblk, nb = item % nblk, n0 = nb * 32;
    const int drow0 = mode == 0 ? n0 : ((n0 >> 7) * 256 + (n0 & 127) + (mode == 2 ? 128 : 0));
    if (f8) cvt_item8(W, 1024, N, (unsigned char*)WT, drow0, scr, kb, nb, lane); else cvt_item(W, 1024, N, WT, drow0, scr, kb, nb, lane, blk);
}
__device__ __forceinline__ void phase_cvt_dense(const PL& P, LAS unsigned char* lds) {
    const int lane = TID & 63, wave = wave_id(), gw = BID * 8 + wave, NGW = GDIM * 8;
    LAS float* scr = (LAS float*)(lds + wave * 16384);
    constexpr int I_IN = 16 * 113, I_SQ = 16 * 32, I_R = 16;
    constexpr int NIT = I_IN + 4 * I_SQ + 2 * I_R;
    unsigned char* ws = P.ws(); const float* w_in = P.in(IHYIN); const float* w_out = P.in(IHYOUT); const float* w_s5 = P.in(IS5IN); const float* w_ga = P.in(IGLUA); const float* w_gb = P.in(IGLUB); const float* w_r = P.in(IRW);
    for (int it = gw; it < NIT; it += NGW) { int r = it;
        if (r < I_IN) { const int kb = r / 113, nb = r % 113, ct = nb >> 3;
            if (ct < 10) cvt_item8(w_in, 1024, INW, ws + WS_WIN8, nb * 32, scr, kb, nb, lane, true);
            else cvt_item(w_in, 1024, INW, (bf16_t*)(ws + WS_WIN), nb * 32 - 2560, scr, kb, nb, lane, true);
            continue; } r -= I_IN;
        if (r < I_SQ) { cvt_matrix_item(w_out, 1024, (bf16_t*)(ws + WS_WOUT), 0, scr, r, lane, true); continue; } r -= I_SQ;
        if (r < I_SQ) { cvt_matrix_item(w_s5, 1024, (bf16_t*)(ws + WS_WS5IN), 0, scr, r, lane, true); continue; } r -= I_SQ;
        if (r < I_SQ) { cvt_matrix_item(w_ga, 1024, (bf16_t*)(ws + WS_WGLU), 1, scr, r, lane, true); continue; } r -= I_SQ;
        if (r < I_SQ) { cvt_matrix_item(w_gb, 1024, (bf16_t*)(ws + WS_WGLU), 2, scr, r, lane, true); continue; } r -= I_SQ;
        const int l = r / I_R; r -= l * I_R;
        cvt_matrix_item(w_r + (size_t)l * 1024 * 32, 32, (bf16_t*)(ws + WS_RB) + (size_t)l * 256 * 1024, 0, scr, r, lane);
    }
    const int gt = BID * 512 + TID, NT = GDIM * 512; const u32x4 z = (u32x4){0u, 0u, 0u, 0u};
    for (int i = gt; i < (INWP - INW) * 128; i += NT) *(u32x4*)((bf16_t*)(ws + WS_WIN) + blk_off(inproj_row(1024 + 32 + (i >> 7)), (i & 127) * 8)) = z;
    for (int i = gt; i < 2 * 224 * 128; i += NT) { const int l = i / (224 * 128), j = i % (224 * 128); *((u32x4*)((bf16_t*)(ws + WS_RB) + ((size_t)l * 256 + 32) * 1024) + j) = z; }
}
struct CvtJob { const float* W; unsigned char* WT; int drow0, k0, n0; };
__device__ __forceinline__ void cvt_load128(const CvtJob& j, float (&v)[32], int tid) {
#pragma unroll
    for (int u = 0; u < 8; ++u) { const int idx = tid + 512 * u, n = idx & 127, kq = idx >> 7; const float* src = j.W + (size_t)(j.k0 + 4 * kq) * 1024 + j.n0 + n;
#pragma unroll
        for (int r = 0; r < 4; ++r) v[4 * u + r] = src[(size_t)r * 1024]; }
}
__device__ __forceinline__ void cvt_store128(const CvtJob& j, const float (&v)[32], LAS unsigned* T32, int tid) {
#pragma unroll
    for (int u = 0; u < 8; ++u) { const int idx = tid + 512 * u, n = idx & 127, kq = idx >> 7;
        T32[n * 33 + kq] = pack4_fp8(v[4 * u] * W8_SCALE, v[4 * u + 1] * W8_SCALE, v[4 * u + 2] * W8_SCALE, v[4 * u + 3] * W8_SCALE); }
    LDS_BAR();
#pragma unroll
    for (int u = 0; u < 2; ++u) { const int idx = tid + 512 * u, n = idx >> 3, q = (idx & 7) * 4; const LAS unsigned* sp = T32 + n * 33 + q;
        u32x4 w; w.x = sp[0]; w.y = sp[1]; w.z = sp[2]; w.w = sp[3];
        *(u32x4*)(j.WT + blk_off8(j.drow0 + n, j.k0 + 4 * q)) = w; }
    LDS_BAR();
}
__device__ __forceinline__ CvtJob cvt_moe_job(int it, int layer, const float* wg, const float* wu, const float* wd, unsigned char* WGU, unsigned char* WDN) {
    const int mat = it >> 6, r = it & 63, e = mat / 3, w = mat % 3, kb = r >> 3, nb = r & 7; const size_t eo = ((size_t)layer * 32 + e) * 1024 * 1024; CvtJob j;
    j.W = (w == 0 ? wg : (w == 1 ? wu : wd)) + eo; j.WT = w == 2 ? WDN + (size_t)e * 1024 * 1024 : WGU + (size_t)e * 2048 * 1024; j.drow0 = w == 2 ? nb * 128 : nb * 256 + (w == 1 ? 128 : 0); j.k0 = kb * 128; j.n0 = nb * 128; return j;
}
__device__ __forceinline__ void phase_cvt_moe(const PL& P, LAS unsigned char* lds, int layer) {
    const int tid = TID;
    LAS unsigned* T = (LAS unsigned*)lds;
    unsigned char* WGU = P.ws() + WS_WMOE; unsigned char* WDN = WGU + (size_t)32 * 2048 * 1024; const float* wg = P.in(IWG); const float* wu = P.in(IWU); const float* wd = P.in(IWD);
    __syncthreads();
    int it = BID;
    if (it < 96 * 64) {
        float v[32], vn[32]; CvtJob cur = cvt_moe_job(it, layer, wg, wu, wd, WGU, WDN); cvt_load128(cur, v, tid);
        for (;;) { const int nx = it + GDIM; const bool has = nx < 96 * 64; CvtJob nj = cur; if (has) { nj = cvt_moe_job(nx, layer, wg, wu, wd, WGU, WDN); cvt_load128(nj, vn, tid); }
            cvt_store128(cur, v, T, tid);
            if (!has) break;
#pragma unroll
            for (int u = 0; u < 32; ++u) v[u] = vn[u];
            cur = nj; it = nx; }
    }
}

__device__ __forceinline__ void phase_s5_tables(const PL& P, LAS unsigned char* lds) {
    LAS float* ar = (LAS float*)lds; LAS float* ai = ar + 64; LAS float* fre = ai + 64; LAS float* fim = fre + 64;
    LAS float* Bb = fim + 64;
    LAS float* Cc = Bb + 2048;
    LAS float* lj = Cc + 2048;
    const int tid = TID;
    float* LP = (float*)(P.ws() + WS_LP); float* BB = (float*)(P.ws() + WS_BB); float* KT = (float*)(P.ws() + WS_KT);
    const float* i_ls = P.in(IS5LS); const float* i_are = P.in(IS5ARE); const float* i_aim = P.in(IS5AIM); const float* i_bre = P.in(IS5BRE); const float* i_bim = P.in(IS5BIM); const float* i_cre = P.in(IS5CRE); const float* i_cim = P.in(IS5CIM);
    for (int it = BID; it < 128; it += GDIM) { const int d = it >> 6, g = it & 63, dg = d * 64 + g;
        __syncthreads();
        if (tid < 64) { const float step = expf(i_ls[dg]), are = i_are[dg * 64 + tid], aim = i_aim[dg * 64 + tid];
            const float a_r = are * step, a_i = aim * step, mag = expf(a_r); float sn, cs; sincosf(a_i, &sn, &cs); const float lr = mag * cs, li = mag * sn, den = are * are + aim * aim;
            ar[tid] = a_r; ai[tid] = a_i; fre[tid] = ((lr - 1.0f) * are + li * aim) / den; fim[tid] = (li * are - (lr - 1.0f) * aim) / den; }
        __syncthreads();
        for (int i = tid; i < 1024; i += 512) { const int p = i >> 4; const float br = i_bre[(size_t)dg * 1024 + i], bi = i_bim[(size_t)dg * 1024 + i];
            const float re = fre[p] * br - fim[p] * bi, im = fre[p] * bi + fim[p] * br; Bb[2 * i] = re; Bb[2 * i + 1] = im; BB[((size_t)dg * 1024 + i) * 2] = re; BB[((size_t)dg * 1024 + i) * 2 + 1] = im;
            Cc[2 * i] = i_cre[(size_t)dg * 1024 + i]; Cc[2 * i + 1] = i_cim[(size_t)dg * 1024 + i]; }
        __syncthreads();
        if (tid < 64) {
            for (int j = 0; j <= 32; ++j) { const float m = expf(ar[tid] * (float)j); float sn, cs; sincosf(ai[tid] * (float)j, &sn, &cs);
                LP[(((size_t)dg * 33 + j) * 64 + tid) * 2] = m * cs; LP[(((size_t)dg * 33 + j) * 64 + tid) * 2 + 1] = m * sn; }
            { const float m = expf(ar[tid]); float sn, cs; sincosf(ai[tid], &sn, &cs); lj[2 * tid] = m * cs; lj[2 * tid + 1] = m * sn; }
        }
        __syncthreads();
        if (tid < 256) { const int h = tid >> 4, h2 = tid & 15; float acc[32];
#pragma unroll
            for (int j = 0; j < 32; ++j) acc[j] = 0.f;
            for (int p = 0; p < 64; ++p) { const float cr = Cc[2 * (h * 64 + p)], ci = Cc[2 * (h * 64 + p) + 1], br = Bb[2 * (p * 16 + h2)], bi = Bb[2 * (p * 16 + h2) + 1], lr = lj[2 * p], li = lj[2 * p + 1];
                float zr = cr * br - ci * bi, zi = cr * bi + ci * br;
#pragma unroll
                for (int j = 0; j < 32; ++j) { acc[j] += zr; const float nr = zr * lr - zi * li, ni = zr * li + zi * lr; zr = nr; zi = ni; } }
#pragma unroll
            for (int j = 0; j < 32; ++j) KT[(((size_t)g * 2 + d) * 32 + j) * 256 + tid] = acc[j]; }
    }
}
__device__ __forceinline__ void phase_s5_mats(const PL& P) {
    unsigned char* ws = P.ws(); const float* i_d = P.in(IS5D); const float* i_cre = P.in(IS5CRE); const float* i_cim = P.in(IS5CIM);
    const float* LP = (const float*)(ws + WS_LP); const float* BB = (const float*)(ws + WS_BB); const float* KT = (const float*)(ws + WS_KT);
    bf16_t* MPm = (bf16_t*)(ws + WS_MP); bf16_t* Em = (bf16_t*)(ws + WS_E);
    const int gt = BID * 512 + TID, NT = GDIM * 512;
    for (int idx = gt; idx < 64 * 512 * 96; idx += NT) { const int k8 = idx % 96, n = (idx / 96) & 511, g = idx / (96 * 512), t = n >> 4, h = n & 15; float v[8];
        if (k8 < 64) { const int s = k8 >> 1, h0 = (k8 & 1) * 8;
#pragma unroll
            for (int i = 0; i < 8; ++i) v[i] = 0.f;
            if (s <= t) { const float* kp = KT + (((size_t)g * 2 + 0) * 32 + (t - s)) * 256 + h * 16 + h0;
#pragma unroll
                for (int i = 0; i < 8; ++i) v[i] += kp[i]; }
            if (s >= t) { const float* kp = KT + (((size_t)g * 2 + 1) * 32 + (s - t)) * 256 + h * 16 + h0;
#pragma unroll
                for (int i = 0; i < 8; ++i) v[i] += kp[i]; }
            if (s == t && (h >> 3) == (k8 & 1)) v[h & 7] += i_d[g * 16 + h];
        } else { const int q = (k8 - 64) * 8, seg = q >> 6, p0 = q & 63, d = seg >> 1, im = seg & 1, e = d == 0 ? t + 1 : 32 - t, dg = d * 64 + g;
#pragma unroll
            for (int i = 0; i < 8; ++i) { const int p = p0 + i; const float cr = i_cre[(size_t)dg * 1024 + h * 64 + p], ci = i_cim[(size_t)dg * 1024 + h * 64 + p];
                const float lr = LP[(((size_t)dg * 33 + e) * 64 + p) * 2], li = LP[(((size_t)dg * 33 + e) * 64 + p) * 2 + 1];
                v[i] = im ? -(cr * li + ci * lr) : (cr * lr - ci * li); } }
        *(u32x4*)(MPm + ((size_t)g * 512 + n) * S5K + k8 * 8) = pack8(v); }
    for (int idx = gt; idx < 64 * 256 * 64; idx += NT) { const int k8 = idx & 63, n = (idx >> 6) & 255, g = idx >> 14, seg = n >> 6, p = n & 63, d = seg >> 1, im = seg & 1, s = k8 >> 1, h0 = (k8 & 1) * 8, e = d == 0 ? 31 - s : s, dg = d * 64 + g;
        const float lr = LP[(((size_t)dg * 33 + e) * 64 + p) * 2], li = LP[(((size_t)dg * 33 + e) * 64 + p) * 2 + 1]; float v[8];
#pragma unroll
        for (int i = 0; i < 8; ++i) { const float br = BB[((size_t)dg * 1024 + p * 16 + h0 + i) * 2], bi = BB[((size_t)dg * 1024 + p * 16 + h0 + i) * 2 + 1]; v[i] = im ? (lr * bi + li * br) : (lr * br - li * bi); }
        *(u32x4*)(Em + ((size_t)g * 256 + n) * 512 + k8 * 8) = pack8(v); }
}

__device__ __forceinline__ void norm_mod_row(const float (&x)[16], const float* w, const float* shift, const float* scale, bf16_t* dst, int lane, unsigned char* dst8 = nullptr) {
    float ss = 0.f;
#pragma unroll
    for (int i = 0; i < 16; ++i) ss += x[i] * x[i];
    const float rs = rsqrtf(wave_sum(ss) * (1.0f / 1024.0f) + RMS_EPS);
    float wv[16], sh[16], sc[16], o[16]; ld_row_f32(w, lane, wv); ld_row_f32(shift, lane, sh); ld_row_f32(scale, lane, sc);
#pragma unroll
    for (int i = 0; i < 16; ++i) o[i] = x[i] * rs * wv[i] * (1.0f + sc[i]) + sh[i];
    if (dst) st_row_bf16(dst, lane, o);
    if (dst8) {
#pragma unroll
        for (int j = 0; j < 2; ++j) { u32x2 q; q.x = pack4_fp8(o[8 * j], o[8 * j + 1], o[8 * j + 2], o[8 * j + 3]); q.y = pack4_fp8(o[8 * j + 4], o[8 * j + 5], o[8 * j + 6], o[8 * j + 7]); *(u32x2*)(dst8 + 8 * lane + 512 * j) = q; } }
}
__device__ __forceinline__ void norm_mod_pre(const float (&x)[16], const float (&wv)[16], const float (&sh)[16], const float (&sc)[16], bf16_t* dst, int lane, unsigned char* dst8) {
    float ss = 0.f;
#pragma unroll
    for (int i = 0; i < 16; ++i) ss += x[i] * x[i];
    const float rs = rsqrtf(wave_sum(ss) * (1.0f / 1024.0f) + RMS_EPS); float o[16];
#pragma unroll
    for (int i = 0; i < 16; ++i) o[i] = x[i] * rs * wv[i] * (1.0f + sc[i]) + sh[i];
    if (dst) st_row_bf16(dst, lane, o);
    if (dst8) {
#pragma unroll
        for (int j = 0; j < 2; ++j) { u32x2 q; q.x = pack4_fp8(o[8 * j], o[8 * j + 1], o[8 * j + 2], o[8 * j + 3]); q.y = pack4_fp8(o[8 * j + 4], o[8 * j + 5], o[8 * j + 6], o[8 * j + 7]); *(u32x2*)(dst8 + 8 * lane + 512 * j) = q; } }
}
__device__ __forceinline__ void norm_mod_blk(const float (&x)[16], const float (&wv)[16], const float (&sh)[16], const float (&sc)[16], bf16_t* base, unsigned char* base8, int r, int lane) {
    float ss = 0.f;
#pragma unroll
    for (int i = 0; i < 16; ++i) ss += x[i] * x[i];
    const float rs = rsqrtf(wave_sum(ss) * (1.0f / 1024.0f) + RMS_EPS); float o[16];
#pragma unroll
    for (int i = 0; i < 16; ++i) o[i] = x[i] * rs * wv[i] * (1.0f + sc[i]) + sh[i];
#pragma unroll
    for (int j = 0; j < 2; ++j) *(u32x4*)(base + blk_off(r, 8 * lane + 512 * j)) = pack8(&o[8 * j]);
#pragma unroll
    for (int j = 0; j < 2; ++j) { u32x2 q; q.x = pack4_fp8(o[8 * j], o[8 * j + 1], o[8 * j + 2], o[8 * j + 3]); q.y = pack4_fp8(o[8 * j + 4], o[8 * j + 5], o[8 * j + 6], o[8 * j + 7]); *(u32x2*)(base8 + blk_off8(r, 8 * lane + 512 * j)) = q; }
}
__device__ __forceinline__ void phase_pre0(const PL& P) {
    const int lane = TID & 63, gw = BID * 8 + wave_id(), NGW = GDIM * 8;
    unsigned char* ws = P.ws(); const float* xin = P.in(IX); const float* cin = P.in(ICTX); const float* nw = P.in(IMNPRE);
    bf16_t* A0 = (bf16_t*)(ws + WS_R2); unsigned char* A08 = ws + WS_A2Q;
    float wv[16]; ld_row_f32(nw, lane, wv);
    for (int r = gw; r < TT; r += 2 * NGW) { const int r2 = r + NGW; const bool has2 = r2 < TT;
        float xa[16], sha[16], sca[16], xb[16], shb[16], scb[16];
        ld_row_f32(xrow(xin, cin, r), lane, xa); ld_row_f32(modp(ws, 0, r, 0), lane, sha); ld_row_f32(modp(ws, 0, r, 1), lane, sca);
        if (has2) { ld_row_f32(xrow(xin, cin, r2), lane, xb); ld_row_f32(modp(ws, 0, r2, 0), lane, shb); ld_row_f32(modp(ws, 0, r2, 1), lane, scb); }
        norm_mod_blk(xa, wv, sha, sca, A0, A08, r, lane);
        if (has2) norm_mod_blk(xb, wv, shb, scb, A0, A08, r2, lane); }
}

template <int I0, int NI>
__device__ __forceinline__ void conv_finish(float (&acc)[NI][8], int r, int lane, const LAS float* cbias, float gc0, float gc1, unsigned char* ws) {
    static_assert(NI == 1, "one chunk per pass");
#pragma unroll
    for (int j = 0; j < 8; ++j) { float a = acc[0][j]; if (I0 >= 3) a += cbias[8 * (lane + 64 * (I0 - 3)) + j]; acc[0][j] = siluf(a); }
    if (I0 < 2) { float ss = 0.f;
#pragma unroll
        for (int j = 0; j < 8; ++j) ss += acc[0][j] * acc[0][j];
        ss += __shfl_xor(ss, 1); ss += __shfl_xor(ss, 2); ss += __shfl_xor(ss, 4); ss += __shfl_xor(ss, 8);
        const float sc = rsqrtf(ss + RMS_EPS);
#pragma unroll
        for (int j = 0; j < 8; ++j) acc[0][j] *= sc; }
    if (I0 < 4) { bf16_t* dst = (bf16_t*)(ws + (I0 == 0 ? WS_Q : (I0 == 1 ? WS_K : (I0 == 2 ? WS_V : WS_XS)))); *(u32x4*)(dst + (size_t)r * 512 + 8 * lane) = pack8(acc[0]); }
    else {
        bf16_t* BMm = (bf16_t*)(ws + WS_BM); bf16_t* CMm = (bf16_t*)(ws + WS_CM);
        const float* GATE = (const float*)(ws + WS_GATE); float* G = (float*)(ws + WS_GPOST); float* BETA = G + (size_t)TT * 8; float* DT = BETA + (size_t)TT * 8; float* DA = DT + (size_t)TT * 16;
        if (lane < 32) *(u32x4*)(BMm + (size_t)r * 256 + 8 * lane) = pack8(acc[0]); else *(u32x4*)(CMm + (size_t)r * 256 + 8 * (lane - 32)) = pack8(acc[0]);
        if (lane < 32) { const float raw = GATE[(size_t)r * 32 + lane];
            if (lane < 8) { G[(size_t)r * 8 + lane] = gc0 * softplusf_(raw + gc1); }
            else if (lane < 16) { BETA[(size_t)r * 8 + lane - 8] = 1.0f / (1.0f + expf(-raw)); }
            else { const int j = lane - 16; const float dt = softplusf_(raw + gc1); DT[(size_t)r * 16 + j] = dt; DA[(size_t)r * 16 + j] = gc0 * dt; } }
    }
}
template <int I>
__device__ __forceinline__ void conv_step1(float (&Am)[1][8], float (&Az)[1][8], float (&Ap)[1][8], const u32x4 (&x)[3], const float (&wr)[9][8], int cn, int c0, int rowbase, int lane,
                                           const LAS float* cbias, float gc0, float gc1, unsigned char* ws) {
#pragma unroll
    for (int d = 0; d < 3; ++d) { float xv[8]; unpack8(x[d], xv);
#pragma unroll
        for (int j = 0; j < 8; ++j) { Am[0][j] += xv[j] * wr[d * 3 + 2][j]; Az[0][j] += xv[j] * wr[d * 3 + 1][j]; Ap[0][j] += xv[j] * wr[d * 3 + 0][j]; } }
    const int co = cn - 1;
    if (co >= c0 && co < c0 + 32) conv_finish<I, 1>(Am, rowbase + co, lane, cbias, gc0, gc1, ws);
#pragma unroll
    for (int j = 0; j < 8; ++j) Am[0][j] = 0.f;
}
template <int I>
__device__ __forceinline__ void conv_walk1(int c0, int rr, int nrows, int ncols, int rowbase, int lane, const bf16_t* CA, const bf16_t* CB, const LAS float* cw, const LAS float* cbias, float gc0, float gc1, unsigned char* ws) {
    const int ch = 8 * (lane + 64 * I), pitch = I < 3 ? 1536 : 1024; const bf16_t* src = I < 3 ? CA + ch : CB + ch - 1536;
    float wr[9][8];
#pragma unroll
    for (int tap = 0; tap < 9; ++tap) { const f32x4 w0 = *(const LAS f32x4*)(cw + tap * 2560 + ch), w1 = *(const LAS f32x4*)(cw + tap * 2560 + ch + 4); wr[tap][0] = w0.x; wr[tap][1] = w0.y; wr[tap][2] = w0.z; wr[tap][3] = w0.w; wr[tap][4] = w1.x; wr[tap][5] = w1.y; wr[tap][6] = w1.z; wr[tap][7] = w1.w; }
    const bool rup = rr - 1 >= 0, rdn = rr + 1 < nrows;
#define CONV_LDCOL(cn_, x_) do { const int cq_ = (cn_) < 0 ? 0 : ((cn_) >= ncols ? ncols - 1 : (cn_)); const bool cok_ = (cn_) >= 0 && (cn_) < ncols; \
        const u32x4 z_ = (u32x4){0u, 0u, 0u, 0u}; \
        const u32x4 a_ = *(const u32x4*)(src + (size_t)(rowbase + (rup ? -ncols : 0) + cq_) * pitch), b_ = *(const u32x4*)(src + (size_t)(rowbase + cq_) * pitch), c_ = *(const u32x4*)(src + (size_t)(rowbase + (rdn ? ncols : 0) + cq_) * pitch); \
        x_[0] = (cok_ && rup) ? a_ : z_; x_[1] = cok_ ? b_ : z_; x_[2] = (cok_ && rdn) ? c_ : z_; } while (0)
    float A0[1][8], A1[1][8], A2[1][8];
#pragma unroll
    for (int j = 0; j < 8; ++j) { A0[0][j] = 0.f; A1[0][j] = 0.f; A2[0][j] = 0.f; }
    u32x4 X0[3], X1[3], X2[3], X3[3];
    CONV_LDCOL(c0 - 1, X0); CONV_LDCOL(c0, X1); CONV_LDCOL(c0 + 1, X2); CONV_LDCOL(c0 + 2, X3);
#define CONV_ST(k_, Am_, Az_, Ap_, X_) do { conv_step1<I>(Am_, Az_, Ap_, X_, wr, cn + (k_), c0, rowbase, lane, cbias, gc0, gc1, ws); CONV_LDCOL(cn + (k_) + 4, X_); } while (0)
#pragma unroll 1
    for (int st = 0; st < 36; st += 12) { const int cn = c0 - 1 + st;
        CONV_ST(0, A0, A1, A2, X0); CONV_ST(1, A1, A2, A0, X1); CONV_ST(2, A2, A0, A1, X2); CONV_ST(3, A0, A1, A2, X3);
        CONV_ST(4, A1, A2, A0, X0); CONV_ST(5, A2, A0, A1, X1); CONV_ST(6, A0, A1, A2, X2); CONV_ST(7, A1, A2, A0, X3);
        CONV_ST(8, A2, A0, A1, X0); CONV_ST(9, A0, A1, A2, X1); CONV_ST(10, A1, A2, A0, X2); CONV_ST(11, A2, A0, A1, X3); }
#undef CONV_ST
#undef CONV_LDCOL
}
__device__ __forceinline__ void phase_conv2(const PL& P, LAS unsigned char* lds) {
    LAS float* cw = (LAS float*)lds;
    LAS float* cbias = cw + 9 * 2560;
    const int tid = TID, lane = tid & 63, gw = BID * 8 + wave_id(), NGW = GDIM * 8;
    unsigned char* ws = P.ws();
    { const float* gcw = P.in(IGCW); const float* scw = P.in(ISCW); const float* scb = P.in(ISCB);
    for (int i = tid; i < 9 * 2560; i += 512) { const int tap = i / 2560, c = i % 2560; cw[i] = c < 1536 ? gcw[tap * 1536 + c] : scw[tap * 1024 + c - 1536]; }
    for (int i = tid; i < 1024; i += 512) cbias[i] = scb[i]; }
    float gc0 = 0.f, gc1 = 0.f;
    if (lane < 8) { gc0 = -expf(P.in(IGALOG)[lane]); gc1 = P.in(IGDTB)[lane]; } else if (lane >= 16 && lane < 32) { gc0 = -expf(P.in(ISALOG)[lane - 16]); gc1 = P.in(ISDTB)[lane - 16]; }
    __syncthreads();
    const bf16_t* CA = (const bf16_t*)(ws + WS_CONVA); const bf16_t* CB = (const bf16_t*)(ws + WS_CONVB);
    for (int it2 = gw; it2 < 5 * 2304; it2 += NGW) { const int pass = it2 / 2304, item = it2 - pass * 2304;
        int rr, nrows, ncols, rowbase, c0;
        if (item < 2048) { const int b = item >> 6; rr = (item >> 1) & 31; c0 = (item & 1) * 32; nrows = 32; ncols = 64; rowbase = b * 2048 + rr * 64; }
        else { const int j = item - 2048, b = j >> 3; rr = 0; c0 = (j & 7) * 32; nrows = 1; ncols = 256; rowbase = TL + b * 256; }
        if (pass == 0) conv_walk1<0>(c0, rr, nrows, ncols, rowbase, lane, CA, CB, cw, cbias, gc0, gc1, ws);
        else if (pass == 1) conv_walk1<1>(c0, rr, nrows, ncols, rowbase, lane, CA, CB, cw, cbias, gc0, gc1, ws);
        else if (pass == 2) conv_walk1<2>(c0, rr, nrows, ncols, rowbase, lane, CA, CB, cw, cbias, gc0, gc1, ws);
        else if (pass == 3) conv_walk1<3>(c0, rr, nrows, ncols, rowbase, lane, CA, CB, cw, cbias, gc0, gc1, ws);
        else conv_walk1<4>(c0, rr, nrows, ncols, rowbase, lane, CA, CB, cw, cbias, gc0, gc1, ws);
    }
}

__device__ __forceinline__ int seq_row(int b, int d, int s) { if (s < 256) { const int l = d ? 255 - s : s; return TL + b * 256 + l; } const int l0 = s - 256, l = d ? 2047 - l0 : l0; return b * 2048 + l; }

#define NFMA(r, a, b) asm("v_fma_f32 %0, -%1, %2, %0" : "+v"(r) : "v"(a), "v"(b))
#define MFMA16(a, b, c) __builtin_amdgcn_mfma_f32_16x16x32_bf16((a), (b), (c), 0, 0, 0)
__device__ __forceinline__ bf16x8 fragl(const LAS bf16_t* M, int pitch, int row0, int k0, int lane) { return *(const LAS bf16x8*)(M + (row0 + (lane & 15)) * pitch + k0 + 8 * (lane >> 4)); }
typedef short s16x4 __attribute__((ext_vector_type(4)));
__device__ __forceinline__ bf16x8 fragt(const LAS bf16_t* M, int pitch, int r0, int c0, int lane) {
    const LAS bf16_t* p = M + (r0 + 8 * (lane >> 4) + ((lane & 15) >> 2)) * pitch + c0 + 4 * (lane & 3);
    const s16x4 lo = __builtin_amdgcn_ds_read_tr16_b64_v4i16((LAS s16x4*)p), hi = __builtin_amdgcn_ds_read_tr16_b64_v4i16((LAS s16x4*)(p + 4 * pitch));
    return (bf16x8){lo[0], lo[1], lo[2], lo[3], hi[0], hi[1], hi[2], hi[3]};
}
constexpr int GDN_NCHUNK = 36, GDN_NINST = 256 * GDN_NCHUNK;
constexpr size_t WS_GUT = WS_OGDN, WS_GWT = WS_R2, WS_GQK = 672 * MiB, WS_GEG = WS_GATE;

__device__ __forceinline__ void phase_gdn1m(const PL& P, LAS unsigned char* lds, size_t ut_off) {
    unsigned char* ws = P.ws();
    const bf16_t* Q = (const bf16_t*)(ws + WS_Q); const bf16_t* Kk = (const bf16_t*)(ws + WS_K); const bf16_t* V = (const bf16_t*)(ws + WS_V);
    const float* G = (const float*)(ws + WS_GPOST); const float* BETA = G + (size_t)TT * 8;
    bf16_t* UT = (bf16_t*)(ws + ut_off); bf16_t* WT = (bf16_t*)(ws + WS_GWT); bf16_t* QKo = (bf16_t*)(ws + WS_GQK);
    float* EG = (float*)(ws + WS_GEG); float* EGL = EG + (size_t)GDN_NINST * 64; float* GL = EGL + (size_t)GDN_NINST * 64;
    LAS bf16_t* Kl = (LAS bf16_t*)lds; LAS bf16_t* Ql = Kl + 64 * 136; LAS bf16_t* Vl = Ql + 64 * 136;
    LAS bf16_t* Mb = Vl + 64 * 136;
    LAS float* Md = (LAS float*)(Mb + 64 * 72);
    LAS bf16_t* Tb = (LAS bf16_t*)(Md + 4 * 16 * 20);
    LAS bf16_t* XT = Tb + 4 * 16 * 40;
    LAS bf16_t* YT = XT + 256 * 72;
    LAS float* gcs = (LAS float*)(YT + 256 * 40); LAS float* bet = gcs + 64; LAS float* betw = bet + 64;
    { const int t0 = TID; __syncthreads();
      for (int i = t0; i < (64 * 72 + 4 * 16 * 20 * 2 + 4 * 16 * 40 + 256 * 72 + 256 * 40) / 8; i += 512) *(LAS u32x4*)((LAS unsigned char*)Mb + i * 16) = (u32x4){0u, 0u, 0u, 0u};
      __syncthreads(); }
    u32x4 pf[6]; float pg = 0.f, pbeta = 0.f;
#define GDN1M_PREFETCH(id_) do { const int tid_ = TID + opaque0(), chain_ = (id_) / GDN_NCHUNK, c_ = (id_) % GDN_NCHUNK, d_ = chain_ & 1, h_ = (chain_ >> 1) & 3, b_ = chain_ >> 3; \
        _Pragma("unroll") for (int u_ = 0; u_ < 6; ++u_) { const int idx = tid_ + 512 * u_, wh = idx >> 10, rem = idx & 1023, i = rem >> 4, off = (rem & 15) * 8; const int row = seq_row(b_, d_, c_ * 64 + i); \
            const bf16_t* src = wh == 0 ? Kk : (wh == 1 ? Q : V); pf[u_] = *(const u32x4*)(src + (size_t)row * 512 + h_ * 128 + off); } \
        if (tid_ < 64) { const int row = seq_row(b_, d_, c_ * 64 + tid_); pg = G[(size_t)row * 8 + d_ * 4 + h_]; pbeta = BETA[(size_t)row * 8 + d_ * 4 + h_]; } } while (0)
    if (BID < GDN_NINST) GDN1M_PREFETCH(BID);
    for (int id = BID; id < GDN_NINST; id += GDIM) {
        const int tid = TID + opaque0(), lane = tid & 63, wave = __builtin_amdgcn_readfirstlane(tid >> 6), q4 = lane >> 4, l15 = lane & 15;
        LDS_BAR();
#pragma unroll
        for (int u_ = 0; u_ < 6; ++u_) { const int idx = tid + 512 * u_, wh = idx >> 10, rem = idx & 1023, i = rem >> 4, off = (rem & 15) * 8;
            LAS bf16_t* dst = wh == 0 ? Kl : (wh == 1 ? Ql : Vl); *(LAS u32x4*)(dst + i * 136 + off) = pf[u_]; }
        if (wave == 0) { float gc = pg; const float be = pbeta;
#pragma unroll
            for (int o = 1; o < 64; o <<= 1) { const float t = __shfl_up(gc, o); if (lane >= o) gc += t; }
            const float gl = __shfl(gc, 63);
            gcs[lane] = gc; bet[lane] = be; betw[lane] = be * expf(gc); EG[(size_t)id * 64 + lane] = expf(gc); EGL[(size_t)id * 64 + lane] = expf(gl - gc); if (lane == 0) GL[id] = expf(gl); }
        LDS_BAR();
        if (id + GDIM < GDN_NINST) GDN1M_PREFETCH(id + GDIM);
#pragma unroll 1
        for (int tl = wave; tl < 10; tl += 8) { const int it = tl < 1 ? 0 : (tl < 3 ? 1 : (tl < 6 ? 2 : 3)), jt = tl - (it * (it + 1)) / 2;
            const int i0 = it * 16, i = i0 + l15, j0 = jt * 16 + 4 * q4; const float gci = gcs[i], bi = bet[i]; f32x4 a = (f32x4){0.f, 0.f, 0.f, 0.f}, a2 = a;
#pragma unroll
            for (int k0 = 0; k0 < 128; k0 += 32) { const bf16x8 fj = fragl(Kl, 136, jt * 16, k0, lane); a = MFMA16(fj, fragl(Kl, 136, i0, k0, lane), a); a2 = MFMA16(fj, fragl(Ql, 136, i0, k0, lane), a2); }
            float mv[4], qv[4];
#pragma unroll
            for (int jj = 0; jj < 4; ++jj) { const int j = j0 + jj; const float ex = __expf(fminf(gci - gcs[j], 0.f)); const float dec = (j <= i) ? ex : 0.f; mv[jj] = (j < i) ? bi * a[jj] * dec : 0.f; qv[jj] = a2[jj] * 0.08838834764831845f * dec; }
            if (it == jt) *(LAS f32x4*)(Md + (it * 16 + l15) * 20 + 4 * q4) = (f32x4){mv[0], mv[1], mv[2], mv[3]};
            else { u32x2 w; w.x = cvt_pk_bf16(-mv[0], -mv[1]); w.y = cvt_pk_bf16(-mv[2], -mv[3]); *(LAS u32x2*)(Mb + i * 72 + j0) = w; }
            u32x2 w; w.x = cvt_pk_bf16(qv[0], qv[1]); w.y = cvt_pk_bf16(qv[2], qv[3]); *(u32x2*)(QKo + ((size_t)id * 64 + i) * 64 + j0) = w; }
        if (wave >= 2) { const int tz = wave - 2;
            const int it = tz < 3 ? 0 : (tz < 5 ? 1 : 2), jt = tz < 3 ? tz + 1 : (tz < 5 ? tz - 1 : 3);
            *(u32x2*)(QKo + ((size_t)id * 64 + it * 16 + l15) * 64 + jt * 16 + 4 * q4) = (u32x2){0u, 0u}; }
        LDS_BAR();
        if (tid < 64) { const int I = tid >> 4, c = tid & 15; const LAS float* md = Md + I * 16 * 20; float t[16];
#pragma unroll
            for (int i = 0; i < 16; ++i) { float r = (i == c) ? 1.0f : 0.0f;
#pragma unroll
                for (int j4 = 0; j4 < (i + 3) / 4; ++j4) { const f32x4 m = *(const LAS f32x4*)(md + i * 20 + 4 * j4);
                    NFMA(r, m.x, t[4 * j4]); if (4 * j4 + 1 < i) NFMA(r, m.y, t[4 * j4 + 1]); if (4 * j4 + 2 < i) NFMA(r, m.z, t[4 * j4 + 2]); if (4 * j4 + 3 < i) NFMA(r, m.w, t[4 * j4 + 3]); }
                t[i] = r; Tb[(I * 16 + i) * 40 + c] = f2bf(r); } }
        LDS_BAR();
#pragma unroll
        for (int I = 0; I < 4; ++I) {
            f32x4 acc[2];
#pragma unroll
            for (int tt = 0; tt < 2; ++tt) { const int ct = 2 * wave + tt, c0 = ct * 16, col = (c0 & 127) + l15; const LAS bf16_t* src = ct < 8 ? Vl : Kl; const LAS float* rsc = ct < 8 ? bet : betw;
#pragma unroll
                for (int jj = 0; jj < 4; ++jj) { const int i = 16 * I + 4 * q4 + jj; acc[tt][jj] = rsc[i] * bf1(src[i * 136 + col]); }
                if (I >= 1) { acc[tt] = MFMA16(fragl(Mb, 72, 16 * I, 0, lane), fragl(XT, 72, c0, 0, lane), acc[tt]); if (I == 3) acc[tt] = MFMA16(fragl(Mb, 72, 48, 32, lane), fragl(XT, 72, c0, 32, lane), acc[tt]); }
                u32x2 w; w.x = cvt_pk_bf16(acc[tt][0], acc[tt][1]); w.y = cvt_pk_bf16(acc[tt][2], acc[tt][3]); *(LAS u32x2*)(YT + (c0 + l15) * 40 + 4 * q4) = w; }
#pragma unroll
            for (int tt = 0; tt < 2; ++tt) { const int ct = 2 * wave + tt, c0 = ct * 16, col = (c0 & 127) + l15;
                const f32x4 zero4 = {0.f, 0.f, 0.f, 0.f}; const f32x4 x = MFMA16(fragl(Tb + I * 16 * 40, 40, 0, 0, lane), fragl(YT, 40, c0, 0, lane), zero4);
                u32x2 w; w.x = cvt_pk_bf16(x[0], x[1]); w.y = cvt_pk_bf16(x[2], x[3]);
                *(LAS u32x2*)(XT + (c0 + l15) * 72 + 16 * I + 4 * q4) = w;
                *(u32x2*)((ct < 8 ? UT : WT) + ((size_t)id * 128 + col) * 64 + 16 * I + 4 * q4) = w; }
        }
    }
#undef GDN1M_PREFETCH
}

__device__ __forceinline__ void phase_gdn2(const PL& P, LAS unsigned char* lds, size_t ut_off) {
    const int tid = TID + opaque0(), lane = tid & 63, wave = __builtin_amdgcn_readfirstlane(tid >> 6), q4 = lane >> 4, l15 = lane & 15;
    LAS bf16_t* WTl = (LAS bf16_t*)lds;
    LAS bf16_t* Ql = WTl + 128 * 72;
    LAS bf16_t* Kdl = Ql + 64 * 136;
    LAS bf16_t* QKl = Kdl + 64 * 136;
    LAS bf16_t* VnT = QKl + 64 * 72;
    LAS bf16_t* St = VnT + 128 * 72;
    unsigned char* ws = P.ws();
    const bf16_t* Q = (const bf16_t*)(ws + WS_Q); const bf16_t* Kk = (const bf16_t*)(ws + WS_K);
    bf16_t* UT = (bf16_t*)(ws + ut_off); const bf16_t* WT = (const bf16_t*)(ws + WS_GWT); const bf16_t* QKo = (const bf16_t*)(ws + WS_GQK);
    const float* EG = (const float*)(ws + WS_GEG); const float* EGL = EG + (size_t)GDN_NINST * 64; const float* GL = EGL + (size_t)GDN_NINST * 64;
    const int dv0 = wave * 16;
    for (int chain = BID; chain < 256; chain += GDIM) { const int d = chain & 1, h = (chain >> 1) & 3, b = chain >> 3;
        f32x4 S[8];
#pragma unroll
        for (int t = 0; t < 8; ++t) S[t] = (f32x4){0.f, 0.f, 0.f, 0.f};
        for (int i = lane; i < 16 * 136 / 8; i += 64) *(LAS u32x4*)(St + dv0 * 136 + i * 8) = (u32x4){0u, 0u, 0u, 0u};
        u32x4 pw[2], pq[2], pk[2], pqk; float peg[2], pegl[2]; u32x2 uu[4]; float pgl;
#define GDN2_PREFETCH(c_) do { const size_t id_ = (size_t)chain * GDN_NCHUNK + (c_); _Pragma("unroll") for (int u_ = 0; u_ < 2; ++u_) { const int idx = tid + 512 * u_; \
            { const int dk_ = idx >> 3, i8_ = (idx & 7) * 8; pw[u_] = *(const u32x4*)(WT + (id_ * 128 + dk_) * 64 + i8_); } \
            { const int i_ = idx >> 4, off_ = (idx & 15) * 8; const int row_ = seq_row(b, d, (c_) * 64 + i_); pq[u_] = *(const u32x4*)(Q + (size_t)row_ * 512 + h * 128 + off_); pk[u_] = *(const u32x4*)(Kk + (size_t)row_ * 512 + h * 128 + off_); \
              peg[u_] = EG[id_ * 64 + i_]; pegl[u_] = EGL[id_ * 64 + i_]; } } \
            pqk = *(const u32x4*)(QKo + id_ * 4096 + tid * 8); pgl = GL[id_]; \
            _Pragma("unroll") for (int it_ = 0; it_ < 4; ++it_) uu[it_] = *(const u32x2*)(UT + (id_ * 128 + dv0 + l15) * 64 + it_ * 16 + 4 * q4); } while (0)
        GDN2_PREFETCH(0);
        for (int c = 0; c < GDN_NCHUNK; ++c) { const size_t id = (size_t)chain * GDN_NCHUNK + c;
            LDS_BAR();
#pragma unroll
            for (int u_ = 0; u_ < 2; ++u_) { const int idx = tid + 512 * u_;
                { const int dk_ = idx >> 3, i8_ = (idx & 7) * 8; *(LAS u32x4*)(WTl + dk_ * 72 + i8_) = (u32x4){pw[u_].x ^ 0x80008000u, pw[u_].y ^ 0x80008000u, pw[u_].z ^ 0x80008000u, pw[u_].w ^ 0x80008000u}; }
                { const int i_ = idx >> 4, off_ = (idx & 15) * 8; float qv[8], kv[8]; unpack8(pq[u_], qv); unpack8(pk[u_], kv); const float sq = peg[u_] * 0.08838834764831845f, sk = pegl[u_];
#pragma unroll
                  for (int e = 0; e < 8; ++e) { qv[e] *= sq; kv[e] *= sk; }
                  *(LAS u32x4*)(Ql + i_ * 136 + off_) = pack8(qv); *(LAS u32x4*)(Kdl + i_ * 136 + off_) = pack8(kv); } }
            { const int i_ = tid >> 3, j8_ = (tid & 7) * 8; *(LAS u32x4*)(QKl + i_ * 72 + j8_) = pqk; }
            const float glast = pgl;
            f32x4 vn[4], o[4];
#pragma unroll
            for (int it = 0; it < 4; ++it) { vn[it] = (f32x4){bflo(uu[it].x), bfhi(uu[it].x), bflo(uu[it].y), bfhi(uu[it].y)}; o[it] = (f32x4){0.f, 0.f, 0.f, 0.f}; }
            LDS_BAR();
            if (c + 1 < GDN_NCHUNK) GDN2_PREFETCH(c + 1);
#pragma unroll
            for (int k0 = 0; k0 < 128; k0 += 32) { const bf16x8 fs = fragl(St, 136, dv0, k0, lane);
#pragma unroll
                for (int it = 0; it < 4; ++it) { vn[it] = MFMA16(fragt(WTl, 72, k0, it * 16, lane), fs, vn[it]); o[it] = MFMA16(fs, fragl(Ql, 136, it * 16, k0, lane), o[it]); } }
#pragma unroll
            for (int it = 0; it < 4; ++it) { u32x2 w; w.x = cvt_pk_bf16(vn[it][0], vn[it][1]); w.y = cvt_pk_bf16(vn[it][2], vn[it][3]); *(LAS u32x2*)(VnT + (dv0 + l15) * 72 + it * 16 + 4 * q4) = w; }
#pragma unroll
            for (int t = 0; t < 8; ++t) S[t] = S[t] * glast;
#pragma unroll
            for (int j0 = 0; j0 < 64; j0 += 32) { const bf16x8 fv = fragl(VnT, 72, dv0, j0, lane);
#pragma unroll
                for (int it = 0; it < 4; ++it) o[it] = MFMA16(fv, fragl(QKl, 72, it * 16, j0, lane), o[it]);
#pragma unroll
                for (int t = 0; t < 8; ++t) S[t] = MFMA16(fragt(Kdl, 136, j0, t * 16, lane), fv, S[t]); }
#pragma unroll
            for (int it = 0; it < 4; ++it) { u32x2 w; w.x = cvt_pk_bf16(o[it][0], o[it][1]); w.y = cvt_pk_bf16(o[it][2], o[it][3]); *(u32x2*)(UT + (id * 64 + it * 16 + l15) * 128 + dv0 + 4 * q4) = w; }
#pragma unroll
            for (int t = 0; t < 8; ++t) { u32x2 w; w.x = cvt_pk_bf16(S[t][0], S[t][1]); w.y = cvt_pk_bf16(S[t][2], S[t][3]); *(LAS u32x2*)(St + (dv0 + l15) * 136 + t * 16 + 4 * q4) = w; }
        }
#undef GDN2_PREFETCH
        __syncthreads();
    }
}

__device__ __forceinline__ void phase_ssd_chunked(const PL& P, LAS unsigned char* lds, size_t out_off) {
    const int tid = TID + opaque0(), lane = tid & 63, wave = __builtin_amdgcn_readfirstlane(tid >> 6), q4 = lane >> 4, l15 = lane & 15, hl = wave >> 2, pt = wave & 3;
    LAS bf16_t* Cl = (LAS bf16_t*)lds;
    LAS bf16_t* Bl = Cl + 64 * 136;
    LAS bf16_t* HD = Bl + 64 * 136;
    constexpr int HDSZ = 3 * 64 * 72 + 64 * 136;
    LAS float* scal = (LAS float*)(HD + 2 * HDSZ);
    LAS bf16_t* XT1 = HD + hl * HDSZ; LAS bf16_t* XT2 = XT1 + 64 * 72; LAS bf16_t* Sc = XT2 + 64 * 72; LAS bf16_t* Hb = Sc + 64 * 72;
    unsigned char* ws = P.ws();
    const bf16_t* XS = (const bf16_t*)(ws + WS_XS); const bf16_t* BMm = (const bf16_t*)(ws + WS_BM); const bf16_t* CMm = (const bf16_t*)(ws + WS_CM);
    const float* DT = (const float*)(ws + WS_GPOST) + (size_t)TT * 16; const float* DA = DT + (size_t)TT * 16;
    bf16_t* OUT = (bf16_t*)(ws + out_off);
    const int p0 = pt * 16;
    for (int unit = BID; unit < 256; unit += GDIM) { const int hp = unit & 1, d = (unit >> 1) & 1, grp = (unit >> 2) & 1, b = unit >> 3, head = grp * 4 + hp * 2 + hl;
        f32x4 H[8];
#pragma unroll
        for (int t = 0; t < 8; ++t) H[t] = (f32x4){0.f, 0.f, 0.f, 0.f};
        for (int i = lane; i < 16 * 136 / 8; i += 64) *(LAS u32x4*)(Hb + p0 * 136 + i * 8) = (u32x4){0u, 0u, 0u, 0u};
        u32x4 pc[2], pb[2], px[2]; float pdt = 0.f, pda = 0.f;
#define SSD_PREFETCH(c_) do { _Pragma("unroll") for (int u_ = 0; u_ < 2; ++u_) { const int idx = tid + 512 * u_; \
            { const int j_ = idx >> 4, off_ = (idx & 15) * 8; const size_t row_ = (size_t)seq_row(b, d, (c_) * 64 + j_); pc[u_] = *(const u32x4*)(CMm + row_ * 256 + grp * 128 + off_); pb[u_] = *(const u32x4*)(BMm + row_ * 256 + grp * 128 + off_); } \
            { const int h2_ = idx >> 9, rem_ = idx & 511, j_ = rem_ >> 3, off_ = (rem_ & 7) * 8; const size_t row_ = (size_t)seq_row(b, d, (c_) * 64 + j_); px[u_] = *(const u32x4*)(XS + row_ * 512 + (grp * 4 + hp * 2 + h2_) * 64 + off_); } } \
            if (tid < 128) { const int h2_ = tid >> 6, j_ = tid & 63; const size_t row_ = (size_t)seq_row(b, d, (c_) * 64 + j_); pdt = DT[row_ * 16 + d * 8 + grp * 4 + hp * 2 + h2_]; pda = DA[row_ * 16 + d * 8 + grp * 4 + hp * 2 + h2_]; } } while (0)
        SSD_PREFETCH(0);
        for (int c = 0; c < 36; ++c) {
            LDS_BAR();
#pragma unroll
            for (int u_ = 0; u_ < 2; ++u_) { const int idx = tid + 512 * u_, j_ = idx >> 4, off_ = (idx & 15) * 8;
                *(LAS u32x4*)(Cl + j_ * 136 + off_) = pc[u_]; *(LAS u32x4*)(Bl + j_ * 136 + off_) = pb[u_]; }
            if (tid < 128) { const int h2_ = tid >> 6; float acs = pda;
#pragma unroll
                for (int o = 1; o < 64; o <<= 1) { const float t = __shfl_up(acs, o); if (lane >= o) acs += t; }
                const float al = __shfl(acs, 63);
                LAS float* sp = scal + h2_ * 256; sp[lane] = acs; sp[64 + lane] = __expf(acs); sp[128 + lane] = __expf(al - acs); sp[192 + lane] = pdt; if (lane == 0) scal[512 + h2_] = __expf(al); }
            LDS_BAR();
#pragma unroll
            for (int u_ = 0; u_ < 2; ++u_) { const int idx = tid + 512 * u_, h2_ = idx >> 9, rem_ = idx & 511, j_ = rem_ >> 3, off_ = (rem_ & 7) * 8; float xv[8]; unpack8(px[u_], xv);
                const float s1 = scal[h2_ * 256 + 192 + j_], s2 = s1 * scal[h2_ * 256 + 128 + j_]; LAS bf16_t* x1 = HD + h2_ * HDSZ; LAS bf16_t* x2 = x1 + 64 * 72; float x2v[8];
#pragma unroll
                for (int e = 0; e < 8; ++e) { x2v[e] = xv[e] * s2; xv[e] *= s1; }
                *(LAS u32x4*)(x1 + j_ * 72 + off_) = pack8(xv); *(LAS u32x4*)(x2 + j_ * 72 + off_) = pack8(x2v); }
            if (c + 1 < 36) SSD_PREFETCH(c + 1);
            { const LAS float* sp = scal + hl * 256; const int i0 = pt * 16, i = i0 + l15; const float ai = sp[i];
#pragma unroll 1
              for (int jt = 0; jt < 4; ++jt) { const int j0 = jt * 16 + 4 * q4; f32x4 g = (f32x4){0.f, 0.f, 0.f, 0.f};
                  if (jt <= pt) {
#pragma unroll
                      for (int k0 = 0; k0 < 128; k0 += 32) g = MFMA16(fragl(Bl, 136, jt * 16, k0, lane), fragl(Cl, 136, i0, k0, lane), g); }
                  float sv[4];
#pragma unroll
                  for (int jj = 0; jj < 4; ++jj) { const int j = j0 + jj; const float ex = __expf(fminf(ai - sp[j], 0.f)); sv[jj] = (j <= i) ? g[jj] * ex : 0.f; }
                  u32x2 w; w.x = cvt_pk_bf16(sv[0], sv[1]); w.y = cvt_pk_bf16(sv[2], sv[3]); *(LAS u32x2*)(Sc + i * 72 + j0) = w; } }
            LDS_BAR();
            { const LAS float* sp = scal + hl * 256; f32x4 y[4];
#pragma unroll
              for (int it = 0; it < 4; ++it) y[it] = (f32x4){0.f, 0.f, 0.f, 0.f};
#pragma unroll
              for (int n0 = 0; n0 < 128; n0 += 32) { const bf16x8 fh = fragl(Hb, 136, p0, n0, lane);
#pragma unroll
                  for (int it = 0; it < 4; ++it) y[it] = MFMA16(fh, fragl(Cl, 136, it * 16, n0, lane), y[it]); }
#pragma unroll
              for (int it = 0; it < 4; ++it) y[it] = y[it] * sp[64 + it * 16 + l15];
#pragma unroll
              for (int j0 = 0; j0 < 64; j0 += 32) { const bf16x8 fx = fragt(XT1, 72, j0, p0, lane);
#pragma unroll
                  for (int it = 0; it < 4; ++it) y[it] = MFMA16(fx, fragl(Sc, 72, it * 16, j0, lane), y[it]); }
#pragma unroll
              for (int it = 0; it < 4; ++it) { const size_t row = (size_t)seq_row(b, d, c * 64 + it * 16 + l15); u32x2 w; w.x = cvt_pk_bf16(y[it][0], y[it][1]); w.y = cvt_pk_bf16(y[it][2], y[it][3]);
                  *(u32x2*)(OUT + ((size_t)d * TT + row) * 512 + head * 64 + p0 + 4 * q4) = w; } }
            { const float gl = scal[512 + hl];
#pragma unroll
              for (int t = 0; t < 8; ++t) H[t] = H[t] * gl;
#pragma unroll
              for (int j0 = 0; j0 < 64; j0 += 32) { const bf16x8 fx = fragt(XT2, 72, j0, p0, lane);
#pragma unroll
                  for (int t = 0; t < 8; ++t) H[t] = MFMA16(fragt(Bl, 136, j0, t * 16, lane), fx, H[t]); }
#pragma unroll
              for (int t = 0; t < 8; ++t) { u32x2 w; w.x = cvt_pk_bf16(H[t][0], H[t][1]); w.y = cvt_pk_bf16(H[t][2], H[t][3]); *(LAS u32x2*)(Hb + (p0 + l15) * 136 + t * 16 + 4 * q4) = w; } }
        }
#undef SSD_PREFETCH
        __syncthreads();
    }
}

__device__ __forceinline__ void phase_merge(const PL& P) {
    const int lane = TID & 63, gw = BID * 8 + wave_id(), NGW = GDIM * 8;
    const bf16_t* OG = (const bf16_t*)(P.ws() + WS_OGDN); const bf16_t* OS = (const bf16_t*)(P.ws() + WS_OSSD); const bf16_t* Z = (const bf16_t*)(P.ws() + WS_Z); const bf16_t* XS = (const bf16_t*)(P.ws() + WS_XS);
    bf16_t* MIX = (bf16_t*)(P.ws() + WS_R2);
    float gw8[8], sw8[8]; { const float* a = P.in(IGNW) + (8 * lane) % 128; const float* s = P.in(ISNW) + 8 * lane;
#pragma unroll
        for (int j = 0; j < 8; ++j) { gw8[j] = a[j]; sw8[j] = s[j]; } }
    const float dsk = P.in(ISD)[lane >> 3];
    for (int r = gw; r < TT; r += NGW) {
        float of[8], orv[8], za[8], o[8];
        { int bb, sf, sr; if (r < TL) { bb = r >> 11; const int l = r & 2047; sf = 256 + l; sr = 256 + 2047 - l; } else { bb = (r - TL) >> 8; const int l = (r - TL) & 255; sf = l; sr = 255 - l; }
          const size_t chf = (size_t)((bb * 4 + (lane >> 4)) * 2);
          unpack8(*(const u32x4*)(OG + ((chf * 2304 + sf) * 128) + 8 * (lane & 15)), of); unpack8(*(const u32x4*)(OG + (((chf + 1) * 2304 + sr) * 128) + 8 * (lane & 15)), orv); }
        unpack8(*(const u32x4*)(Z + (size_t)r * 1024 + 8 * lane), za);
        float ss = 0.f;
#pragma unroll
        for (int j = 0; j < 8; ++j) { o[j] = of[j] + orv[j]; ss += o[j] * o[j]; }
        ss += __shfl_xor(ss, 1); ss += __shfl_xor(ss, 2); ss += __shfl_xor(ss, 4); ss += __shfl_xor(ss, 8);
        float rs = rsqrtf(ss * (1.0f / 128.0f) + RMS_EPS);
#pragma unroll
        for (int j = 0; j < 8; ++j) o[j] = o[j] * rs * gw8[j] * siluf(za[j]);
        { u32x2 q; q.x = pack4_fp8(o[0], o[1], o[2], o[3]); q.y = pack4_fp8(o[4], o[5], o[6], o[7]); *(u32x2*)((unsigned char*)MIX + (size_t)r * 1024 + 8 * lane) = q; }
        float yf[8], yr[8], xs[8], zb[8], y[8]; unpack8(*(const u32x4*)(OS + (size_t)r * 512 + 8 * lane), yf); unpack8(*(const u32x4*)(OS + ((size_t)TT + r) * 512 + 8 * lane), yr);
        unpack8(*(const u32x4*)(XS + (size_t)r * 512 + 8 * lane), xs); unpack8(*(const u32x4*)(Z + (size_t)r * 1024 + 512 + 8 * lane), zb);
        ss = 0.f;
#pragma unroll
        for (int j = 0; j < 8; ++j) { y[j] = (yf[j] + yr[j] + dsk * xs[j]) * siluf(zb[j]); ss += y[j] * y[j]; }
        ss += __shfl_xor(ss, 1); ss += __shfl_xor(ss, 2); ss += __shfl_xor(ss, 4); ss += __shfl_xor(ss, 8); ss += __shfl_xor(ss, 16);
        rs = rsqrtf(ss * (1.0f / 256.0f) + RMS_EPS);
#pragma unroll
        for (int j = 0; j < 8; ++j) y[j] = y[j] * rs * sw8[j];
        { u32x2 q; q.x = pack4_fp8(y[0], y[1], y[2], y[3]); q.y = pack4_fp8(y[4], y[5], y[6], y[7]); *(u32x2*)((unsigned char*)MIX + (size_t)r * 1024 + 512 + 8 * lane) = q; }
    }
}

__device__ __forceinline__ void phase_post2(const PL& P, LAS unsigned char* lds, int layer, const bf16_t* YM, int nrows, int CT) {
    const int tid = TID, lane = tid & 63, gw = BID * 8 + wave_id(), NGW = GDIM * 8;
    unsigned char* ws = P.ws(); const float* xin = P.in(IX); const float* cin = P.in(ICTX); const float* nwpost = P.in(IMNPOST) + layer * D; const float* nwpre = P.in(IFNPRE) + layer * D;
    LAS bf16_t* Wl = (LAS bf16_t*)lds;
    { const float* rw = P.in(IRW) + (size_t)layer * 1024 * 32; __syncthreads();
      for (int idx = tid; idx < 1024 * 32; idx += 512) { const int c = idx >> 5, e = idx & 31, l = (c & 511) >> 3, j = c >> 9, i = c & 7; Wl[(((e * 2 + j) * 64) + l) * 8 + i] = __builtin_bit_cast(unsigned short, (_Float16)rw[idx]); }
      __syncthreads(); }
    const float rbias = P.in(IRB)[layer * 32 + (lane >> 1)];
    int* RE = (int*)(ws + WS_RE); int* RP = RE + (size_t)TT * 4; float* RG = (float*)(RP + (size_t)TT * 4);
    int* TOK = (int*)(ws + WS_TOK); unsigned* CNT = (unsigned*)(ws + WS_CTL) + CW_CNT + layer * NCH * 32;
    float w[16], wp[16]; ld_row_f32(nwpost, lane, w); ld_row_f32(nwpre, lane, wp);
    const int rpw = (nrows + NGW - 1) / NGW, rbeg = gw * rpw, rend = (rbeg + rpw < nrows) ? rbeg + rpw : nrows;
    float m2v[16], shv[16], scv[16]; int curb = -1;
    u32x4 yq0, yq1; f32x4 xq0, xq1, xq2, xq3;
#define P2_LOAD(rr) do { const bf16_t* yp_ = YM + (size_t)(rr) * D + 8 * lane; yq0 = *(const u32x4*)yp_; yq1 = *(const u32x4*)(yp_ + 512); \
        if (layer == 0) { const float* xp_ = xrow(xin, cin, (rr)) + 8 * lane; xq0 = *(const f32x4*)xp_; xq1 = *(const f32x4*)(xp_ + 4); xq2 = *(const f32x4*)(xp_ + 512); xq3 = *(const f32x4*)(xp_ + 516); } \
        else { const bf16_t* hp_ = hbrow(ws, (rr)) + 8 * lane; xq0 = __builtin_bit_cast(f32x4, *(const u32x4*)hp_); xq1 = __builtin_bit_cast(f32x4, *(const u32x4*)(hp_ + 512)); } } while (0)
    if (rbeg < rend) P2_LOAD(rbeg);
    int pr = -1, pek = 0, ppos = 0, pch = 0;
    for (int r = rbeg; r < rend; ++r) {
        float y[16], x[16]; unpack8(yq0, &y[0]); unpack8(yq1, &y[8]);
        if (layer == 0) { x[0] = xq0.x; x[1] = xq0.y; x[2] = xq0.z; x[3] = xq0.w; x[4] = xq1.x; x[5] = xq1.y; x[6] = xq1.z; x[7] = xq1.w; x[8] = xq2.x; x[9] = xq2.y; x[10] = xq2.z; x[11] = xq2.w; x[12] = xq3.x; x[13] = xq3.y; x[14] = xq3.z; x[15] = xq3.w; }
        else { unpack8(__builtin_bit_cast(u32x4, xq0), &x[0]); unpack8(__builtin_bit_cast(u32x4, xq1), &x[8]); }
        if (r + 1 < rend) P2_LOAD(r + 1);
        const int bb = r < TL ? (r >> 11) : 32;
        if (bb != curb) { curb = bb; ld_row_f32(modp(ws, layer, r, 2), lane, m2v); ld_row_f32(modp(ws, layer, r, 3), lane, shv); ld_row_f32(modp(ws, layer, r, 4), lane, scv); }
        float ss = 0.f;
#pragma unroll
        for (int i = 0; i < 16; ++i) ss += y[i] * y[i];
        float rs = rsqrtf(wave_sum(ss) * (1.0f / 1024.0f) + RMS_EPS);
#pragma unroll
        for (int i = 0; i < 16; ++i) x[i] += m2v[i] * (y[i] * rs * w[i]);
        st_row_bf16(hbrow(ws, r), lane, x);
        ss = 0.f;
#pragma unroll
        for (int i = 0; i < 16; ++i) ss += x[i] * x[i];
        rs = rsqrtf(wave_sum(ss) * (1.0f / 1024.0f) + RMS_EPS);
        float o[16];
#pragma unroll
        for (int i = 0; i < 16; ++i) o[i] = x[i] * rs * wp[i] * (1.0f + scv[i]) + shv[i];
        { unsigned char* dst8 = ws + WS_A2Q;
#pragma unroll
          for (int j = 0; j < 2; ++j) { u32x2 q; q.x = pack4_fp8(o[8 * j], o[8 * j + 1], o[8 * j + 2], o[8 * j + 3]); q.y = pack4_fp8(o[8 * j + 4], o[8 * j + 5], o[8 * j + 6], o[8 * j + 7]); *(u32x2*)(dst8 + blk_off8(r, 8 * lane + 512 * j)) = q; } }
        typedef _Float16 h2v __attribute__((ext_vector_type(2)));
        h2v op[8];
#pragma unroll
        for (int q = 0; q < 8; ++q) { op[q].x = (_Float16)o[2 * q]; op[q].y = (_Float16)o[2 * q + 1]; }
        float pl[32];
        { typedef unsigned short u16x8 __attribute__((ext_vector_type(8))); u32x4 wb[2][8];
#define P2_LDG(buf, g) do { _Pragma("unroll") for (int q = 0; q < 8; ++q) wb[buf][q] = __builtin_bit_cast(u32x4, *(const LAS u16x8*)(Wl + ((((4 * (g) + (q >> 1)) * 2 + (q & 1)) * 64) + lane) * 8)); } while (0)
          P2_LDG(0, 0);
#pragma unroll
          for (int g = 0; g < 8; ++g) { if (g < 7) P2_LDG((g + 1) & 1, g + 1);
#pragma unroll
              for (int ee = 0; ee < 4; ++ee) { float acc = 0.f;
#pragma unroll
                  for (int j = 0; j < 2; ++j) { const u32x4 wv = wb[g & 1][2 * ee + j]; const unsigned w0 = wv.x, w1 = wv.y, w2 = wv.z, w3 = wv.w;
                      acc = __builtin_amdgcn_fdot2(op[4 * j + 0], __builtin_bit_cast(h2v, w0), acc, false); acc = __builtin_amdgcn_fdot2(op[4 * j + 1], __builtin_bit_cast(h2v, w1), acc, false);
                      acc = __builtin_amdgcn_fdot2(op[4 * j + 2], __builtin_bit_cast(h2v, w2), acc, false); acc = __builtin_amdgcn_fdot2(op[4 * j + 3], __builtin_bit_cast(h2v, w3), acc, false); }
                  pl[4 * g + ee] = acc; }
              __builtin_amdgcn_sched_barrier(0); }
#undef P2_LDG
        }
#pragma unroll
        for (int n = 32, m = 32; n >= 2; n >>= 1, m >>= 1) { const bool up = (lane & m) != 0;
#pragma unroll
            for (int k = 0; k < n / 2; ++k) { const float a = pl[k], b = pl[k + n / 2]; const float snd = up ? a : b, keep = up ? b : a; pl[k] = keep + __shfl_xor(snd, m); } }
        float lg = pl[0] + __shfl_xor(pl[0], 1) + rbias;
        const int myexp = lane >> 1;
        const int lgb = __builtin_bit_cast(int, lg); int rank = 0;
#pragma unroll
        for (int e = 0; e < 32; ++e) { const float L = __builtin_bit_cast(float, __builtin_amdgcn_readlane(lgb, 2 * e)); rank += (L > lg || (L == lg && e < myexp)) ? 1 : 0; }
        int sel[4]; float sv[4];
#pragma unroll
        for (int k = 0; k < 4; ++k) { const unsigned long long m = __builtin_amdgcn_ballot_w64(rank == k); const int l = m ? (int)__builtin_ctzll(m) : 0; sel[k] = l >> 1; sv[k] = __builtin_bit_cast(float, __builtin_amdgcn_readlane(lgb, l)); }
        const float e1 = expf(sv[1] - sv[0]), e2 = expf(sv[2] - sv[0]), e3 = expf(sv[3] - sv[0]), inv = 1.0f / (1.0f + e1 + e2 + e3);
        if (lane < 4) { const int ek = lane == 0 ? sel[0] : (lane == 1 ? sel[1] : (lane == 2 ? sel[2] : sel[3])); const float gk = (lane == 0 ? 1.0f : (lane == 1 ? e1 : (lane == 2 ? e2 : e3))) * inv;
            if (pr >= 0) { RP[(size_t)pr * 4 + lane] = ppos; TOK[((size_t)pch * 32 + pek) * CT + ppos] = pr; }
            const int ch = r / CT; ppos = (int)atomicAdd(&CNT[ch * 32 + ek], 1u); pek = ek; pch = ch;
            RE[(size_t)r * 4 + lane] = ek; RG[(size_t)r * 4 + lane] = gk; }
        pr = r;
    }
    if (pr >= 0 && lane < 4) { RP[(size_t)pr * 4 + lane] = ppos; TOK[((size_t)pch * 32 + pek) * CT + ppos] = pr; }
#undef P2_LOAD
}

__device__ __forceinline__ void moe_tables(const PL& P, LAS unsigned char* lds, int layer, int ch) {
    LAS int* cnt = (LAS int*)(lds + LDS_X + (ch & 1) * 512); LAS int* tp = cnt + 32;
    __syncthreads();
    if (TID == 0) { const unsigned* CNT = (const unsigned*)(P.ws() + WS_CTL) + CW_CNT + (layer * NCH + ch) * 32; int acc = 0;
        for (int e = 0; e < 32; ++e) { const int c = (int)__hip_atomic_load(CNT + e, __ATOMIC_RELAXED, __HIP_MEMORY_SCOPE_AGENT); cnt[e] = c; tp[e] = acc; acc += (c + 255) >> 8; } tp[32] = acc; }
    __syncthreads();
    { const int t = TID; LAS int* te = (LAS int*)(lds + LDS_X + 1024 + (ch & 1) * 2048); if (t < 32) { const int t1 = tp[t + 1]; for (int i = tp[t]; i < t1; ++i) te[i] = t; } }
    __syncthreads();
}
__device__ __forceinline__ void combine_acc(const u32x2 (&yq)[8], const u32x4 (&hq)[2], const float (&g)[4], float (&f)[16], float (&x)[16]) {
#pragma unroll
    for (int i = 0; i < 16; ++i) f[i] = 0.f;
#pragma unroll
    for (int k = 0; k < 4; ++k)
#pragma unroll
        for (int j = 0; j < 2; ++j) { const u32x2 w = yq[2 * k + j];
            const f32x2 a = __builtin_amdgcn_cvt_pk_f32_fp8((int)w.x, false), b = __builtin_amdgcn_cvt_pk_f32_fp8((int)w.x, true), c = __builtin_amdgcn_cvt_pk_f32_fp8((int)w.y, false), d = __builtin_amdgcn_cvt_pk_f32_fp8((int)w.y, true);
            f[8 * j] += g[k] * a.x; f[8 * j + 1] += g[k] * a.y; f[8 * j + 2] += g[k] * b.x; f[8 * j + 3] += g[k] * b.y; f[8 * j + 4] += g[k] * c.x; f[8 * j + 5] += g[k] * c.y; f[8 * j + 6] += g[k] * d.x; f[8 * j + 7] += g[k] * d.y; }
    unpack8(hq[0], &x[0]); unpack8(hq[1], &x[8]);
}
__device__ __forceinline__ void phase_combine(const PL& P, LAS unsigned char* lds, int layer, int ch, int CT) {
    const LAS int* tp = (const LAS int*)(lds + LDS_X + (ch & 1) * 512) + 32;
    const int lane = TID & 63, gw = BID * 8 + wave_id(), NGW = GDIM * 8;
    unsigned char* ws = P.ws(); float* outp = P.out(); const float* nwpost = P.in(IFNPOST) + layer * D; const float* nwpre1 = P.in(IMNPRE) + D;
    const int* RE = (const int*)(ws + WS_RE); const int* RP = RE + (size_t)TT * 4; const float* RG = (const float*)(RP + (size_t)TT * 4);
    const unsigned char* Y = ws + WS_Y + (size_t)(ch & 1) * (160 * MiB); unsigned char* A1 = ws + WS_A1;
    const int rpw = (CT + NGW - 1) / NGW, rlim = (ch + 1) * CT, rbeg = ch * CT + gw * rpw, rend = rbeg + rpw < rlim ? rbeg + rpw : rlim;
    float w[16], wv[16], m5[16], sh[16], sc[16]; ld_row_f32(nwpost, lane, w);
#pragma unroll
    for (int i = 0; i < 16; ++i) { wv[i] = 0.f; m5[i] = 0.f; sh[i] = 0.f; sc[i] = 0.f; }
    if (layer == 0) ld_row_f32(nwpre1, lane, wv);
    int curb = -1;
#define CB_LOAD(set, j) do { _Pragma("unroll") for (int k_ = 0; k_ < 4; ++k_) { const int slot_ = __builtin_amdgcn_readlane(slotL, 4 * (j) + k_); const unsigned char* yp_ = Y + (size_t)slot_ * D + 8 * lane; \
            yq[set][2 * k_] = *(const u32x2*)yp_; yq[set][2 * k_ + 1] = *(const u32x2*)(yp_ + 512); } \
        const bf16_t* hp_ = hbrow(ws, g0 + (j)) + 8 * lane; hq[set][0] = *(const u32x4*)hp_; hq[set][1] = *(const u32x4*)(hp_ + 512); } while (0)
#define CB_ROW(set, j) do { const int r = g0 + (j); float f[16], x[16], g_[4]; \
        _Pragma("unroll") for (int k_ = 0; k_ < 4; ++k_) g_[k_] = __builtin_bit_cast(float, __builtin_amdgcn_readlane(gLb, 4 * (j) + k_)); \
        combine_acc(yq[set], hq[set], g_, f, x); \
        if ((j) + 2 < gn) CB_LOAD(set, (j) + 2); \
        const int bb = r < TL ? (r >> 11) : 32; \
        if (bb != curb) { curb = bb; ld_row_f32(modp(ws, layer, r, 5), lane, m5); if (layer == 0) { ld_row_f32(modp(ws, 1, r, 0), lane, sh); ld_row_f32(modp(ws, 1, r, 1), lane, sc); } } \
        float ss = 0.f; \
        _Pragma("unroll") for (int i = 0; i < 16; ++i) ss += f[i] * f[i]; \
        const float rs = rsqrtf(wave_sum(ss) * (1.0f / 1024.0f) + RMS_EPS); \
        _Pragma("unroll") for (int i = 0; i < 16; ++i) x[i] += m5[i] * (f[i] * rs * w[i]); \
        if (layer == 0) { st_row_bf16(hbrow(ws, r), lane, x); norm_mod_pre(x, wv, sh, sc, nullptr, lane, A1 + (size_t)r * D); } else st_row_f32(outp + (size_t)r * D, lane, x); } while (0)
    for (int g0 = rbeg; g0 < rend; g0 += 16) {
        const int gn = rend - g0 < 16 ? rend - g0 : 16;
        int slotL = 0; float gL = 0.f;
        if (lane < 4 * gn) { const int e = RE[(size_t)g0 * 4 + lane], pos = RP[(size_t)g0 * 4 + lane]; gL = RG[(size_t)g0 * 4 + lane]; slotL = tp[e] * 256 + pos; }
        const int gLb = __builtin_bit_cast(int, gL);
        u32x2 yq[2][8]; u32x4 hq[2][2];
        CB_LOAD(0, 0); if (gn > 1) CB_LOAD(1, 1);
        for (int j = 0; j < gn; j += 2) { CB_ROW(0, j); if (j + 1 < gn) CB_ROW(1, j + 1); }
    }
#undef CB_LOAD
#undef CB_ROW
}

__device__ __forceinline__ void phase_s5_scan(const PL& P) {
    const float* S = (const float*)(P.ws() + WS_S5S); const float* LP = (const float*)(P.ws() + WS_LP); bf16_t* UL = (bf16_t*)(P.ws() + WS_UL);
    for (int idx = BID * 512 + TID; idx < 32 * 64 * 2 * 64; idx += GDIM * 512) { const int p = idx & 63, d = (idx >> 6) & 1, g = (idx >> 7) & 63, b = idx >> 13, dg = d * 64 + g;
        const float lr = LP[(((size_t)dg * 33 + 32) * 64 + p) * 2], li = LP[(((size_t)dg * 33 + 32) * 64 + p) * 2 + 1];
        const float* Sg = S + (size_t)g * S5ROWS * 256 + d * 128 + p; bf16_t* Ug = UL + (size_t)g * S5ROWS * S5K + 512 + d * 128 + p;
        float xr = 0.f, xi = 0.f;
        for (int c = 0; c < 8; ++c) { const int cc = d ? 7 - c : c, row = 2048 + b * 8 + cc; const float sr = Sg[(size_t)row * 256], si = Sg[(size_t)row * 256 + 64];
            const float nr = lr * xr - li * xi + sr, ni = lr * xi + li * xr + si; xr = nr; xi = ni; }
#pragma unroll 8
        for (int c = 0; c < 64; ++c) { const int cc = d ? 63 - c : c, row = b * 64 + cc; const float sr = Sg[(size_t)row * 256], si = Sg[(size_t)row * 256 + 64];
            Ug[(size_t)row * S5K] = f2bf(xr); Ug[(size_t)row * S5K + 64] = f2bf(xi);
            const float nr = lr * xr - li * xi + sr, ni = lr * xi + li * xr + si; xr = nr; xi = ni; }
    }
}

__global__ void __launch_bounds__(512, 2) hybrid_fwd(Params Pk) {
    extern __shared__ __attribute__((aligned(16))) unsigned char lds_raw[];
    LAS unsigned char* lds = (LAS unsigned char*)lds_raw;
    volatile LAS unsigned* MISC = (volatile LAS unsigned*)(lds + LDS_MISC);
    for (int u = threadIdx.x; u < 256; u += 512) MISC[u] = 0u;
    __syncthreads();
    if (threadIdx.x < (NIN + 2) * 2) ((LAS unsigned*)(lds + LDS_PARAMS))[threadIdx.x] = ((const unsigned*)&Pk)[threadIdx.x];
    __syncthreads();
    const int w0_ = __builtin_amdgcn_readfirstlane((int)threadIdx.x >> 6); const PL P0{lds, 0, w0_};
    (void)xcd_barrier_post((unsigned*)(P0.ws() + WS_CTL) + CW_BAR, MISC + 8);
#define GRID_BAR() do { SITE; xcd_barrier(P, MISC + 8); } while (0)
#define SITE const int z_ = opaque0(); const PL P{lds + z_, z_, w0_}

    { SITE; phase_mod(P, lds); __syncthreads(); phase_cvt_dense(P, lds); __syncthreads(); phase_s5_tables(P, lds); }
    GRID_BAR();
    { SITE; phase_pre0(P); }
    GRID_BAR();
    { SITE; unsigned char* ws = P.ws(); DenseSched S; S.init(ws + WS_R2, ws + WS_WIN, TT / 256, 5, 1024, 1024, P.z);
      EpiInProj E{(bf16_t*)(ws + WS_CONVA), (bf16_t*)(ws + WS_CONVB), (bf16_t*)(ws + WS_Z), (float*)(ws + WS_GATE), 0};
      pg8::gemm_phase<EpiInProj, DenseSched, false>(lds, 1024, 64, 64, S, E, TID, 256 * 128); }
    { SITE; unsigned char* ws = P.ws(); DenseSched S; S.init(ws + WS_A2Q, ws + WS_WIN8, TT / 256, 10, 1024, 1024, P.z, 1);
      EpiInProj E{(bf16_t*)(ws + WS_CONVA), (bf16_t*)(ws + WS_CONVB), (bf16_t*)(ws + WS_Z), (float*)(ws + WS_GATE), 1};
      pg8::gemm_phase<EpiInProj, DenseSched, false, true>(lds, 1024, 128, 128, S, E, TID, 256 * 128); }
    GRID_BAR();
    { SITE; phase_conv2(P, lds); }
    GRID_BAR();
    { SITE; phase_gdn1m(P, lds, WS_OGDN); }
    GRID_BAR();
    { SITE; phase_gdn2(P, lds, WS_OGDN); __syncthreads(); phase_ssd_chunked(P, lds, WS_OSSD); }
    GRID_BAR();
    { SITE; phase_merge(P); phase_cvt_moe(P, lds, 0); }
    GRID_BAR();
    { SITE; unsigned char* ws = P.ws(); DenseSched S; S.init(ws + WS_R2, ws + WS_WOUT, TT / 256, 4, 1024, 1024, P.z, 1);
      EpiBf16 E{(bf16_t*)(ws + WS_YMIX), 1024, nullptr, 0, 1.0f / W8_SCALE};
      pg8::gemm_phase<EpiBf16, DenseSched, false, true>(lds, 1024, 1024, 1024, S, E, TID);
      }
    GRID_BAR();

#pragma unroll 1
    for (int layer = 0; layer < 2; ++layer) {
        const int ntok = layer == 0 ? TT : TL, CT = ntok / NCH;
        if (layer == 1) {
            { SITE; phase_s5_mats(P); }
            { SITE; unsigned char* ws = P.ws(); DenseSched S; S.init(ws + WS_A1, ws + WS_WS5IN, TT / 256, 4, 1024, 1024, P.z, 1);
              EpiS5U E{(bf16_t*)(ws + WS_UL)};
              pg8::gemm_phase<EpiS5U, DenseSched, false, true>(lds, 1024, 1024, 1024, S, E, TID);
              }
            GRID_BAR();
            { SITE; unsigned char* ws = P.ws(); GroupSched S{(const char*)(ws + WS_UL), (const char*)(ws + WS_E), (size_t)S5ROWS * S5K * 2, (size_t)256 * 512 * 2, (size_t)256 * S5K * 2, 0, 64, S5ROWS / 256, 1, GDIM, BID};
              EpiS5S E{(float*)(ws + WS_S5S)};
              pg8::gemm_phase<EpiS5S, GroupSched, false>(lds, 512, S5K, 512, S, E, TID);
              }
            GRID_BAR();
            { SITE; phase_s5_scan(P); }
            GRID_BAR();
            { SITE; unsigned char* ws = P.ws(); GroupSched S{(const char*)(ws + WS_UL), (const char*)(ws + WS_MP), (size_t)S5ROWS * S5K * 2, (size_t)512 * S5K * 2, (size_t)256 * S5K * 2, (size_t)256 * S5K * 2, 64, 8, 2, GDIM, BID};
              EpiS5Y E{ws + WS_R2};
              pg8::gemm_phase<EpiS5Y, GroupSched, false>(lds, S5K, S5K, S5K, S, E, TID);
              }
            GRID_BAR();
            { SITE; unsigned char* ws = P.ws(); DenseSched S; S.init(ws + WS_R2, ws + WS_WGLU, TL / 256, 8, 1024, 1024, P.z, 1);
              EpiGLU E{(bf16_t*)(ws + WS_YMIX1)};
              pg8::gemm_phase<EpiGLU, DenseSched, false, true>(lds, 1024, 1024, 1024, S, E, TID);
              }
            GRID_BAR();
        }
        { SITE; phase_post2(P, lds, layer, (const bf16_t*)(P.ws() + (layer == 0 ? WS_YMIX : WS_YMIX1)), ntok, CT); }
        GRID_BAR();
#pragma unroll 1
        for (int k = 0; k < NCH + 2; ++k) {
            if (k >= 2) { SITE; phase_combine(P, lds, layer, k - 2, CT); if (layer == 0 && k == NCH + 1) phase_cvt_moe(P, lds, 1); }
            if (k < NCH) { SITE; moe_tables(P, lds, layer, k); }
            int xrot = 0;
            if (k >= 1 && k <= NCH) { SITE; const int ch = k - 1; const LAS int* cnt = (const LAS int*)(lds + LDS_X + (ch & 1) * 512); const LAS int* tp = cnt + 32; unsigned char* ws = P.ws();
              MoeSched S{tp, cnt, (const LAS int*)(lds + LDS_X + 1024 + (ch & 1) * 2048), 4, tp[32], false, (const char*)(ws + WS_H + (size_t)(ch & 1) * (80 * MiB)), (const char*)(ws + WS_WMOE) + (size_t)32 * 2048 * 1024, (size_t)1024 * 1024, nullptr, CT, GDIM, BID, 1024, 0};
              EpiFp8 E{ws + WS_Y + (size_t)(ch & 1) * (160 * MiB), 1024, P.in(IBD) + (size_t)layer * 32 * 1024, 1024, 1.0f / (W8_SCALE * H8_SCALE)};
              pg8::gemm_phase<EpiFp8, MoeSched, false, true>(lds, 1024, 128, 128, S, E, TID, 256 * 128);
              xrot = __builtin_amdgcn_readfirstlane(((tp[32] + 7) >> 3) & 7); }
            if (k < NCH) { SITE; const int ch = k; const LAS int* cnt = (const LAS int*)(lds + LDS_X + (ch & 1) * 512); const LAS int* tp = cnt + 32; unsigned char* ws = P.ws();
              MoeSched S{tp, cnt, (const LAS int*)(lds + LDS_X + 1024 + (ch & 1) * 2048), 8, tp[32], true, (const char*)(ws + WS_A2Q), (const char*)(ws + WS_WMOE), (size_t)2048 * 1024, (const int*)(ws + WS_TOK) + (size_t)ch * 32 * CT, CT, GDIM, BID, 1024, xrot};
              EpiSwiGLU E{ws + WS_H + (size_t)(ch & 1) * (80 * MiB), P.in(IBG) + (size_t)layer * 32 * 1024, P.in(IBU) + (size_t)layer * 32 * 1024};
              pg8::gemm_phase<EpiSwiGLU, MoeSched, true, true>(lds, 1024, 128, 128, S, E, TID, 256 * 128);
              }
            GRID_BAR();
        }
    }
#undef GRID_BAR
}

extern "C" void kernel_launch(void* const* d_in, const int* in_sizes, int n_in, void* d_out, int out_size, void* d_ws, size_t ws_size, hipStream_t stream) {
    static int grid = 0;
    if (grid == 0) {
        if (n_in != NIN || in_sizes[IX] != TL * D || out_size != TL * D || ws_size < WS_END) { fprintf(stderr, "kernel_launch: unexpected shapes (n_in %d, x %d, out %d, ws %zu < %zu); nothing launched\n", n_in, n_in > 0 ? in_sizes[0] : -1, out_size, ws_size, (size_t)WS_END); grid = -1; return; }
        int dev = 0, cus = 0, per_cu = 0;
        if (hipGetDevice(&dev) != hipSuccess || hipDeviceGetAttribute(&cus, hipDeviceAttributeMultiprocessorCount, dev) != hipSuccess) { grid = -1; return; }
        if (hipFuncSetAttribute((const void*)hybrid_fwd, hipFuncAttributeMaxDynamicSharedMemorySize, LDS_BYTES) != hipSuccess) { fprintf(stderr, "kernel_launch: hipFuncSetAttribute failed\n"); grid = -1; return; }
        if (hipOccupancyMaxActiveBlocksPerMultiprocessor(&per_cu, (const void*)hybrid_fwd, 512, LDS_BYTES) != hipSuccess || per_cu < 1) fprintf(stderr, "kernel_launch: occupancy query reports %d\n", per_cu);
        (void)hipGetLastError();
        grid = cus;
    }
    if (grid < 0) return;
    if (hipMemsetAsync((char*)d_ws + WS_CTL, 0, CTL_ZERO_BYTES, stream) != hipSuccess) return;
    Params p; memset(&p, 0, sizeof(p));
    for (int i = 0; i < NIN; ++i) p.in[i] = (const float*)d_in[i];
    p.out = (float*)d_out; p.ws = (unsigned char*)d_ws;
    hipLaunchKernelGGL(hybrid_fwd, dim3(grid), dim3(512), LDS_BYTES, stream, p);
}
```

```cpp
#include <hip/hip_runtime.h>
#include <cstdio>
#include <cstdint>
#include <cstring>

#define LAS __attribute__((address_space(3)))
typedef unsigned short bf16_t;
typedef short bf16x8 __attribute__((ext_vector_type(8)));
typedef float f32x4 __attribute__((ext_vector_type(4)));
typedef float f32x2 __attribute__((ext_vector_type(2)));
typedef unsigned u32x4 __attribute__((ext_vector_type(4)));
typedef unsigned u32x2 __attribute__((ext_vector_type(2)));

constexpr int D = 1024, NBATCH = 32, SEQ = 2048, CTXL = 256;
constexpr int TL = NBATCH * SEQ, TC = NBATCH * CTXL, TT = TL + TC;
constexpr int NEXP = 32;
constexpr int INW = 3616, INWP = 3840;
constexpr float RMS_EPS = 1e-6f;
constexpr int NCH = 4;
constexpr int S5T = 32, S5ROWS = 2304, S5K = 768;

enum { IX = 0, IC, ICTX, ICCTX, IADAW, IADAB, IMNPRE, IMNPOST, IFNPRE, IFNPOST, IRW, IRB, IWG, IBG, IWU, IBU, IWD, IBD, IHYIN, IGCW, IGALOG, IGDTB, IGNW,
       ISCW, ISCB, ISALOG, ISDTB, ISD, ISNW, IHYOUT, IS5IN, IS5ARE, IS5AIM, IS5LS, IS5BRE, IS5BIM, IS5CRE, IS5CIM, IS5D, IGLUA, IGLUB, NIN };

constexpr size_t MiB = 1u << 20;
constexpr size_t WS_CTL = 0, CTL_ZERO_BYTES = 65536;
constexpr size_t WS_R2 = 1 * MiB;
constexpr size_t WS_Z = 145 * MiB;
constexpr size_t WS_H = 145 * MiB;
constexpr size_t WS_Y = 305 * MiB;
constexpr size_t WS_UL = 145 * MiB;
constexpr size_t WS_YMIX1 = 145 * MiB;
constexpr size_t WS_XS = 289 * MiB;
constexpr size_t WS_GATE = 361 * MiB;
constexpr size_t WS_S5S = 361 * MiB;
constexpr size_t WS_GPOST = 370 * MiB;
constexpr size_t WS_CONVA = 384 * MiB;
constexpr size_t WS_OGDN = 384 * MiB;
constexpr size_t WS_YMIX = 384 * MiB;
constexpr size_t WS_MP = 505 * MiB;
constexpr size_t WS_E = 553 * MiB;
constexpr size_t WS_OSSD = 528 * MiB;
constexpr size_t WS_CONVB = 600 * MiB;
constexpr size_t WS_A1 = 625 * MiB;
constexpr size_t WS_Q = 744 * MiB, WS_K = 816 * MiB, WS_V = 888 * MiB;
constexpr size_t WS_WMOE = 768 * MiB;
constexpr size_t WS_A2Q = 864 * MiB;
constexpr float W8_SCALE = 32.0f, H8_SCALE = 4.0f;

constexpr size_t WS_BM = 960 * MiB, WS_CM = 996 * MiB;
constexpr size_t WS_HCTX = 1032 * MiB;
constexpr size_t WS_MOD = 1064 * MiB;
constexpr size_t WS_WIN = 1066 * MiB;
constexpr size_t WS_WOUT = 1074 * MiB;
constexpr size_t WS_RB = 1076 * MiB;
constexpr size_t WS_WS5IN = 1077 * MiB;
constexpr size_t WS_WGLU = 1079 * MiB;
constexpr size_t WS_KT = 1083 * MiB;
constexpr size_t WS_LP = 1087 * MiB;
constexpr size_t WS_BB = 1090 * MiB;
constexpr size_t WS_WIN8 = 1091 * MiB;
constexpr size_t WS_RE = 1100 * MiB;
constexpr size_t WS_TOK = 1104 * MiB;
constexpr size_t WS_HBL = 936 * MiB;
constexpr size_t WS_HBC = 1113 * MiB;
constexpr size_t WS_END = 1129 * MiB;
constexpr int CW_BAR = 4096, CW_CNT = 8192;

constexpr int LDS_BYTES = 147456, LDS_X = 131072  , LDS_MISC = LDS_BYTES - 1024;

__device__ __forceinline__ float bflo(unsigned w) { return __uint_as_float(w << 16); }
__device__ __forceinline__ float bfhi(unsigned w) { return __uint_as_float(w & 0xffff0000u); }
__device__ __forceinline__ float bf1(bf16_t b) { return __uint_as_float(((unsigned)b) << 16); }
typedef __bf16 bf16n2 __attribute__((ext_vector_type(2)));
__device__ __forceinline__ unsigned cvt_pk_bf16(float lo, float hi) { bf16n2 v; v.x = (__bf16)lo; v.y = (__bf16)hi; return __builtin_bit_cast(unsigned, v); }
__device__ __forceinline__ bf16_t f2bf(float f) { return (bf16_t)(cvt_pk_bf16(f, 0.f) & 0xffffu); }
__device__ __forceinline__ unsigned pack4_fp8(float a, float b, float c, float d) { int w = 0; w = __builtin_amdgcn_cvt_pk_fp8_f32(a, b, w, false); w = __builtin_amdgcn_cvt_pk_fp8_f32(c, d, w, true); return (unsigned)w; }
template <int CTRL, int RM = 0xF, int BM = 0xF> __device__ __forceinline__ float dppmov(float old, float src) { return __builtin_bit_cast(float, __builtin_amdgcn_update_dpp(__builtin_bit_cast(int, old), __builtin_bit_cast(int, src), CTRL, RM, BM, false)); }
template <int CTRL, int RM, int BM, bool BC> __device__ __forceinline__ float dppz(float src) { return __builtin_bit_cast(float, __builtin_amdgcn_update_dpp(0, __builtin_bit_cast(int, src), CTRL, RM, BM, BC)); }
__device__ __forceinline__ float wave_scan(float v) {
    v += dppz<0x111, 0xF, 0xF, true>(v); v += dppz<0x112, 0xF, 0xF, true>(v); v += dppz<0x114, 0xF, 0xF, true>(v); v += dppz<0x118, 0xF, 0xF, true>(v);
    v += dppz<0x142, 0xA, 0xF, false>(v); v += dppz<0x143, 0xC, 0xF, false>(v);
    return v;
}
__device__ __forceinline__ float row16_sum(float v) { v += dppmov<0xB1>(v, v); v += dppmov<0x4E>(v, v); v += dppmov<0x141>(v, v); v += dppmov<0x140>(v, v); return v; }
__device__ __forceinline__ float wave_sum(float v) {
    v += dppmov<0xB1>(v, v); v += dppmov<0x4E>(v, v); v += dppmov<0x141>(v, v); v += dppmov<0x140>(v, v);
    const int b = __builtin_bit_cast(int, v);
    return (__builtin_bit_cast(float, __builtin_amdgcn_readlane(b, 0)) + __builtin_bit_cast(float, __builtin_amdgcn_readlane(b, 16))) + (__builtin_bit_cast(float, __builtin_amdgcn_readlane(b, 32)) + __builtin_bit_cast(float, __builtin_amdgcn_readlane(b, 48)));
}
__device__ __forceinline__ float siluf(float x) { return x * __builtin_amdgcn_rcpf(1.0f + __expf(-x)); }
__device__ __forceinline__ float sigmoidf_(float x) { return __builtin_amdgcn_rcpf(1.0f + __expf(-x)); }
__device__ __forceinline__ float softplusf_(float x) { return x > 20.f ? x : log1pf(expf(x)); }
#define PFMA(r, a, b) asm("v_fmac_f32 %0, %1, %2" : "+v"(r) : "v"(a), "v"(b))
#define LDS_WAIT() asm volatile("s_waitcnt lgkmcnt(0)" ::: "memory")
#define VM_WAIT() asm volatile("s_waitcnt vmcnt(0)" ::: "memory")
#define LDS_BAR() do { asm volatile("s_waitcnt lgkmcnt(0)" ::: "memory"); __builtin_amdgcn_s_barrier(); asm volatile("" ::: "memory"); } while (0)

__device__ __forceinline__ void ld_row_f32(const float* p, int lane, float (&v)[16]) {
#pragma unroll
    for (int j = 0; j < 2; ++j) { const f32x4 a = *(const f32x4*)(p + 8 * lane + 512 * j), b = *(const f32x4*)(p + 8 * lane + 512 * j + 4);
        v[8 * j + 0] = a.x; v[8 * j + 1] = a.y; v[8 * j + 2] = a.z; v[8 * j + 3] = a.w; v[8 * j + 4] = b.x; v[8 * j + 5] = b.y; v[8 * j + 6] = b.z; v[8 * j + 7] = b.w; }
}
__device__ __forceinline__ void st_row_f32(float* p, int lane, const float (&v)[16]) {
#pragma unroll
    for (int j = 0; j < 2; ++j) { *(f32x4*)(p + 8 * lane + 512 * j) = (f32x4){v[8 * j], v[8 * j + 1], v[8 * j + 2], v[8 * j + 3]}; *(f32x4*)(p + 8 * lane + 512 * j + 4) = (f32x4){v[8 * j + 4], v[8 * j + 5], v[8 * j + 6], v[8 * j + 7]}; }
}
__device__ __forceinline__ void unpack8(const u32x4 w, float* v) { v[0] = bflo(w.x); v[1] = bfhi(w.x); v[2] = bflo(w.y); v[3] = bfhi(w.y); v[4] = bflo(w.z); v[5] = bfhi(w.z); v[6] = bflo(w.w); v[7] = bfhi(w.w); }
__device__ __forceinline__ u32x4 pack8(const float* v) { u32x4 w; w.x = cvt_pk_bf16(v[0], v[1]); w.y = cvt_pk_bf16(v[2], v[3]); w.z = cvt_pk_bf16(v[4], v[5]); w.w = cvt_pk_bf16(v[6], v[7]); return w; }
__device__ __forceinline__ size_t blk_off(int r, int c) { return (size_t)(r >> 8) * (256 * 1024) + (size_t)(c >> 6) * (256 * 64) + (size_t)(r & 255) * 64 + (c & 63); }
__device__ __forceinline__ int inproj_row(int n) { const int c = n & 255; return (n & ~255) + 128 * ((c >> 5) & 1) + 32 * (c >> 6) + (c & 31); }
__device__ __forceinline__ size_t blk_off8(int r, int c) { return (size_t)(r >> 8) * (256 * 1024) + (size_t)(c >> 7) * (256 * 128) + (size_t)(r & 255) * 128 + (c & 127); }
__device__ __forceinline__ void ld_row_bf16(const bf16_t* p, int lane, float (&v)[16]) {
#pragma unroll
    for (int j = 0; j < 2; ++j) { const u32x4 w = *(const u32x4*)(p + 8 * lane + 512 * j); unpack8(w, &v[8 * j]); }
}
__device__ __forceinline__ u32x4 pair16(const u32x2 q0, const u32x2 q1, const bool odd) {
    const unsigned sx = odd ? q0.x : q1.x, sy = odd ? q0.y : q1.y;
    const unsigned rx = (unsigned)__builtin_amdgcn_update_dpp(0, (int)sx, 0xB1, 0xF, 0xF, false), ry = (unsigned)__builtin_amdgcn_update_dpp(0, (int)sy, 0xB1, 0xF, 0xF, false);
    return odd ? (u32x4){rx, ry, q1.x, q1.y} : (u32x4){q0.x, q0.y, rx, ry};
}
__device__ __forceinline__ int pair16_col(int lane) { return (lane & 1) ? 512 + 8 * (lane - 1) : 8 * lane; }
__device__ __forceinline__ void ld_row_fp8(const unsigned char* p, int lane, float (&v)[16]) {
#pragma unroll
    for (int j = 0; j < 2; ++j) { const u32x2 w = *(const u32x2*)(p + 8 * lane + 512 * j);
        const f32x2 a = __builtin_amdgcn_cvt_pk_f32_fp8((int)w.x, false), b = __builtin_amdgcn_cvt_pk_f32_fp8((int)w.x, true), c = __builtin_amdgcn_cvt_pk_f32_fp8((int)w.y, false), d = __builtin_amdgcn_cvt_pk_f32_fp8((int)w.y, true);
        v[8 * j] = a.x; v[8 * j + 1] = a.y; v[8 * j + 2] = b.x; v[8 * j + 3] = b.y; v[8 * j + 4] = c.x; v[8 * j + 5] = c.y; v[8 * j + 6] = d.x; v[8 * j + 7] = d.y; }
}
__device__ __forceinline__ void st_row_bf16(bf16_t* p, int lane, const float (&v)[16]) {
#pragma unroll
    for (int j = 0; j < 2; ++j) *(u32x4*)(p + 8 * lane + 512 * j) = pack8(&v[8 * j]);
}

__device__ __forceinline__ int lane_id(int z) { return (int)__builtin_amdgcn_mbcnt_hi(~0u, __builtin_amdgcn_mbcnt_lo(~0u, (unsigned)z)); }
#define XB_TMO      128
#define XB_XCNT(j)  (256  + 64 * (j))
#define XB_XSUB(j)  (1280 + 64 * (j))
#define XB_XGEN(j)  (2304 + 64 * (j))
#define XB_TOP      3328
#define XB_TOPGEN   3392
#define XCD_BAR_WORDS 3456
#define XB_SPIN_CAP (1u << 22)
__device__ __forceinline__ unsigned xb_ld(unsigned* p)              { return __hip_atomic_load(p, __ATOMIC_RELAXED, __HIP_MEMORY_SCOPE_AGENT); }
__device__ __forceinline__ unsigned xb_add(unsigned* p, unsigned v) { return __hip_atomic_fetch_add(p, v, __ATOMIC_RELAXED, __HIP_MEMORY_SCOPE_AGENT); }
__device__ __forceinline__ unsigned xb_xcc_id() { return (unsigned)__builtin_amdgcn_s_getreg((3 << 11) | 20) & 0xFu; }
#define XB_SPIN(cond, bar) do { unsigned _sp = 0; while (cond) { __builtin_amdgcn_s_sleep(1); \
    if ((++_sp & 255u) == 0u) { if (xb_ld(&(bar)[XB_TMO])) break; if (_sp > XB_SPIN_CAP) { atomicAdd(&(bar)[XB_TMO], 1u); break; } } } } while (0)
struct XcdBarrier { unsigned* bar; unsigned x; volatile LAS unsigned* st; };
__device__ __forceinline__ XcdBarrier xcd_barrier_post(unsigned* bar, volatile LAS unsigned* st) {
    XcdBarrier b; b.bar = bar; b.x = xb_xcc_id(); b.st = st;
    if (threadIdx.x == 0) (void)xb_add(&bar[XB_XCNT(b.x)], 1u);
    return b;
}
__device__ __forceinline__ void xcd_barrier_complete(unsigned* bar, unsigned x, unsigned& nloc, unsigned& nx) {
    const unsigned G = gridDim.x * gridDim.y * gridDim.z;
    unsigned sum, cnt, mine, sp = 0u;
    for (;;) {
        sum = 0u; cnt = 0u; mine = 0u;
#pragma unroll
        for (unsigned j = 0; j < 16; ++j) { const unsigned c = xb_ld(&bar[XB_XCNT(j)]); sum += c; cnt += (c > 0u) ? 1u : 0u; mine = (j == x) ? c : mine; }
        if (sum == G) break;
        __builtin_amdgcn_s_sleep(1);
        if ((++sp & 255u) == 0u) { if (xb_ld(&bar[XB_TMO])) break; if (sp > XB_SPIN_CAP) { atomicAdd(&bar[XB_TMO], 1u); break; } }
    }
    nloc = mine > 0u ? mine : 1u; nx = cnt > 0u ? cnt : 1u;
}
template <class PLT> __device__ __forceinline__ void xcd_barrier(const PLT& P, volatile LAS unsigned* st) {
    asm volatile("s_waitcnt vmcnt(0)" ::: "memory");
    __syncthreads();
    if (P.w0 == 0 && lane_id(P.z) == 0) {
        XcdBarrier b; b.bar = (unsigned*)(P.ws() + WS_CTL) + CW_BAR; b.x = xb_xcc_id(); b.st = st;
        unsigned* bar = b.bar;
        __builtin_amdgcn_s_waitcnt(0);
        unsigned nloc = b.st[0], nx = b.st[1];
        if (nloc == 0u) { xcd_barrier_complete(bar, b.x, nloc, nx); b.st[0] = nloc; b.st[1] = nx; }
        const unsigned old = xb_add(&bar[XB_XSUB(b.x)], 1u);
        const unsigned gen = old / nloc;
        if (old + 1u == (gen + 1u) * nloc) {
            __builtin_amdgcn_fence(__ATOMIC_RELEASE, "agent");
            asm volatile("s_waitcnt vmcnt(0)" ::: "memory");
            const unsigned og = xb_add(&bar[XB_TOP], 1u);
            const unsigned tg = og / nx;
            if (og + 1u == (tg + 1u) * nx) xb_add(&bar[XB_TOPGEN], 1u);
            else XB_SPIN(xb_ld(&bar[XB_TOPGEN]) == tg, bar);
            __builtin_amdgcn_fence(__ATOMIC_ACQUIRE, "agent");
            xb_add(&bar[XB_XGEN(b.x)], 1u);
            asm volatile("s_waitcnt vmcnt(0)" ::: "memory");
        } else {
            XB_SPIN(xb_ld(&bar[XB_XGEN(b.x)]) == gen, bar);
            __builtin_amdgcn_fence(__ATOMIC_ACQUIRE, "agent");
            asm volatile("s_waitcnt vmcnt(0)" ::: "memory");
        }
    }
    __syncthreads();
}

namespace pg8 {
constexpr int BM = 256, BK = 64, HALF = 128, HTB = HALF * BK * 2, STAGE_BYTES = 8 * HTB, NXCD = 8, WGM = 8;
__device__ __forceinline__ int lds_byte(int r, int c) { const int st = (r >> 4) * 2 + (c >> 5), rr = r & 15, cc = c & 31, ob = rr * 64 + cc * 2; return st * 1024 + (ob ^ (((ob >> 9) & 1) << 5)); }
__device__ __forceinline__ void stage_rc(int b, int& R, int& C) { const int st = b / 1024, sb = b % 1024, swz = sb ^ (((sb >> 9) & 1) << 5); R = (st >> 1) * 16 + swz / 64; C = (st & 1) * 32 + (swz % 64) / 2; }
__device__ __forceinline__ int perm32(int rho) { const int n = rho >> 4, i = rho & 15; return 8 * (i >> 2) + 4 * n + (i & 3); }

struct Unit { const char* A; const char* B; const int* gat; int nvalid; int r0, c0, e; };

struct TileOrder {
    int nM, nN, nwg, G, c;
    __device__ void init(int nM_, int nN_, int G_, int c_) { nM = nM_; nN = nN_; nwg = nM * nN; G = G_; c = c_; }
    __device__ bool next(int i, int& pm, int& pn) const {
        const long L = (long)i * G + c; if (L >= nwg) return false;
        int wgid = (int)L; { const int q = nwg / NXCD, r = nwg % NXCD, xcd = wgid % NXCD, off = wgid / NXCD; wgid = (xcd < r ? xcd * (q + 1) : r * (q + 1) + (xcd - r) * q) + off; }
        const int nig = WGM * nN, gid = wgid / nig, fm = gid * WGM, gsz = (nM - fm) < WGM ? (nM - fm) : WGM;
        pm = fm + ((wgid % nig) % gsz); pn = (wgid % nig) / gsz; return true;
    }
};

typedef int v8i32 __attribute__((ext_vector_type(8)));
struct NoPre {};
template <class E, class = void> struct PreOf { typedef NoPre type; static constexpr bool has = false; };
template <class E> struct PreOf<E, decltype((void)sizeof(typename E::Pre))> { typedef typename E::Pre type; static constexpr bool has = true; };
template <class Epi, class Sched, bool GATHER, bool FP8 = false>
__device__ __forceinline__ void gemm_phase(LAS unsigned char* lds, const int K, const int lda, const int ldb, const Sched& S, const Epi& E, const int tid, const int kstepb = BK * 2) {
    constexpr int ES = FP8 ? 1 : 2;
    const int wid = __builtin_amdgcn_readfirstlane(tid >> 6), lane = tid & 63, wr = wid >> 2, wc = wid & 3, fr = lane & 15, fq = lane >> 4;
    const int nt = K / (FP8 ? 2 * BK : BK);
    unsigned cvA[2][2], nvA[2][2], voffB[2]; int stR[2], stC[2];
#pragma unroll
    for (int i = 0; i < 2; ++i) { int R, C; stage_rc(tid * 16 + i * 8192, R, C); stR[i] = R; stC[i] = C; const int Rb = Epi::PERM ? ((R & ~31) + perm32(R & 31)) : R;
        voffB[i] = (unsigned)(Rb * ldb * ES + C * 2);
#pragma unroll
        for (int h = 0; h < 2; ++h) { cvA[h][i] = (unsigned)((R + HALF * h) * lda * ES + C * 2); nvA[h][i] = cvA[h][i]; } }
    const size_t kstep = (size_t)kstepb;
    const size_t hstepB = (size_t)HALF * ldb * ES;
    const unsigned ldsw = (unsigned)wid * 1024u;
    const int aoff0 = lds_byte(wr * 64 + fr, fq * 8), aoff1 = aoff0 + 1024;
    const int boff0 = lds_byte(wc * 32 + fr, fq * 8), boff1 = boff0 + 1024;
    LAS unsigned char* pA = lds + aoff0; LAS unsigned char* pB = lds + 4 * HTB + boff0;
    asm volatile("" : "+v"(pA), "+v"(pB));
#define PG8_SA(b, h) (((b) * 2 + (h)) * HTB)
#define PG8_SB(b, h) ((4 + (b) * 2 + (h)) * HTB)
#define PG8_STAGE(bufoff, gbase, v0, v1) do { \
        __builtin_amdgcn_global_load_lds((const unsigned*)((const char*)(gbase) + (v0)), (LAS unsigned*)(lds + (bufoff) + ldsw), 16, 0, 0); \
        __builtin_amdgcn_global_load_lds((const unsigned*)((const char*)(gbase) + (v1)), (LAS unsigned*)(lds + (bufoff) + ldsw + 8192), 16, 0, 0); } while (0)
#define PG8_LD32(addr0, addr1) __builtin_bit_cast(v8i32, __builtin_shufflevector(*(const LAS u32x4*)(addr0), *(const LAS u32x4*)(addr1), 0, 1, 2, 3, 4, 5, 6, 7))
#define PG8_LDA(dst, b, h) do { _Pragma("unroll") for (int m = 0; m < 4; ++m) { if constexpr (FP8) dst##8[m] = PG8_LD32(pA + PG8_SA(b, h) + m * 2048, pA + PG8_SA(b, h) + (aoff1 - aoff0) + m * 2048); \
        else { _Pragma("unroll") for (int k = 0; k < 2; ++k) dst[m][k] = *(const LAS bf16x8*)(pA + PG8_SA(b, h) + (k ? aoff1 - aoff0 : 0) + m * 2048); } } } while (0)
#define PG8_LDB(dst, b, h) do { _Pragma("unroll") for (int n = 0; n < 2; ++n) { if constexpr (FP8) dst##8[n] = PG8_LD32(pB + (PG8_SB(b, h) - 4 * HTB) + n * 2048, pB + (PG8_SB(b, h) - 4 * HTB) + (boff1 - boff0) + n * 2048); \
        else { _Pragma("unroll") for (int k = 0; k < 2; ++k) dst[n][k] = *(const LAS bf16x8*)(pB + (PG8_SB(b, h) - 4 * HTB) + (k ? boff1 - boff0 : 0) + n * 2048); } } } while (0)
#define PG8_CAT(x0, x1) __builtin_shufflevector(__builtin_bit_cast(u32x4, x0), __builtin_bit_cast(u32x4, x1), 0, 1, 2, 3, 4, 5, 6, 7)
#define PG8_MMA(ai, bj, At, Bt) do { __builtin_amdgcn_s_setprio(1); _Pragma("unroll") for (int m = 0; m < 4; ++m) _Pragma("unroll") for (int n = 0; n < 2; ++n) { \
        if constexpr (FP8) asm volatile("v_mfma_f32_16x16x128_f8f6f4 %0, %1, %2, %0" : "+v"(acc[ai][bj][m][n]) : "v"(Bt##8[n]), "v"(At##8[m]));   \
        else { _Pragma("unroll") for (int k = 0; k < 2; ++k) acc[ai][bj][m][n] = __builtin_amdgcn_mfma_f32_16x16x32_bf16(Bt[n][k], At[m][k], acc[ai][bj][m][n], 0, 0, 0); } } __builtin_amdgcn_s_setprio(0); } while (0)
#define PG8_WAIT_V(n) asm volatile("s_waitcnt vmcnt(" #n ")" ::: "memory")
#define PG8_WAIT_L(n) asm volatile("s_waitcnt lgkmcnt(" #n ")" ::: "memory")
#define PG8_BAR __builtin_amdgcn_s_barrier()
#define PG8_SCHED __builtin_amdgcn_sched_barrier(0)
#define PG8_GATHER(u, dst) do { _Pragma("unroll") for (int h = 0; h < 2; ++h) _Pragma("unroll") for (int i = 0; i < 2; ++i) { const int rr = h * HALF + stR[i]; \
        const int tok = (rr < (u).nvalid) ? (u).gat[rr] : 0; dst[h][i] = kstepb == BK * 2 ? (unsigned)(tok * lda * ES + stC[i] * 2) : (unsigned)((tok >> 8) * (256 * 1024) + (tok & 255) * 128 + stC[i] * 2); } } while (0)
#define PG8_GATHER_RAW(u, dst) do { _Pragma("unroll") for (int h = 0; h < 2; ++h) _Pragma("unroll") for (int i = 0; i < 2; ++i) { const int rr = h * HALF + stR[i]; const int* gp_ = (u).gat + (rr < (u).nvalid ? rr : (u).nvalid - 1); \
        asm volatile("global_load_dword %0, %1, off" : "=v"(dst[h][i]) : "v"(gp_) : "memory"); } } while (0)
#define PG8_TOKOFF(tok_, i_) (kstepb == BK * 2 ? (unsigned)((int)(tok_) * lda * ES + stC[i_] * 2) : (unsigned)(((int)(tok_) >> 8) * (256 * 1024) + ((int)(tok_) & 255) * 128 + stC[i_] * 2))
    Unit cur, nxt; int ui = 0;
    if (!S.next(0, cur)) return;
    f32x4 acc[2][2][4][2];
#pragma unroll
    for (int a = 0; a < 2; ++a)
#pragma unroll
        for (int b = 0; b < 2; ++b)
#pragma unroll
            for (int m = 0; m < 4; ++m)
#pragma unroll
                for (int n = 0; n < 2; ++n) acc[a][b][m][n] = (f32x4){0.f, 0.f, 0.f, 0.f};
    bf16x8 At[4][2], B0[2][2], B1[2][2]; v8i32 At8[4], B08[2], B18[2];
    if constexpr (GATHER) { PG8_GATHER(cur, cvA); }
    const char* cA = cur.A; const char* cB = cur.B;
    PG8_STAGE(PG8_SB(0, 0), cB, voffB[0], voffB[1]); PG8_STAGE(PG8_SB(0, 1), cB + hstepB, voffB[0], voffB[1]); PG8_STAGE(PG8_SA(0, 0), cA, cvA[0][0], cvA[0][1]); PG8_STAGE(PG8_SA(0, 1), cA, cvA[1][0], cvA[1][1]);
    if (wr == 1) PG8_BAR;
    PG8_WAIT_V(2); PG8_BAR;
    PG8_STAGE(PG8_SB(1, 0), cB + kstep, voffB[0], voffB[1]); PG8_STAGE(PG8_SA(1, 0), cA + kstep, cvA[0][0], cvA[0][1]); PG8_STAGE(PG8_SB(1, 1), cB + hstepB + kstep, voffB[0], voffB[1]);
    PG8_WAIT_V(6); PG8_BAR;
    for (;;) {
        const bool has_next = S.next(ui + 1, nxt);
        if constexpr (GATHER) { if (has_next) { PG8_GATHER_RAW(nxt, nvA); } else {
#pragma unroll
            for (int h = 0; h < 2; ++h)
#pragma unroll
                for (int i = 0; i < 2; ++i) nvA[h][i] = 0u; } }
        const char* nA = has_next ? nxt.A : cA; const char* nB = has_next ? nxt.B : cB;
        typename PreOf<Epi>::type pre; if constexpr (PreOf<Epi>::has) E.prefetch(pre, cur, wr, wc, fr, fq);
#pragma unroll 1
        for (int t = 0; t < nt; t += 2) {
            const bool last = (t == nt - 2);
            const char* a1 = cA + (size_t)(t + 1) * kstep;
            const char* a2 = last ? nA : cA + (size_t)(t + 2) * kstep; const char* b2 = last ? nB : cB + (size_t)(t + 2) * kstep;
            asm volatile("" : "+s"(a1), "+s"(a2), "+s"(b2));
            asm volatile("" : "+v"(voffB[0]), "+v"(voffB[1]), "+v"(cvA[0][0]), "+v"(cvA[0][1]), "+v"(cvA[1][0]), "+v"(cvA[1][1]));
            const char* a3 = a2 + kstep; const char* b3 = b2 + kstep;
            unsigned x00 = cvA[0][0], x01 = cvA[0][1], x10 = cvA[1][0], x11 = cvA[1][1];
            if constexpr (GATHER) { if (last) { asm volatile("" : "+v"(nvA[0][0]), "+v"(nvA[0][1]), "+v"(nvA[1][0]), "+v"(nvA[1][1]));
                x00 = PG8_TOKOFF(nvA[0][0], 0); x01 = PG8_TOKOFF(nvA[0][1], 1); x10 = PG8_TOKOFF(nvA[1][0], 0); x11 = PG8_TOKOFF(nvA[1][1], 1); } }
            PG8_LDB(B0, 0, 0); PG8_LDB(B1, 0, 1); PG8_SCHED; PG8_LDA(At, 0, 0); PG8_STAGE(PG8_SA(1, 1), a1, cvA[1][0], cvA[1][1]);
            PG8_WAIT_V(8); PG8_WAIT_L(0); PG8_BAR; PG8_MMA(0, 0, At, B0); PG8_MMA(0, 1, At, B1); PG8_BAR; PG8_SCHED;
            PG8_LDA(At, 0, 1); PG8_STAGE(PG8_SB(0, 0), b2, voffB[0], voffB[1]); PG8_STAGE(PG8_SB(0, 1), b2 + hstepB, voffB[0], voffB[1]); PG8_STAGE(PG8_SA(0, 0), a2, x00, x01);
            PG8_WAIT_V(8); PG8_WAIT_L(0); PG8_BAR; PG8_MMA(1, 0, At, B0); PG8_MMA(1, 1, At, B1); PG8_BAR; PG8_SCHED;
            PG8_LDB(B0, 1, 0); PG8_LDB(B1, 1, 1); PG8_SCHED; PG8_LDA(At, 1, 0); PG8_STAGE(PG8_SA(0, 1), a2, x10, x11);
            PG8_WAIT_V(8); PG8_WAIT_L(0); PG8_BAR; PG8_MMA(0, 0, At, B0); PG8_MMA(0, 1, At, B1); PG8_BAR; PG8_SCHED;
            PG8_LDA(At, 1, 1); PG8_STAGE(PG8_SB(1, 0), b3, voffB[0], voffB[1]); PG8_STAGE(PG8_SB(1, 1), b3 + hstepB, voffB[0], voffB[1]); PG8_STAGE(PG8_SA(1, 0), a3, x00, x01);
            PG8_WAIT_V(8); PG8_WAIT_L(0); PG8_BAR; PG8_MMA(1, 0, At, B0); PG8_MMA(1, 1, At, B1); PG8_BAR; PG8_SCHED;
        }
        if constexpr (FP8) asm volatile("s_nop 15\n\ts_nop 15\n\ts_nop 7" ::: "memory");
        if (wr == 0) PG8_BAR;
        { Unit eu = cur; asm volatile("" : "+s"(eu.r0), "+s"(eu.c0), "+s"(eu.e));
          if constexpr (PreOf<Epi>::has) E(acc, eu, wr, wc, fr, fq, pre); else E(acc, eu, wr, wc, fr, fq); }
        if (!has_next) break;
#pragma unroll
        for (int a = 0; a < 2; ++a)
#pragma unroll
            for (int b = 0; b < 2; ++b)
#pragma unroll
                for (int m = 0; m < 4; ++m)
#pragma unroll
                    for (int n = 0; n < 2; ++n) acc[a][b][m][n] = (f32x4){0.f, 0.f, 0.f, 0.f};
        cur = nxt; cA = nA; cB = nB; ++ui;
        if constexpr (GATHER) {
#pragma unroll
            for (int h = 0; h < 2; ++h)
#pragma unroll
                for (int i = 0; i < 2; ++i) cvA[h][i] = PG8_TOKOFF(nvA[h][i], i); }
        if (wr == 1) PG8_BAR;
    }
    PG8_WAIT_V(0);
    PG8_BAR;
#undef PG8_SA
#undef PG8_SB
#undef PG8_STAGE
#undef PG8_LDA
#undef PG8_LD32
#undef PG8_LDB
#undef PG8_MMA
#undef PG8_CAT
#undef PG8_WAIT_V
#undef PG8_WAIT_L
#undef PG8_BAR
#undef PG8_SCHED
#undef PG8_GATHER
#undef PG8_GATHER_RAW
#undef PG8_TOKOFF
}
}
using pg8::Unit;

struct Params { const float* in[NIN]; float* out; unsigned char* ws; };
constexpr int LDS_PARAMS = LDS_BYTES - 1024 + 256;
__device__ __forceinline__ int opaque0() { int z; asm volatile("s_mov_b32 %0, 0" : "=s"(z)); return z; }
struct PL {
    LAS unsigned char* lds; int z; int w0;
    __device__ __forceinline__ unsigned long long word(int i) const { const LAS unsigned* w = (const LAS unsigned*)(lds + LDS_PARAMS) + 2 * i;
        const unsigned lo = __builtin_amdgcn_readfirstlane(w[0]), hi = __builtin_amdgcn_readfirstlane(w[1]); return ((unsigned long long)hi << 32) | lo; }
    __device__ __forceinline__ const float* in(int i) const { return (const float*)(__attribute__((address_space(1))) const float*)word(i); }
    __device__ __forceinline__ float* out() const { return (float*)(__attribute__((address_space(1))) float*)word(NIN); }
    __device__ __forceinline__ unsigned char* ws() const { return (unsigned char*)(__attribute__((address_space(1))) unsigned char*)word(NIN + 1); }
};

__device__ __forceinline__ u32x4 widen16(const u32x2 qa, const u32x2 qb) {
    const auto rx = __builtin_amdgcn_permlane16_swap(qa.x, qb.x, false, false); const unsigned ax = rx[0], bx = rx[1];
    const auto ry = __builtin_amdgcn_permlane16_swap(qa.y, qb.y, false, false); const unsigned ay = ry[0], by = ry[1];
    return (u32x4){ax, ay, bx, by};
}
struct EpiBf16 {
    static constexpr bool PERM = true;
    bf16_t* O; int ldc; const float* bias; int bias_estride; float ascale = 1.0f;
    __device__ __forceinline__ void operator()(const f32x4 (&acc)[2][2][4][2], const Unit& u, int wr, int wc, int fr, int fq) const {
        const int row0 = u.r0 + wr * 64 + fr, col0 = u.c0 * 256 + wc * 32 + 8 * fq;
        f32x4 bv[2][2];
#pragma unroll
        for (int bj = 0; bj < 2; ++bj)
#pragma unroll
            for (int n = 0; n < 2; ++n) bv[bj][n] = bias ? *(const f32x4*)(bias + (size_t)u.e * bias_estride + col0 + bj * 128 + 4 * n) : (f32x4){0.f, 0.f, 0.f, 0.f};
#pragma unroll
        for (int ai = 0; ai < 2; ++ai)
#pragma unroll
            for (int m = 0; m < 4; ++m) { bf16_t* rowp = O + (size_t)(row0 + ai * 128 + m * 16) * ldc + col0;
#pragma unroll
                for (int bj = 0; bj < 2; ++bj) { const f32x4 v0 = acc[ai][bj][m][0] * ascale + bv[bj][0], v1 = acc[ai][bj][m][1] * ascale + bv[bj][1];
                    u32x4 w; w.x = cvt_pk_bf16(v0[0], v0[1]); w.y = cvt_pk_bf16(v0[2], v0[3]); w.z = cvt_pk_bf16(v1[0], v1[1]); w.w = cvt_pk_bf16(v1[2], v1[3]);
                    *(u32x4*)(rowp + bj * 128) = w; } }
    }
};
struct EpiFp8 {
    static constexpr bool PERM = true;
    unsigned char* O; int ldc; const float* bias; int bias_estride; float ascale;
    struct Pre { f32x4 bv[2][2]; };
    __device__ __forceinline__ void prefetch(Pre& p, const Unit& u, int wr, int wc, int fr, int fq) const { const int col0 = u.c0 * 256 + wc * 32 + 8 * fq;
#pragma unroll
        for (int bj = 0; bj < 2; ++bj)
#pragma unroll
            for (int n = 0; n < 2; ++n) p.bv[bj][n] = *(const f32x4*)(bias + (size_t)u.e * bias_estride + col0 + bj * 128 + 4 * n); }
    __device__ __forceinline__ void operator()(const f32x4 (&acc)[2][2][4][2], const Unit& u, int wr, int wc, int fr, int fq, const Pre& p) const {
        const int row0 = u.r0 + wr * 64 + fr, col0 = u.c0 * 256 + wc * 32 + 8 * fq;
        const f32x4 (&bv)[2][2] = p.bv;
        const int odd = fq & 1;
#pragma unroll
        for (int ai = 0; ai < 2; ++ai)
#pragma unroll
            for (int mp = 0; mp < 4; mp += 2) { unsigned char* rowp = O + (size_t)(row0 + ai * 128 + (mp + odd) * 16) * ldc + col0 - 8 * odd;
#pragma unroll
                for (int bj = 0; bj < 2; ++bj) { u32x2 q[2];
#pragma unroll
                    for (int mm = 0; mm < 2; ++mm) { const f32x4 v0 = acc[ai][bj][mp + mm][0] * ascale + bv[bj][0], v1 = acc[ai][bj][mp + mm][1] * ascale + bv[bj][1];
                        q[mm].x = pack4_fp8(v0[0], v0[1], v0[2], v0[3]); q[mm].y = pack4_fp8(v1[0], v1[1], v1[2], v1[3]); }
                    *(u32x4*)(rowp + bj * 128) = widen16(q[0], q[1]); } }
    }
};
__device__ __forceinline__ void epi_cols32(const f32x4 (&acc)[2][2][4][2], float* dst, const float* bias, int r0, int wr, int wc, int fr, int fq, float ascale) {
    if (wc != 0) return;
    const int row0 = r0 + wr * 64 + fr, c = 8 * fq;
    f32x4 b0 = (f32x4){0.f, 0.f, 0.f, 0.f}, b1 = b0;
    if (bias) { b0 = *(const f32x4*)(bias + c); b1 = *(const f32x4*)(bias + c + 4); }
#pragma unroll
    for (int ai = 0; ai < 2; ++ai)
#pragma unroll
        for (int m = 0; m < 4; ++m) { float* p = dst + (size_t)(row0 + ai * 128 + m * 16) * 32 + c;
            *(f32x4*)p = acc[ai][0][m][0] * ascale + b0; *(f32x4*)(p + 4) = acc[ai][0][m][1] * ascale + b1; }
}
struct EpiInProj {
    static constexpr bool PERM = true;
    bf16_t *ca, *cb, *z; float* gate; int f8 = 0;
    __device__ __forceinline__ void operator()(const f32x4 (&acc)[2][2][4][2], const Unit& u, int wr, int wc, int fr, int fq) const {
        const int ct = f8 ? u.c0 : u.c0 + 10; const float ascale = f8 ? 1.0f / W8_SCALE : 1.0f;
        if (ct == 14) { epi_cols32(acc, gate, nullptr, u.r0, wr, wc, fr, fq, 1.0f); return; }
        bf16_t* O; int ldc, c0;
        if (ct < 6) { O = ca; ldc = 1536; c0 = ct; } else if (ct < 10) { O = cb; ldc = 1024; c0 = ct - 6; } else { O = z; ldc = 1024; c0 = ct - 10; }
        const bool odd = (fr & 1) != 0;
        const int col = c0 * 256 + wc * 64 + (odd ? 32 : 0) + 8 * fq, rowb = u.r0 + wr * 64 + (fr & ~1);
#pragma unroll
        for (int ai = 0; ai < 2; ++ai)
#pragma unroll
            for (int m = 0; m < 4; ++m) { unsigned p0[4], p1[4], s0[4], s1[4];
#pragma unroll
                for (int n = 0; n < 2; ++n) { const f32x4 v0 = acc[ai][0][m][n] * ascale, v1 = acc[ai][1][m][n] * ascale;
                    p0[2 * n] = cvt_pk_bf16(v0[0], v0[1]); p0[2 * n + 1] = cvt_pk_bf16(v0[2], v0[3]); p1[2 * n] = cvt_pk_bf16(v1[0], v1[1]); p1[2 * n + 1] = cvt_pk_bf16(v1[2], v1[3]); }
#pragma unroll
                for (int i = 0; i < 4; ++i) { const unsigned x = odd ? p0[i] : p1[i]; const unsigned rcv = (unsigned)__builtin_amdgcn_update_dpp(0, (int)x, 0xB1, 0xF, 0xF, false);
                    s0[i] = odd ? rcv : p0[i]; s1[i] = odd ? p1[i] : rcv; }
                bf16_t* rp = O + (size_t)(rowb + ai * 128 + m * 16) * ldc + col;
                *(u32x4*)rp = (u32x4){s0[0], s0[1], s0[2], s0[3]}; *(u32x4*)(rp + ldc) = (u32x4){s1[0], s1[1], s1[2], s1[3]}; }
    }
};
struct EpiSwiGLU {
    static constexpr bool PERM = true;
    unsigned char* H; const float* bg; const float* bu;
    struct Pre { f32x4 gv[2], uv[2]; };
    __device__ __forceinline__ void prefetch(Pre& p, const Unit& u, int wr, int wc, int fr, int fq) const { const int colf = u.c0 * 128 + wc * 32 + 8 * fq;
#pragma unroll
        for (int n = 0; n < 2; ++n) { p.gv[n] = *(const f32x4*)(bg + (size_t)u.e * 1024 + colf + 4 * n); p.uv[n] = *(const f32x4*)(bu + (size_t)u.e * 1024 + colf + 4 * n); } }
    __device__ __forceinline__ void operator()(const f32x4 (&acc)[2][2][4][2], const Unit& u, int wr, int wc, int fr, int fq, const Pre& p) const {
        const int row0 = u.r0 + wr * 64 + fr, colf = u.c0 * 128 + wc * 32 + 8 * fq;
        f32x4 gv[2], uv[2];
#pragma unroll
        for (int n = 0; n < 2; ++n) { gv[n] = p.gv[n]; uv[n] = (p.uv[n] + 1.0f) * H8_SCALE; }
        const int odd = fq & 1;
#pragma unroll
        for (int ai = 0; ai < 2; ++ai)
#pragma unroll
            for (int mp = 0; mp < 4; mp += 2) { u32x2 q[2];
#pragma unroll
                for (int mm = 0; mm < 2; ++mm) { const int m = mp + mm; float o[8];
#pragma unroll
                    for (int n = 0; n < 2; ++n) { const f32x4 g = acc[ai][0][m][n] * (1.0f / W8_SCALE) + gv[n], l = acc[ai][1][m][n] * (H8_SCALE / W8_SCALE) + uv[n];
#pragma unroll
                        for (int j = 0; j < 4; ++j) { const float gl = fminf(g[j], 7.0f), lp = fminf(fmaxf(l[j], -6.0f * H8_SCALE), 8.0f * H8_SCALE);
                            o[4 * n + j] = gl * __builtin_amdgcn_rcpf(1.0f + __builtin_amdgcn_exp2f(gl * (-1.702f * 1.4426950408889634f))) * lp; } }
                    q[mm].x = pack4_fp8(o[0], o[1], o[2], o[3]); q[mm].y = pack4_fp8(o[4], o[5], o[6], o[7]); }
                *(u32x4*)(H + blk_off8(row0 + ai * 128 + (mp + odd) * 16, colf - 8 * odd)) = widen16(q[0], q[1]); }
    }
};
struct EpiGLU {
    static constexpr bool PERM = true;
    bf16_t* O;
    __device__ __forceinline__ void operator()(const f32x4 (&acc)[2][2][4][2], const Unit& u, int wr, int wc, int fr, int fq) const {
        const int row0 = u.r0 + wr * 64 + fr, colf = u.c0 * 128 + wc * 32 + 8 * fq;
#pragma unroll
        for (int ai = 0; ai < 2; ++ai)
#pragma unroll
            for (int m = 0; m < 4; ++m) { float o[8];
#pragma unroll
                for (int n = 0; n < 2; ++n) { const f32x4 a = acc[ai][0][m][n], b = acc[ai][1][m][n];
#pragma unroll
                    for (int j = 0; j < 4; ++j) o[4 * n + j] = a[j] * (1.0f / W8_SCALE) * sigmoidf_(b[j] * (1.0f / W8_SCALE)); }
                *(u32x4*)(O + (size_t)(row0 + ai * 128 + m * 16) * 1024 + colf) = pack8(o); }
    }
};
__device__ __forceinline__ void s5_rowmap(int r, int& crow, int& t) {
    if (r < TL) { const int b = r >> 11, l = r & 2047; crow = b * 64 + (l >> 5); t = l & 31; }
    else { const int rc = r - TL, b = rc >> 8, l = rc & 255; crow = 2048 + b * 8 + (l >> 5); t = l & 31; }
}
struct EpiS5U {
    static constexpr bool PERM = true;
    bf16_t* UL;
    __device__ __forceinline__ void operator()(const f32x4 (&acc)[2][2][4][2], const Unit& u, int wr, int wc, int fr, int fq) const {
        const int row0 = u.r0 + wr * 64 + fr, col0 = u.c0 * 256 + wc * 32 + 8 * fq;
#pragma unroll
        for (int ai = 0; ai < 2; ++ai)
#pragma unroll
            for (int m = 0; m < 4; ++m) { int crow, t; s5_rowmap(row0 + ai * 128 + m * 16, crow, t);
#pragma unroll
                for (int bj = 0; bj < 2; ++bj) { const int c = col0 + bj * 128, g = c >> 4; const f32x4 v0 = acc[ai][bj][m][0] * (1.0f / W8_SCALE), v1 = acc[ai][bj][m][1] * (1.0f / W8_SCALE);
                    u32x4 w; w.x = cvt_pk_bf16(v0[0], v0[1]); w.y = cvt_pk_bf16(v0[2], v0[3]); w.z = cvt_pk_bf16(v1[0], v1[1]); w.w = cvt_pk_bf16(v1[2], v1[3]);
                    *(u32x4*)(UL + ((size_t)g * S5ROWS + crow) * S5K + t * 16 + (c & 15)) = w; } }
    }
};
struct EpiS5S {
    static constexpr bool PERM = false;
    float* S;
    __device__ __forceinline__ void operator()(const f32x4 (&acc)[2][2][4][2], const Unit& u, int wr, int wc, int fr, int fq) const {
        const int row0 = u.r0 + wr * 64 + fr, col0 = wc * 32 + 4 * fq;
#pragma unroll
        for (int ai = 0; ai < 2; ++ai)
#pragma unroll
            for (int m = 0; m < 4; ++m) { float* rowp = S + ((size_t)u.e * S5ROWS + row0 + ai * 128 + m * 16) * 256 + col0;
#pragma unroll
                for (int bj = 0; bj < 2; ++bj)
#pragma unroll
                    for (int n = 0; n < 2; ++n) *(f32x4*)(rowp + bj * 128 + n * 16) = acc[ai][bj][m][n]; }
    }
};
__device__ __forceinline__ float gelu_tanh(float x) { const float u = 0.7978845608f * (x + 0.044715f * x * x * x); return x * sigmoidf_(2.0f * u); }
struct EpiS5Y {
    static constexpr bool PERM = true;
    unsigned char* OG;
    __device__ __forceinline__ void operator()(const f32x4 (&acc)[2][2][4][2], const Unit& u, int wr, int wc, int fr, int fq) const {
        const int row0 = u.r0 + wr * 64 + fr, n0 = u.c0 * 256 + wc * 32 + 8 * fq;
        const int odd = fq & 1;
#pragma unroll
        for (int ai = 0; ai < 2; ++ai)
#pragma unroll
            for (int mp = 0; mp < 4; mp += 2) { const int crow = row0 + ai * 128 + (mp + odd) * 16;
#pragma unroll
                for (int bj = 0; bj < 2; ++bj) { const int n = n0 + bj * 128, t = n >> 4, h0 = n & 15; u32x2 q[2];
#pragma unroll
                    for (int mm = 0; mm < 2; ++mm) { float o[8];
#pragma unroll
                        for (int j = 0; j < 4; ++j) { o[j] = gelu_tanh(acc[ai][bj][mp + mm][0][j]); o[4 + j] = gelu_tanh(acc[ai][bj][mp + mm][1][j]); }
                        q[mm].x = pack4_fp8(o[0], o[1], o[2], o[3]); q[mm].y = pack4_fp8(o[4], o[5], o[6], o[7]); }
                    *(u32x4*)(OG + ((size_t)crow * 32 + t) * 1024 + u.e * 16 + h0 - 8 * odd) = widen16(q[0], q[1]); } }
    }
};

struct DenseSched {
    pg8::TileOrder T; const char* A; const char* B; size_t astep, bstep;
    __device__ void init(const void* A_, const void* B_, int nM, int nN, int lda, int ldb, int z, int es = 2) { T.init(nM, nN, (int)gridDim.x + z, (int)blockIdx.x + z); A = (const char*)A_; B = (const char*)B_; astep = (size_t)256 * lda * es; bstep = (size_t)256 * ldb * es; }
    __device__ __forceinline__ bool next(int i, Unit& u) const { int pm, pn; if (!T.next(i, pm, pn)) return false;
        u.A = A + pm * astep; u.B = B + pn * bstep; u.gat = nullptr; u.nvalid = 256; u.r0 = pm * 256; u.c0 = pn; u.e = 0; return true; }
};
struct GroupSched {
    const char* A; const char* B; size_t agstep, bgstep, astep, bstep; int nG, nM, nN, G, c;
    __device__ __forceinline__ bool next(int i, Unit& u) const { const long L = (long)i * G + c; if (L >= (long)nG * nM * nN) return false;
        const int per = nM * nN, g = (int)(L / per), rem = (int)(L % per), pm = rem / nN, pn = rem % nN;
        u.A = A + g * agstep + pm * astep; u.B = B + g * bgstep + pn * bstep; u.gat = nullptr; u.nvalid = 256; u.r0 = pm * 256; u.c0 = pn; u.e = g; return true; }
};
struct MoeSched {
    const LAS int* tp; const LAS int* cnt; const LAS int* te  ; int NC, ntiles; bool gather;
    const char* A; const char* B; size_t bestep  ; const int* tok; int CT, G, c; int rowbytes  ; int xrot  ;
    __device__ __forceinline__ bool next(int i, Unit& u) const {
        int rt, ct;
        if (G == 256) { const int xcd = ((c & 7) + 8 - xrot) & 7, j = c >> 3, RPS = 32 / NC; rt = (i * 8 + xcd) * RPS + j / NC; ct = j % NC; }
        else { const long L = (long)i * G + c; rt = (int)(L / NC); ct = (int)(L % NC); }
        if (rt >= ntiles) return false;
        const int e = __builtin_amdgcn_readfirstlane(te[rt]), lt = rt - __builtin_amdgcn_readfirstlane(tp[e]);
        u.e = e; u.r0 = rt * 256; u.c0 = ct; u.nvalid = cnt[e] - lt * 256; u.gat = tok + (size_t)e * CT + lt * 256;
        u.A = gather ? A : A + (size_t)rt * 256 * rowbytes; u.B = B + (size_t)e * bestep + (size_t)ct * 256 * rowbytes; return true;
    }
};

#define TID (P.w0 * 64 + lane_id(P.z))
#define BID ((int)blockIdx.x + P.z)
#define GDIM ((int)gridDim.x + P.z)
#define wave_id() __builtin_amdgcn_readfirstlane(TID >> 6)
__device__ __forceinline__ bf16_t* hbrow(unsigned char* ws, int r) { return r < TL ? (bf16_t*)(ws + WS_HBL) + (size_t)r * D : (bf16_t*)(ws + WS_HBC) + (size_t)(r - TL) * D; }
__device__ __forceinline__ const float* xrow(const float* x, const float* ctx, int r) { return r < TL ? x + (size_t)r * D : ctx + (size_t)(r - TL) * D; }
__device__ __forceinline__ const float* modp(const unsigned char* ws, int layer, int r, int which) { const int mb = r < TL ? (r >> 11) : 32; return (const float*)(ws + WS_MOD) + ((size_t)(layer * 33 + mb) * 6 + which) * D; }

__device__ __forceinline__ void phase_mod(const PL& P, LAS unsigned char* lds) {
    LAS float* sT = (LAS float*)lds;
    LAS float* red = (LAS float*)lds;
    const int tid = TID, lane = tid & 63, wave = wave_id();
    float* MOD = (float*)(P.ws() + WS_MOD); const float* cc = P.in(IC); const float* cctx = P.in(ICCTX); const float* adaw = P.in(IADAW); const float* adab = P.in(IADAB);
    for (int cb = BID; cb < 256; cb += GDIM) {
        __syncthreads();
        for (int i = tid; i < 33 * 1024; i += 512) { const int r = i >> 10, k = i & 1023; const float x = r < 32 ? cc[r * 1024 + k] : cctx[k]; sT[i] = x / (1.0f + expf(-x)); }
        __syncthreads();
        const int col0 = cb * 48, layer = col0 / 6144, cl0 = col0 % 6144;
        float acc[33];
#pragma unroll
        for (int r = 0; r < 33; ++r) acc[r] = 0.f;
        if (lane < 48) {
            const float* Wp = adaw + (size_t)layer * 1024 * 6144 + cl0 + (size_t)(wave * 128) * 6144 + lane;
            float wa[16], wb[16];
#define MOD_LD(dst, k0_) do { _Pragma("unroll") for (int q = 0; q < 16; ++q) dst[q] = Wp[(size_t)((k0_) + q) * 6144]; } while (0)
#define MOD_FMA(src, k0_) do { _Pragma("unroll") for (int q = 0; q < 16; q += 4) { _Pragma("unroll") for (int r = 0; r < 33; ++r) { \
                const f32x4 s4 = *(const LAS f32x4*)(sT + r * 1024 + wave * 128 + (k0_) + q); PFMA(acc[r], s4.x, src[q]); PFMA(acc[r], s4.y, src[q + 1]); PFMA(acc[r], s4.z, src[q + 2]); PFMA(acc[r], s4.w, src[q + 3]); } \
                asm volatile("" ::: "memory"); } } while (0)
            MOD_LD(wa, 0);
#pragma unroll 1
            for (int kb = 0; kb < 128; kb += 32) {
                MOD_LD(wb, kb + 16);
                MOD_FMA(wa, kb);
                if (kb + 32 < 128) MOD_LD(wa, kb + 32);
                MOD_FMA(wb, kb + 16);
            }
#undef MOD_LD
#undef MOD_FMA
        }
        __syncthreads();
        if (lane < 48) {
#pragma unroll
            for (int r = 0; r < 33; ++r) red[(wave * 33 + r) * 48 + lane] = acc[r]; }
        __syncthreads();
        for (int o = tid; o < 33 * 48; o += 512) { const int r = o / 48, c = o % 48; float sm = 0.f;
#pragma unroll
            for (int w = 0; w < 8; ++w) sm += red[(w * 33 + r) * 48 + c];
            MOD[(size_t)(layer * 33 + r) * 6144 + cl0 + c] = sm + adab[layer * 6144 + cl0 + c]; }
    }
}

__device__ __forceinline__ void cvt_item(const float* W, int K, int N, bf16_t* WT, int drow0, LAS float* scr, int kb, int nb, int lane, bool blk = false) {
    const int k0 = 64 * kb, n0 = 32 * nb;
#pragma unroll
    for (int i = 0; i < 32; ++i) { const int kk = 2 * i + (lane >> 5); scr[kk * 33 + (lane & 31)] = W[(size_t)(k0 + kk) * N + n0 + (lane & 31)]; }
    LDS_WAIT(); asm volatile("" ::: "memory");
    const int c = lane & 7;
#pragma unroll
    for (int j = 0; j < 4; ++j) { const int n = (lane >> 3) + 8 * j; const LAS float* s = scr + (8 * c) * 33 + n;
        u32x4 o; o.x = cvt_pk_bf16(s[0 * 33], s[1 * 33]); o.y = cvt_pk_bf16(s[2 * 33], s[3 * 33]); o.z = cvt_pk_bf16(s[4 * 33], s[5 * 33]); o.w = cvt_pk_bf16(s[6 * 33], s[7 * 33]);
        *(u32x4*)(WT + (blk ? blk_off(inproj_row(drow0 + n), k0 + 8 * c) : (size_t)(drow0 + n) * K + k0 + 8 * c)) = o; }
    LDS_WAIT(); asm volatile("" ::: "memory");
}
__device__ __forceinline__ void cvt_item8(const float* W, int K, int N, unsigned char* WT, int drow0, LAS float* scr, int kb, int nb, int lane, bool blkperm = false) {
    const int k0 = 64 * kb, n0 = 32 * nb;
#pragma unroll
    for (int i = 0; i < 32; ++i) { const int kk = 2 * i + (lane >> 5); scr[kk * 33 + (lane & 31)] = W[(size_t)(k0 + kk) * N + n0 + (lane & 31)]; }
    LDS_WAIT(); asm volatile("" ::: "memory");
    const int n = lane >> 1, kh = (lane & 1) * 32; const LAS float* sp = scr + kh * 33 + n; unsigned w[8];
#pragma unroll
    for (int q = 0; q < 8; ++q) w[q] = pack4_fp8(sp[(4 * q) * 33] * W8_SCALE, sp[(4 * q + 1) * 33] * W8_SCALE, sp[(4 * q + 2) * 33] * W8_SCALE, sp[(4 * q + 3) * 33] * W8_SCALE);
    unsigned char* dst = WT + (blkperm ? blk_off8(inproj_row(drow0 + n), k0 + kh) : (size_t)(drow0 + n) * K + k0 + kh);
    *(u32x4*)dst = (u32x4){w[0], w[1], w[2], w[3]}; *(u32x4*)(dst + 16) = (u32x4){w[4], w[5], w[6], w[7]};
    LDS_WAIT(); asm volatile("" ::: "memory");
}
__device__ __forceinline__ void cvt_matrix_item(const float* W, int N, bf16_t* WT, int mode, LAS float* scr, int item, int lane, bool f8 = false, bool blk = false) {
    const int nblk = N / 32, kb = item / nblk, nb = item % nblk, n0 = nb * 32;
    const int drow0 = mode == 0 ? n0 : ((n0 >> 7) * 256 + (n0 & 127) + (mode == 2 ? 128 : 0));
    if (f8) cvt_item8(W, 1024, N, (unsigned char*)WT, drow0, scr, kb, nb, lane); else cvt_item(W, 1024, N, WT, drow0, scr, kb, nb, lane, blk);
}
__device__ __forceinline__ void phase_cvt_dense(const PL& P, LAS unsigned char* lds) {
    const int lane = TID & 63, wave = wave_id(), gw = BID * 8 + wave, NGW = GDIM * 8;
    LAS float* scr = (LAS float*)(lds + wave * 16384);
    constexpr int I_IN = 16 * 113, I_SQ = 16 * 32, I_R = 16;
    constexpr int NIT = I_IN + 4 * I_SQ + 2 * I_R;
    unsigned char* ws = P.ws(); const float* w_in = P.in(IHYIN); const float* w_out = P.in(IHYOUT); const float* w_s5 = P.in(IS5IN); const float* w_ga = P.in(IGLUA); const float* w_gb = P.in(IGLUB); const float* w_r = P.in(IRW);
    for (int it = gw; it < NIT; it += NGW) { int r = it;
        if (r < I_IN) { const int kb = r / 113, nb = r % 113, ct = nb >> 3;
            if (ct < 10) cvt_item8(w_in, 1024, INW, ws + WS_WIN8, nb * 32, scr, kb, nb, lane, true);
            else cvt_item(w_in, 1024, INW, (bf16_t*)(ws + WS_WIN), nb * 32 - 2560, scr, kb, nb, lane, true);
            continue; } r -= I_IN;
        if (r < I_SQ) { cvt_matrix_item(w_out, 1024, (bf16_t*)(ws + WS_WOUT), 0, scr, r, lane, true); continue; } r -= I_SQ;
        if (r < I_SQ) { cvt_matrix_item(w_s5, 1024, (bf16_t*)(ws + WS_WS5IN), 0, scr, r, lane, true); continue; } r -= I_SQ;
        if (r < I_SQ) { cvt_matrix_item(w_ga, 1024, (bf16_t*)(ws + WS_WGLU), 1, scr, r, lane, true); continue; } r -= I_SQ;
        if (r < I_SQ) { cvt_matrix_item(w_gb, 1024, (bf16_t*)(ws + WS_WGLU), 2, scr, r, lane, true); continue; } r -= I_SQ;
        const int l = r / I_R; r -= l * I_R;
        cvt_matrix_item(w_r + (size_t)l * 1024 * 32, 32, (bf16_t*)(ws + WS_RB) + (size_t)l * 256 * 1024, 0, scr, r, lane);
    }
    const int gt = BID * 512 + TID, NT = GDIM * 512; const u32x4 z = (u32x4){0u, 0u, 0u, 0u};
    for (int i = gt; i < (INWP - INW) * 128; i += NT) *(u32x4*)((bf16_t*)(ws + WS_WIN) + blk_off(inproj_row(1024 + 32 + (i >> 7)), (i & 127) * 8)) = z;
    for (int i = gt; i < 2 * 224 * 128; i += NT) { const int l = i / (224 * 128), j = i % (224 * 128); *((u32x4*)((bf16_t*)(ws + WS_RB) + ((size_t)l * 256 + 32) * 1024) + j) = z; }
}
struct CvtJob { const float* W; unsigned char* WT; int drow0, k0, n0; };
__device__ __forceinline__ void cvt_load128(const CvtJob& j, float (&v)[32], int tid) {
#pragma unroll
    for (int u = 0; u < 8; ++u) { const int idx = tid + 512 * u, n = idx & 127, kq = idx >> 7; const float* src = j.W + (size_t)(j.k0 + 4 * kq) * 1024 + j.n0 + n;
#pragma unroll
        for (int r = 0; r < 4; ++r) v[4 * u + r] = src[(size_t)r * 1024]; }
}
__device__ __forceinline__ void cvt_store128(const CvtJob& j, const float (&v)[32], LAS unsigned* T32, int tid) {
#pragma unroll
    for (int u = 0; u < 8; ++u) { const int idx = tid + 512 * u, n = idx & 127, kq = idx >> 7;
        T32[n * 33 + kq] = pack4_fp8(v[4 * u] * W8_SCALE, v[4 * u + 1] * W8_SCALE, v[4 * u + 2] * W8_SCALE, v[4 * u + 3] * W8_SCALE); }
    LDS_BAR();
#pragma unroll
    for (int u = 0; u < 2; ++u) { const int idx = tid + 512 * u, n = idx >> 3, q = (idx & 7) * 4; const LAS unsigned* sp = T32 + n * 33 + q;
        u32x4 w; w.x = sp[0]; w.y = sp[1]; w.z = sp[2]; w.w = sp[3];
        *(u32x4*)(j.WT + blk_off8(j.drow0 + n, j.k0 + 4 * q)) = w; }
    LDS_BAR();
}
__device__ __forceinline__ CvtJob cvt_moe_job(int it, int layer, const float* wg, const float* wu, const float* wd, unsigned char* WGU, unsigned char* WDN) {
    const int mat = it >> 6, r = it & 63, e = mat / 3, w = mat % 3, kb = r >> 3, nb = r & 7; const size_t eo = ((size_t)layer * 32 + e) * 1024 * 1024; CvtJob j;
    j.W = (w == 0 ? wg : (w == 1 ? wu : wd)) + eo; j.WT = w == 2 ? WDN + (size_t)e * 1024 * 1024 : WGU + (size_t)e * 2048 * 1024; j.drow0 = w == 2 ? nb * 128 : nb * 256 + (w == 1 ? 128 : 0); j.k0 = kb * 128; j.n0 = nb * 128; return j;
}
__device__ __forceinline__ void phase_cvt_moe(const PL& P, LAS unsigned char* lds, int layer) {
    const int tid = TID;
    LAS unsigned* T = (LAS unsigned*)lds;
    unsigned char* WGU = P.ws() + WS_WMOE; unsigned char* WDN = WGU + (size_t)32 * 2048 * 1024; const float* wg = P.in(IWG); const float* wu = P.in(IWU); const float* wd = P.in(IWD);
    __syncthreads();
    int it = BID;
    if (it < 96 * 64) {
        float v[32], vn[32]; CvtJob cur = cvt_moe_job(it, layer, wg, wu, wd, WGU, WDN); cvt_load128(cur, v, tid);
        for (;;) { const int nx = it + GDIM; const bool has = nx < 96 * 64; CvtJob nj = cur; if (has) { nj = cvt_moe_job(nx, layer, wg, wu, wd, WGU, WDN); cvt_load128(nj, vn, tid); }
            cvt_store128(cur, v, T, tid);
            if (!has) break;
#pragma unroll
            for (int u = 0; u < 32; ++u) v[u] = vn[u];
            cur = nj; it = nx; }
    }
}

__device__ __forceinline__ void phase_s5_tables(const PL& P, LAS unsigned char* lds) {
    LAS float* ar = (LAS float*)lds; LAS float* ai = ar + 64; LAS float* fre = ai + 64; LAS float* fim = fre + 64;
    LAS float* Bb = fim + 64;
    LAS float* Cc = Bb + 2048;
    LAS float* lj = Cc + 2048;
    const int tid = TID;
    float* LP = (float*)(P.ws() + WS_LP); float* BB = (float*)(P.ws() + WS_BB); float* KT = (float*)(P.ws() + WS_KT);
    const float* i_ls = P.in(IS5LS); const float* i_are = P.in(IS5ARE); const float* i_aim = P.in(IS5AIM); const float* i_bre = P.in(IS5BRE); const float* i_bim = P.in(IS5BIM); const float* i_cre = P.in(IS5CRE); const float* i_cim = P.in(IS5CIM);
    for (int it = BID; it < 128; it += GDIM) { const int d = it >> 6, g = it & 63, dg = d * 64 + g;
        __syncthreads();
        if (tid < 64) { const float step = expf(i_ls[dg]), are = i_are[dg * 64 + tid], aim = i_aim[dg * 64 + tid];
            const float a_r = are * step, a_i = aim * step, mag = expf(a_r); float sn, cs; sincosf(a_i, &sn, &cs); const float lr = mag * cs, li = mag * sn, den = are * are + aim * aim;
            ar[tid] = a_r; ai[tid] = a_i; fre[tid] = ((lr - 1.0f) * are + li * aim) / den; fim[tid] = (li * are - (lr - 1.0f) * aim) / den; }
        __syncthreads();
        for (int i = tid; i < 1024; i += 512) { const int p = i >> 4; const float br = i_bre[(size_t)dg * 1024 + i], bi = i_bim[(size_t)dg * 1024 + i];
            const float re = fre[p] * br - fim[p] * bi, im = fre[p] * bi + fim[p] * br; Bb[2 * i] = re; Bb[2 * i + 1] = im; BB[((size_t)dg * 1024 + i) * 2] = re; BB[((size_t)dg * 1024 + i) * 2 + 1] = im;
            Cc[2 * i] = i_cre[(size_t)dg * 1024 + i]; Cc[2 * i + 1] = i_cim[(size_t)dg * 1024 + i]; }
        __syncthreads();
        if (tid < 64) {
            for (int j = 0; j <= 32; ++j) { const float m = expf(ar[tid] * (float)j); float sn, cs; sincosf(ai[tid] * (float)j, &sn, &cs);
                LP[(((size_t)dg * 33 + j) * 64 + tid) * 2] = m * cs; LP[(((size_t)dg * 33 + j) * 64 + tid) * 2 + 1] = m * sn; }
            { const float m = expf(ar[tid]); float sn, cs; sincosf(ai[tid], &sn, &cs); lj[2 * tid] = m * cs; lj[2 * tid + 1] = m * sn; }
        }
        __syncthreads();
        if (tid < 256) { const int h = tid >> 4, h2 = tid & 15; float acc[32];
#pragma unroll
            for (int j = 0; j < 32; ++j) acc[j] = 0.f;
            for (int p = 0; p < 64; ++p) { const float cr = Cc[2 * (h * 64 + p)], ci = Cc[2 * (h * 64 + p) + 1], br = Bb[2 * (p * 16 + h2)], bi = Bb[2 * (p * 16 + h2) + 1], lr = lj[2 * p], li = lj[2 * p + 1];
                float zr = cr * br - ci * bi, zi = cr * bi + ci * br;
#pragma unroll
                for (int j = 0; j < 32; ++j) { acc[j] += zr; const float nr = zr * lr - zi * li, ni = zr * li + zi * lr; zr = nr; zi = ni; } }
#pragma unroll
            for (int j = 0; j < 32; ++j) KT[(((size_t)g * 2 + d) * 32 + j) * 256 + tid] = acc[j]; }
    }
}
__device__ __forceinline__ void phase_s5_mats(const PL& P) {
    unsigned char* ws = P.ws(); const float* i_d = P.in(IS5D); const float* i_cre = P.in(IS5CRE); const float* i_cim = P.in(IS5CIM);
    const float* LP = (const float*)(ws + WS_LP); const float* BB = (const float*)(ws + WS_BB); const float* KT = (const float*)(ws + WS_KT);
    bf16_t* MPm = (bf16_t*)(ws + WS_MP); bf16_t* Em = (bf16_t*)(ws + WS_E);
    const int gt = BID * 512 + TID, NT = GDIM * 512;
    for (int idx = gt; idx < 64 * 512 * 96; idx += NT) { const int k8 = idx % 96, n = (idx / 96) & 511, g = idx / (96 * 512), t = n >> 4, h = n & 15; float v[8];
        if (k8 < 64) { const int s = k8 >> 1, h0 = (k8 & 1) * 8;
#pragma unroll
            for (int i = 0; i < 8; ++i) v[i] = 0.f;
            if (s <= t) { const float* kp = KT + (((size_t)g * 2 + 0) * 32 + (t - s)) * 256 + h * 16 + h0;
#pragma unroll
                for (int i = 0; i < 8; ++i) v[i] += kp[i]; }
            if (s >= t) { const float* kp = KT + (((size_t)g * 2 + 1) * 32 + (s - t)) * 256 + h * 16 + h0;
#pragma unroll
                for (int i = 0; i < 8; ++i) v[i] += kp[i]; }
            if (s == t && (h >> 3) == (k8 & 1)) v[h & 7] += i_d[g * 16 + h];
        } else { const int q = (k8 - 64) * 8, seg = q >> 6, p0 = q & 63, d = seg >> 1, im = seg & 1, e = d == 0 ? t + 1 : 32 - t, dg = d * 64 + g;
#pragma unroll
            for (int i = 0; i < 8; ++i) { const int p = p0 + i; const float cr = i_cre[(size_t)dg * 1024 + h * 64 + p], ci = i_cim[(size_t)dg * 1024 + h * 64 + p];
                const float lr = LP[(((size_t)dg * 33 + e) * 64 + p) * 2], li = LP[(((size_t)dg * 33 + e) * 64 + p) * 2 + 1];
                v[i] = im ? -(cr * li + ci * lr) : (cr * lr - ci * li); } }
        *(u32x4*)(MPm + ((size_t)g * 512 + n) * S5K + k8 * 8) = pack8(v); }
    for (int idx = gt; idx < 64 * 256 * 64; idx += NT) { const int k8 = idx & 63, n = (idx >> 6) & 255, g = idx >> 14, seg = n >> 6, p = n & 63, d = seg >> 1, im = seg & 1, s = k8 >> 1, h0 = (k8 & 1) * 8, e = d == 0 ? 31 - s : s, dg = d * 64 + g;
        const float lr = LP[(((size_t)dg * 33 + e) * 64 + p) * 2], li = LP[(((size_t)dg * 33 + e) * 64 + p) * 2 + 1]; float v[8];
#pragma unroll
        for (int i = 0; i < 8; ++i) { const float br = BB[((size_t)dg * 1024 + p * 16 + h0 + i) * 2], bi = BB[((size_t)dg * 1024 + p * 16 + h0 + i) * 2 + 1]; v[i] = im ? (lr * bi + li * br) : (lr * br - li * bi); }
        *(u32x4*)(Em + ((size_t)g * 256 + n) * 512 + k8 * 8) = pack8(v); }
}

__device__ __forceinline__ void norm_mod_row(const float (&x)[16], const float* w, const float* shift, const float* scale, bf16_t* dst, int lane, unsigned char* dst8 = nullptr) {
    float ss = 0.f;
#pragma unroll
    for (int i = 0; i < 16; ++i) ss += x[i] * x[i];
    const float rs = rsqrtf(wave_sum(ss) * (1.0f / 1024.0f) + RMS_EPS);
    float wv[16], sh[16], sc[16], o[16]; ld_row_f32(w, lane, wv); ld_row_f32(shift, lane, sh); ld_row_f32(scale, lane, sc);
#pragma unroll
    for (int i = 0; i < 16; ++i) o[i] = x[i] * rs * wv[i] * (1.0f + sc[i]) + sh[i];
    if (dst) st_row_bf16(dst, lane, o);
    if (dst8) {
#pragma unroll
        for (int j = 0; j < 2; ++j) { u32x2 q; q.x = pack4_fp8(o[8 * j], o[8 * j + 1], o[8 * j + 2], o[8 * j + 3]); q.y = pack4_fp8(o[8 * j + 4], o[8 * j + 5], o[8 * j + 6], o[8 * j + 7]); *(u32x2*)(dst8 + 8 * lane + 512 * j) = q; } }
}
__device__ __forceinline__ void norm_mod_pre(const float (&x)[16], const float (&wv)[16], const float (&sh)[16], const float (&sc)[16], bf16_t* dst, int lane, unsigned char* dst8) {
    float ss = 0.f;
#pragma unroll
    for (int i = 0; i < 16; ++i) ss += x[i] * x[i];
    const float rs = rsqrtf(wave_sum(ss) * (1.0f / 1024.0f) + RMS_EPS); float o[16];
#pragma unroll
    for (int i = 0; i < 16; ++i) o[i] = x[i] * rs * wv[i] * (1.0f + sc[i]) + sh[i];
    if (dst) st_row_bf16(dst, lane, o);
    if (dst8) { u32x2 q[2];
#pragma unroll
        for (int j = 0; j < 2; ++j) { q[j].x = pack4_fp8(o[8 * j], o[8 * j + 1], o[8 * j + 2], o[8 * j + 3]); q[j].y = pack4_fp8(o[8 * j + 4], o[8 * j + 5], o[8 * j + 6], o[8 * j + 7]); }
        *(u32x4*)(dst8 + pair16_col(lane)) = pair16(q[0], q[1], (lane & 1) != 0); }
}
__device__ __forceinline__ void norm_mod_blk(const float (&x)[16], const float (&wv)[16], const float (&sh)[16], const float (&sc)[16], bf16_t* base, unsigned char* base8, int r, int lane) {
    float ss = 0.f;
#pragma unroll
    for (int i = 0; i < 16; ++i) ss += x[i] * x[i];
    const float rs = rsqrtf(wave_sum(ss) * (1.0f / 1024.0f) + RMS_EPS); float o[16];
#pragma unroll
    for (int i = 0; i < 16; ++i) o[i] = x[i] * rs * wv[i] * (1.0f + sc[i]) + sh[i];
#pragma unroll
    for (int j = 0; j < 2; ++j) *(u32x4*)(base + blk_off(r, 8 * lane + 512 * j)) = pack8(&o[8 * j]);
    u32x2 q8[2];
#pragma unroll
    for (int j = 0; j < 2; ++j) { q8[j].x = pack4_fp8(o[8 * j], o[8 * j + 1], o[8 * j + 2], o[8 * j + 3]); q8[j].y = pack4_fp8(o[8 * j + 4], o[8 * j + 5], o[8 * j + 6], o[8 * j + 7]); }
    *(u32x4*)(base8 + blk_off8(r, pair16_col(lane))) = pair16(q8[0], q8[1], (lane & 1) != 0);
}
__device__ __forceinline__ void phase_pre0(const PL& P) {
    const int lane = TID & 63, gw = BID * 8 + wave_id(), NGW = GDIM * 8;
    unsigned char* ws = P.ws(); const float* xin = P.in(IX); const float* cin = P.in(ICTX); const float* nw = P.in(IMNPRE);
    bf16_t* A0 = (bf16_t*)(ws + WS_R2); unsigned char* A08 = ws + WS_A2Q;
    float wv[16]; ld_row_f32(nw, lane, wv);
    for (int r = gw; r < TT; r += 2 * NGW) { const int r2 = r + NGW; const bool has2 = r2 < TT;
        float xa[16], sha[16], sca[16], xb[16], shb[16], scb[16];
        ld_row_f32(xrow(xin, cin, r), lane, xa); ld_row_f32(modp(ws, 0, r, 0), lane, sha); ld_row_f32(modp(ws, 0, r, 1), lane, sca);
        if (has2) { ld_row_f32(xrow(xin, cin, r2), lane, xb); ld_row_f32(modp(ws, 0, r2, 0), lane, shb); ld_row_f32(modp(ws, 0, r2, 1), lane, scb); }
        norm_mod_blk(xa, wv, sha, sca, A0, A08, r, lane);
        if (has2) norm_mod_blk(xb, wv, shb, scb, A0, A08, r2, lane); }
}

template <int I0, int NI>
__device__ __forceinline__ void conv_finish(float (&acc)[NI][8], int r, int lane, const LAS float* cbias, float gc0, float gc1, unsigned char* ws, float graw) {
    static_assert(NI == 1, "one chunk per pass");
#pragma unroll
    for (int j = 0; j < 8; ++j) { float a = acc[0][j]; if (I0 >= 3) a += cbias[8 * (lane + 64 * (I0 - 3)) + j]; acc[0][j] = siluf(a); }
    if (I0 < 2) { float ss = 0.f;
#pragma unroll
        for (int j = 0; j < 8; ++j) ss += acc[0][j] * acc[0][j];
        ss = row16_sum(ss);
        const float sc = rsqrtf(ss + RMS_EPS);
#pragma unroll
        for (int j = 0; j < 8; ++j) acc[0][j] *= sc; }
    if (I0 < 4) { bf16_t* dst = (bf16_t*)(ws + (I0 == 0 ? WS_Q : (I0 == 1 ? WS_K : (I0 == 2 ? WS_V : WS_XS)))); *(u32x4*)(dst + (size_t)r * 512 + 8 * lane) = pack8(acc[0]); }
    else {
        bf16_t* BMm = (bf16_t*)(ws + WS_BM); bf16_t* CMm = (bf16_t*)(ws + WS_CM);
        const float* GATE = (const float*)(ws + WS_GATE); float* G = (float*)(ws + WS_GPOST); float* BETA = G + (size_t)TT * 8; float* DT = BETA + (size_t)TT * 8; float* DA = DT + (size_t)TT * 16;
        if (lane < 32) *(u32x4*)(BMm + (size_t)r * 256 + 8 * lane) = pack8(acc[0]); else *(u32x4*)(CMm + (size_t)r * 256 + 8 * (lane - 32)) = pack8(acc[0]);
        if (lane < 32) { const float raw = graw;
            if (lane < 8) { G[(size_t)r * 8 + lane] = gc0 * softplusf_(raw + gc1); }
            else if (lane < 16) { BETA[(size_t)r * 8 + lane - 8] = 1.0f / (1.0f + expf(-raw)); }
            else { const int j = lane - 16; const float dt = softplusf_(raw + gc1); DT[(size_t)r * 16 + j] = dt; DA[(size_t)r * 16 + j] = gc0 * dt; } }
    }
}
template <int I>
__device__ __forceinline__ void conv_step1(float (&Am)[1][8], float (&Az)[1][8], float (&Ap)[1][8], const u32x4 (&x)[3], const float (&wr)[9][8], int cn, int c0, int rowbase, int lane,
                                           const LAS float* cbias, float gc0, float gc1, unsigned char* ws, float graw) {
#pragma unroll
    for (int d = 0; d < 3; ++d) { float xv[8]; unpack8(x[d], xv);
#pragma unroll
        for (int j = 0; j < 8; ++j) { Am[0][j] += xv[j] * wr[d * 3 + 2][j]; Az[0][j] += xv[j] * wr[d * 3 + 1][j]; Ap[0][j] += xv[j] * wr[d * 3 + 0][j]; } }
    const int co = cn - 1;
    if (co >= c0 && co < c0 + 32) conv_finish<I, 1>(Am, rowbase + co, lane, cbias, gc0, gc1, ws, graw);
#pragma unroll
    for (int j = 0; j < 8; ++j) Am[0][j] = 0.f;
}
template <int I>
__device__ __forceinline__ void conv_walk1(int c0, int rr, int nrows, int ncols, int rowbase, int lane, const bf16_t* CA, const bf16_t* CB, const LAS float* cw, const LAS float* cbias, float gc0, float gc1, unsigned char* ws) {
    const int ch = 8 * (lane + 64 * I), pitch = I < 3 ? 1536 : 1024; const bf16_t* src = I < 3 ? CA + ch : CB + ch - 1536;
    float wr[9][8];
#pragma unroll
    for (int tap = 0; tap < 9; ++tap) { const f32x4 w0 = *(const LAS f32x4*)(cw + tap * 2560 + ch), w1 = *(const LAS f32x4*)(cw + tap * 2560 + ch + 4); wr[tap][0] = w0.x; wr[tap][1] = w0.y; wr[tap][2] = w0.z; wr[tap][3] = w0.w; wr[tap][4] = w1.x; wr[tap][5] = w1.y; wr[tap][6] = w1.z; wr[tap][7] = w1.w; }
    const bool rup = rr - 1 >= 0, rdn = rr + 1 < nrows;
    const float* GATEp = (const float*)(ws + WS_GATE);
#define CONV_LDCOL(cn_, x_, g_) do { if (I == 4) { const int co_ = (cn_) - 1, cg_ = co_ < c0 ? c0 : (co_ > c0 + 31 ? c0 + 31 : co_); g_ = GATEp[(size_t)(rowbase + cg_) * 32 + (lane & 31)]; } \
        const int cq_ = (cn_) < 0 ? 0 : ((cn_) >= ncols ? ncols - 1 : (cn_)); const bool cok_ = (cn_) >= 0 && (cn_) < ncols; \
        const u32x4 z_ = (u32x4){0u, 0u, 0u, 0u}; \
        const u32x4 a_ = *(const u32x4*)(src + (size_t)(rowbase + (rup ? -ncols : 0) + cq_) * pitch), b_ = *(const u32x4*)(src + (size_t)(rowbase + cq_) * pitch), c_ = *(const u32x4*)(src + (size_t)(rowbase + (rdn ? ncols : 0) + cq_) * pitch); \
        x_[0] = (cok_ && rup) ? a_ : z_; x_[1] = cok_ ? b_ : z_; x_[2] = (cok_ && rdn) ? c_ : z_; } while (0)
    float A0[1][8], A1[1][8], A2[1][8];
#pragma unroll
    for (int j = 0; j < 8; ++j) { A0[0][j] = 0.f; A1[0][j] = 0.f; A2[0][j] = 0.f; }
    u32x4 X0[3], X1[3], X2[3], X3[3]; float G0 = 0.f, G1 = 0.f, G2 = 0.f, G3 = 0.f;
    CONV_LDCOL(c0 - 1, X0, G0); CONV_LDCOL(c0, X1, G1); CONV_LDCOL(c0 + 1, X2, G2); CONV_LDCOL(c0 + 2, X3, G3);
#define CONV_ST(k_, Am_, Az_, Ap_, X_, G_) do { conv_step1<I>(Am_, Az_, Ap_, X_, wr, cn + (k_), c0, rowbase, lane, cbias, gc0, gc1, ws, G_); CONV_LDCOL(cn + (k_) + 4, X_, G_); } while (0)
#pragma unroll 1
    for (int st = 0; st < 36; st += 12) { const int cn = c0 - 1 + st;
        CONV_ST(0, A0, A1, A2, X0, G0); CONV_ST(1, A1, A2, A0, X1, G1); CONV_ST(2, A2, A0, A1, X2, G2); CONV_ST(3, A0, A1, A2, X3, G3);
        CONV_ST(4, A1, A2, A0, X0, G0); CONV_ST(5, A2, A0, A1, X1, G1); CONV_ST(6, A0, A1, A2, X2, G2); CONV_ST(7, A1, A2, A0, X3, G3);
        CONV_ST(8, A2, A0, A1, X0, G0); CONV_ST(9, A0, A1, A2, X1, G1); CONV_ST(10, A1, A2, A0, X2, G2); CONV_ST(11, A2, A0, A1, X3, G3); }
#undef CONV_ST
#undef CONV_LDCOL
}
__device__ __forceinline__ void phase_conv2(const PL& P, LAS unsigned char* lds) {
    LAS float* cw = (LAS float*)lds;
    LAS float* cbias = cw + 9 * 2560;
    const int tid = TID, lane = tid & 63, gw = BID * 8 + wave_id(), NGW = GDIM * 8;
    unsigned char* ws = P.ws();
    { const float* gcw = P.in(IGCW); const float* scw = P.in(ISCW); const float* scb = P.in(ISCB);
    for (int i = tid; i < 9 * 2560; i += 512) { const int tap = i / 2560, c = i % 2560; cw[i] = c < 1536 ? gcw[tap * 1536 + c] : scw[tap * 1024 + c - 1536]; }
    for (int i = tid; i < 1024; i += 512) cbias[i] = scb[i]; }
    float gc0 = 0.f, gc1 = 0.f;
    if (lane < 8) { gc0 = -expf(P.in(IGALOG)[lane]); gc1 = P.in(IGDTB)[lane]; } else if (lane >= 16 && lane < 32) { gc0 = -expf(P.in(ISALOG)[lane - 16]); gc1 = P.in(ISDTB)[lane - 16]; }
    __syncthreads();
    const bf16_t* CA = (const bf16_t*)(ws + WS_CONVA); const bf16_t* CB = (const bf16_t*)(ws + WS_CONVB);
    for (int it2 = gw; it2 < 5 * 2304; it2 += NGW) { const int pass = it2 / 2304, item = it2 - pass * 2304;
        int rr, nrows, ncols, rowbase, c0;
        if (item < 2048) { const int b = item >> 6; rr = (item >> 1) & 31; c0 = (item & 1) * 32; nrows = 32; ncols = 64; rowbase = b * 2048 + rr * 64; }
        else { const int j = item - 2048, b = j >> 3; rr = 0; c0 = (j & 7) * 32; nrows = 1; ncols = 256; rowbase = TL + b * 256; }
        if (pass == 0) conv_walk1<0>(c0, rr, nrows, ncols, rowbase, lane, CA, CB, cw, cbias, gc0, gc1, ws);
        else if (pass == 1) conv_walk1<1>(c0, rr, nrows, ncols, rowbase, lane, CA, CB, cw, cbias, gc0, gc1, ws);
        else if (pass == 2) conv_walk1<2>(c0, rr, nrows, ncols, rowbase, lane, CA, CB, cw, cbias, gc0, gc1, ws);
        else if (pass == 3) conv_walk1<3>(c0, rr, nrows, ncols, rowbase, lane, CA, CB, cw, cbias, gc0, gc1, ws);
        else conv_walk1<4>(c0, rr, nrows, ncols, rowbase, lane, CA, CB, cw, cbias, gc0, gc1, ws);
    }
}

__device__ __forceinline__ int seq_row(int b, int d, int s) { if (s < 256) { const int l = d ? 255 - s : s; return TL + b * 256 + l; } const int l0 = s - 256, l = d ? 2047 - l0 : l0; return b * 2048 + l; }

#define NFMA(r, a, b) asm("v_fma_f32 %0, -%1, %2, %0" : "+v"(r) : "v"(a), "v"(b))
#define MFMA16(a, b, c) __builtin_amdgcn_mfma_f32_16x16x32_bf16((a), (b), (c), 0, 0, 0)
__device__ __forceinline__ bf16x8 fragl(const LAS bf16_t* M, int pitch, int row0, int k0, int lane) { return *(const LAS bf16x8*)(M + (row0 + (lane & 15)) * pitch + k0 + 8 * (lane >> 4)); }
typedef short s16x4 __attribute__((ext_vector_type(4)));
__device__ __forceinline__ bf16x8 fragt(const LAS bf16_t* M, int pitch, int r0, int c0, int lane) {
    const LAS bf16_t* p = M + (r0 + 8 * (lane >> 4) + ((lane & 15) >> 2)) * pitch + c0 + 4 * (lane & 3);
    const s16x4 lo = __builtin_amdgcn_ds_read_tr16_b64_v4i16((LAS s16x4*)p), hi = __builtin_amdgcn_ds_read_tr16_b64_v4i16((LAS s16x4*)(p + 4 * pitch));
    return (bf16x8){lo[0], lo[1], lo[2], lo[3], hi[0], hi[1], hi[2], hi[3]};
}
constexpr int GDN_NCHUNK = 36, GDN_NINST = 256 * GDN_NCHUNK;
constexpr size_t WS_GUT = WS_OGDN, WS_GWT = WS_R2, WS_GQK = 672 * MiB, WS_GEG = WS_GATE;

__device__ __forceinline__ void phase_gdn1m(const PL& P, LAS unsigned char* lds, size_t ut_off) {
    unsigned char* ws = P.ws();
    const bf16_t* Q = (const bf16_t*)(ws + WS_Q); const bf16_t* Kk = (const bf16_t*)(ws + WS_K); const bf16_t* V = (const bf16_t*)(ws + WS_V);
    const float* G = (const float*)(ws + WS_GPOST); const float* BETA = G + (size_t)TT * 8;
    bf16_t* UT = (bf16_t*)(ws + ut_off); bf16_t* WT = (bf16_t*)(ws + WS_GWT); bf16_t* QKo = (bf16_t*)(ws + WS_GQK);
    float* EG = (float*)(ws + WS_GEG); float* EGL = EG + (size_t)GDN_NINST * 64; float* GL = EGL + (size_t)GDN_NINST * 64;
    LAS bf16_t* Kl = (LAS bf16_t*)lds; LAS bf16_t* Ql = Kl + 64 * 136; LAS bf16_t* Vl = Ql + 64 * 136;
    LAS bf16_t* Mb = Vl + 64 * 136;
    LAS float* Md = (LAS float*)(Mb + 64 * 72);
    LAS bf16_t* Tb = (LAS bf16_t*)(Md + 4 * 16 * 20);
    LAS bf16_t* XT = Tb + 4 * 16 * 40;
    LAS bf16_t* YT = XT + 256 * 72;
    LAS float* gcs = (LAS float*)(YT + 256 * 40); LAS float* bet = gcs + 64; LAS float* betw = bet + 64;
    { const int t0 = TID; __syncthreads();
      for (int i = t0; i < (64 * 72 + 4 * 16 * 20 * 2 + 4 * 16 * 40 + 256 * 72 + 256 * 40) / 8; i += 512) *(LAS u32x4*)((LAS unsigned char*)Mb + i * 16) = (u32x4){0u, 0u, 0u, 0u};
      __syncthreads(); }
    u32x4 pf[6]; float pg = 0.f, pbeta = 0.f;
#define GDN1M_PREFETCH(id_) do { const int tid_ = TID + opaque0(), chain_ = (id_) / GDN_NCHUNK, c_ = (id_) % GDN_NCHUNK, d_ = chain_ & 1, h_ = (chain_ >> 1) & 3, b_ = chain_ >> 3; \
        _Pragma("unroll") for (int u_ = 0; u_ < 6; ++u_) { const int idx = tid_ + 512 * u_, wh = idx >> 10, rem = idx & 1023, i = rem >> 4, off = (rem & 15) * 8; const int row = seq_row(b_, d_, c_ * 64 + i); \
            const bf16_t* src = wh == 0 ? Kk : (wh == 1 ? Q : V); pf[u_] = *(const u32x4*)(src + (size_t)row * 512 + h_ * 128 + off); } \
        if (tid_ < 64) { const int row = seq_row(b_, d_, c_ * 64 + tid_); pg = G[(size_t)row * 8 + d_ * 4 + h_]; pbeta = BETA[(size_t)row * 8 + d_ * 4 + h_]; } } while (0)
    if (BID < GDN_NINST) GDN1M_PREFETCH(BID);
    for (int id = BID; id < GDN_NINST; id += GDIM) {
        const int tid = TID + opaque0(), lane = tid & 63, wave = __builtin_amdgcn_readfirstlane(tid >> 6), q4 = lane >> 4, l15 = lane & 15;
        LDS_BAR();
#pragma unroll
        for (int u_ = 0; u_ < 6; ++u_) { const int idx = tid + 512 * u_, wh = idx >> 10, rem = idx & 1023, i = rem >> 4, off = (rem & 15) * 8;
            LAS bf16_t* dst = wh == 0 ? Kl : (wh == 1 ? Ql : Vl); *(LAS u32x4*)(dst + i * 136 + off) = pf[u_]; }
        if (wave == 0) { const float gc = wave_scan(pg); const float be = pbeta;
            const float gl = __builtin_bit_cast(float, __builtin_amdgcn_readlane(__builtin_bit_cast(int, gc), 63));
            gcs[lane] = gc; bet[lane] = be; betw[lane] = be * expf(gc); EG[(size_t)id * 64 + lane] = expf(gc); EGL[(size_t)id * 64 + lane] = expf(gl - gc); if (lane == 0) GL[id] = expf(gl); }
        LDS_BAR();
        if (id + GDIM < GDN_NINST) GDN1M_PREFETCH(id + GDIM);
#pragma unroll 1
        for (int tl = wave; tl < 10; tl += 8) { const int it = tl < 1 ? 0 : (tl < 3 ? 1 : (tl < 6 ? 2 : 3)), jt = tl - (it * (it + 1)) / 2;
            const int i0 = it * 16, i = i0 + l15, j0 = jt * 16 + 4 * q4; const float gci = gcs[i], bi = bet[i]; f32x4 a = (f32x4){0.f, 0.f, 0.f, 0.f}, a2 = a;
#pragma unroll
            for (int k0 = 0; k0 < 128; k0 += 32) { const bf16x8 fj = fragl(Kl, 136, jt * 16, k0, lane); a = MFMA16(fj, fragl(Kl, 136, i0, k0, lane), a); a2 = MFMA16(fj, fragl(Ql, 136, i0, k0, lane), a2); }
            float mv[4], qv[4];
#pragma unroll
            for (int jj = 0; jj < 4; ++jj) { const int j = j0 + jj; const float ex = __expf(fminf(gci - gcs[j], 0.f)); const float dec = (j <= i) ? ex : 0.f; mv[jj] = (j < i) ? bi * a[jj] * dec : 0.f; qv[jj] = a2[jj] * 0.08838834764831845f * dec; }
            if (it == jt) *(LAS f32x4*)(Md + (it * 16 + l15) * 20 + 4 * q4) = (f32x4){mv[0], mv[1], mv[2], mv[3]};
            else { u32x2 w; w.x = cvt_pk_bf16(-mv[0], -mv[1]); w.y = cvt_pk_bf16(-mv[2], -mv[3]); *(LAS u32x2*)(Mb + i * 72 + j0) = w; }
            u32x2 w; w.x = cvt_pk_bf16(qv[0], qv[1]); w.y = cvt_pk_bf16(qv[2], qv[3]); *(u32x2*)(QKo + ((size_t)id * 64 + i) * 64 + j0) = w; }
        if (wave >= 2) { const int tz = wave - 2;
            const int it = tz < 3 ? 0 : (tz < 5 ? 1 : 2), jt = tz < 3 ? tz + 1 : (tz < 5 ? tz - 1 : 3);
            *(u32x2*)(QKo + ((size_t)id * 64 + it * 16 + l15) * 64 + jt * 16 + 4 * q4) = (u32x2){0u, 0u}; }
        LDS_BAR();
        if (tid < 64) { const int I = tid >> 4, c = tid & 15; const LAS float* md = Md + I * 16 * 20; float t[16];
#pragma unroll
            for (int i = 0; i < 16; ++i) { float r = (i == c) ? 1.0f : 0.0f;
#pragma unroll
                for (int j4 = 0; j4 < (i + 3) / 4; ++j4) { const f32x4 m = *(const LAS f32x4*)(md + i * 20 + 4 * j4);
                    NFMA(r, m.x, t[4 * j4]); if (4 * j4 + 1 < i) NFMA(r, m.y, t[4 * j4 + 1]); if (4 * j4 + 2 < i) NFMA(r, m.z, t[4 * j4 + 2]); if (4 * j4 + 3 < i) NFMA(r, m.w, t[4 * j4 + 3]); }
                t[i] = r; Tb[(I * 16 + i) * 40 + c] = f2bf(r); } }
        LDS_BAR();
#pragma unroll
        for (int I = 0; I < 4; ++I) {
            f32x4 acc[2];
#pragma unroll
            for (int tt = 0; tt < 2; ++tt) { const int ct = 2 * wave + tt, c0 = ct * 16, col = (c0 & 127) + l15; const LAS bf16_t* src = ct < 8 ? Vl : Kl; const LAS float* rsc = ct < 8 ? bet : betw;
#pragma unroll
                for (int jj = 0; jj < 4; ++jj) { const int i = 16 * I + 4 * q4 + jj; acc[tt][jj] = rsc[i] * bf1(src[i * 136 + col]); }
                if (I >= 1) { acc[tt] = MFMA16(fragl(Mb, 72, 16 * I, 0, lane), fragl(XT, 72, c0, 0, lane), acc[tt]); if (I == 3) acc[tt] = MFMA16(fragl(Mb, 72, 48, 32, lane), fragl(XT, 72, c0, 32, lane), acc[tt]); }
                u32x2 w; w.x = cvt_pk_bf16(acc[tt][0], acc[tt][1]); w.y = cvt_pk_bf16(acc[tt][2], acc[tt][3]); *(LAS u32x2*)(YT + (c0 + l15) * 40 + 4 * q4) = w; }
#pragma unroll
            for (int tt = 0; tt < 2; ++tt) { const int ct = 2 * wave + tt, c0 = ct * 16, col = (c0 & 127) + l15;
                const f32x4 zero4 = {0.f, 0.f, 0.f, 0.f}; const f32x4 x = MFMA16(fragl(Tb + I * 16 * 40, 40, 0, 0, lane), fragl(YT, 40, c0, 0, lane), zero4);
                u32x2 w; w.x = cvt_pk_bf16(x[0], x[1]); w.y = cvt_pk_bf16(x[2], x[3]);
                *(LAS u32x2*)(XT + (c0 + l15) * 72 + 16 * I + 4 * q4) = w;
                *(u32x2*)((ct < 8 ? UT : WT) + ((size_t)id * 128 + col) * 64 + 16 * I + 4 * q4) = w; }
        }
    }
#undef GDN1M_PREFETCH
}

__device__ __forceinline__ void phase_gdn2(const PL& P, LAS unsigned char* lds, size_t ut_off) {
    const int tid = TID + opaque0(), lane = tid & 63, wave = __builtin_amdgcn_readfirstlane(tid >> 6), q4 = lane >> 4, l15 = lane & 15;
    LAS bf16_t* WTl = (LAS bf16_t*)lds;
    LAS bf16_t* Ql = WTl + 128 * 72;
    LAS bf16_t* Kdl = Ql + 64 * 136;
    LAS bf16_t* QKl = Kdl + 64 * 136;
    LAS bf16_t* VnT = QKl + 64 * 72;
    LAS bf16_t* St = VnT + 128 * 72;
    unsigned char* ws = P.ws();
    const bf16_t* Q = (const bf16_t*)(ws + WS_Q); const bf16_t* Kk = (const bf16_t*)(ws + WS_K);
    bf16_t* UT = (bf16_t*)(ws + ut_off); const bf16_t* WT = (const bf16_t*)(ws + WS_GWT); const bf16_t* QKo = (const bf16_t*)(ws + WS_GQK);
    const float* EG = (const float*)(ws + WS_GEG); const float* EGL = EG + (size_t)GDN_NINST * 64; const float* GL = EGL + (size_t)GDN_NINST * 64;
    const int dv0 = wave * 16;
    for (int chain = BID; chain < 256; chain += GDIM) { const int d = chain & 1, h = (chain >> 1) & 3, b = chain >> 3;
        f32x4 S[8];
#pragma unroll
        for (int t = 0; t < 8; ++t) S[t] = (f32x4){0.f, 0.f, 0.f, 0.f};
        for (int i = lane; i < 16 * 136 / 8; i += 64) *(LAS u32x4*)(St + dv0 * 136 + i * 8) = (u32x4){0u, 0u, 0u, 0u};
        u32x4 pw[2], pq[2], pk[2], pqk; float peg[2], pegl[2]; u32x2 uu[4]; float pgl;
#define GDN2_PREFETCH(c_) do { const size_t id_ = (size_t)chain * GDN_NCHUNK + (c_); _Pragma("unroll") for (int u_ = 0; u_ < 2; ++u_) { const int idx = tid + 512 * u_; \
            { const int dk_ = idx >> 3, i8_ = (idx & 7) * 8; pw[u_] = *(const u32x4*)(WT + (id_ * 128 + dk_) * 64 + i8_); } \
            { const int i_ = idx >> 4, off_ = (idx & 15) * 8; const int row_ = seq_row(b, d, (c_) * 64 + i_); pq[u_] = *(const u32x4*)(Q + (size_t)row_ * 512 + h * 128 + off_); pk[u_] = *(const u32x4*)(Kk + (size_t)row_ * 512 + h * 128 + off_); \
              peg[u_] = EG[id_ * 64 + i_]; pegl[u_] = EGL[id_ * 64 + i_]; } } \
            pqk = *(const u32x4*)(QKo + id_ * 4096 + tid * 8); pgl = GL[id_]; \
            _Pragma("unroll") for (int it_ = 0; it_ < 4; ++it_) uu[it_] = *(const u32x2*)(UT + (id_ * 128 + dv0 + l15) * 64 + it_ * 16 + 4 * q4); } while (0)
        GDN2_PREFETCH(0);
        for (int c = 0; c < GDN_NCHUNK; ++c) { const size_t id = (size_t)chain * GDN_NCHUNK + c;
            LDS_BAR();
#pragma unroll
            for (int u_ = 0; u_ < 2; ++u_) { const int idx = tid + 512 * u_;
                { const int dk_ = idx >> 3, i8_ = (idx & 7) * 8; *(LAS u32x4*)(WTl + dk_ * 72 + i8_) = (u32x4){pw[u_].x ^ 0x80008000u, pw[u_].y ^ 0x80008000u, pw[u_].z ^ 0x80008000u, pw[u_].w ^ 0x80008000u}; }
                { const int i_ = idx >> 4, off_ = (idx & 15) * 8; float qv[8], kv[8]; unpack8(pq[u_], qv); unpack8(pk[u_], kv); const float sq = peg[u_] * 0.08838834764831845f, sk = pegl[u_];
#pragma unroll
                  for (int e = 0; e < 8; ++e) { qv[e] *= sq; kv[e] *= sk; }
                  *(LAS u32x4*)(Ql + i_ * 136 + off_) = pack8(qv); *(LAS u32x4*)(Kdl + i_ * 136 + off_) = pack8(kv); } }
            { const int i_ = tid >> 3, j8_ = (tid & 7) * 8; *(LAS u32x4*)(QKl + i_ * 72 + j8_) = pqk; }
            const float glast = pgl;
            f32x4 vn[4], o[4];
#pragma unroll
            for (int it = 0; it < 4; ++it) { vn[it] = (f32x4){bflo(uu[it].x), bfhi(uu[it].x), bflo(uu[it].y), bfhi(uu[it].y)}; o[it] = (f32x4){0.f, 0.f, 0.f, 0.f}; }
            LDS_BAR();
            if (c + 1 < GDN_NCHUNK) GDN2_PREFETCH(c + 1);
#pragma unroll
            for (int k0 = 0; k0 < 128; k0 += 32) { const bf16x8 fs = fragl(St, 136, dv0, k0, lane);
#pragma unroll
                for (int it = 0; it < 4; ++it) { vn[it] = MFMA16(fragt(WTl, 72, k0, it * 16, lane), fs, vn[it]); o[it] = MFMA16(fs, fragl(Ql, 136, it * 16, k0, lane), o[it]); } }
#pragma unroll
            for (int it = 0; it < 4; ++it) { u32x2 w; w.x = cvt_pk_bf16(vn[it][0], vn[it][1]); w.y = cvt_pk_bf16(vn[it][2], vn[it][3]); *(LAS u32x2*)(VnT + (dv0 + l15) * 72 + it * 16 + 4 * q4) = w; }
#pragma unroll
            for (int t = 0; t < 8; ++t) S[t] = S[t] * glast;
#pragma unroll
            for (int j0 = 0; j0 < 64; j0 += 32) { const bf16x8 fv = fragl(VnT, 72, dv0, j0, lane);
#pragma unroll
                for (int it = 0; it < 4; ++it) o[it] = MFMA16(fv, fragl(QKl, 72, it * 16, j0, lane), o[it]);
#pragma unroll
                for (int t = 0; t < 8; ++t) S[t] = MFMA16(fragt(Kdl, 136, j0, t * 16, lane), fv, S[t]); }
#pragma unroll
            for (int it = 0; it < 4; it += 2) { u32x2 w0, w1; w0.x = cvt_pk_bf16(o[it][0], o[it][1]); w0.y = cvt_pk_bf16(o[it][2], o[it][3]); w1.x = cvt_pk_bf16(o[it + 1][0], o[it + 1][1]); w1.y = cvt_pk_bf16(o[it + 1][2], o[it + 1][3]);
                const int od = q4 & 1; *(u32x4*)(UT + (id * 64 + (it + od) * 16 + l15) * 128 + dv0 + 4 * (q4 - od)) = widen16(w0, w1); }
#pragma unroll
            for (int t = 0; t < 8; ++t) { u32x2 w; w.x = cvt_pk_bf16(S[t][0], S[t][1]); w.y = cvt_pk_bf16(S[t][2], S[t][3]); *(LAS u32x2*)(St + (dv0 + l15) * 136 + t * 16 + 4 * q4) = w; }
        }
#undef GDN2_PREFETCH
        __syncthreads();
    }
}

__device__ __forceinline__ void phase_ssd_chunked(const PL& P, LAS unsigned char* lds, size_t out_off) {
    const int tid = TID + opaque0(), lane = tid & 63, wave = __builtin_amdgcn_readfirstlane(tid >> 6), q4 = lane >> 4, l15 = lane & 15, hl = wave >> 2, pt = wave & 3;
    LAS bf16_t* Cl = (LAS bf16_t*)lds;
    LAS bf16_t* Bl = Cl + 64 * 136;
    LAS bf16_t* HD = Bl + 64 * 136;
    constexpr int HDSZ = 3 * 64 * 72 + 64 * 136;
    LAS float* scal = (LAS float*)(HD + 2 * HDSZ);
    LAS bf16_t* XT1 = HD + hl * HDSZ; LAS bf16_t* XT2 = XT1 + 64 * 72; LAS bf16_t* Sc = XT2 + 64 * 72; LAS bf16_t* Hb = Sc + 64 * 72;
    unsigned char* ws = P.ws();
    const bf16_t* XS = (const bf16_t*)(ws + WS_XS); const bf16_t* BMm = (const bf16_t*)(ws + WS_BM); const bf16_t* CMm = (const bf16_t*)(ws + WS_CM);
    const float* DT = (const float*)(ws + WS_GPOST) + (size_t)TT * 16; const float* DA = DT + (size_t)TT * 16;
    bf16_t* OUT = (bf16_t*)(ws + out_off);
    const int p0 = pt * 16;
    for (int unit = BID; unit < 256; unit += GDIM) { const int hp = unit & 1, d = (unit >> 1) & 1, grp = (unit >> 2) & 1, b = unit >> 3, head = grp * 4 + hp * 2 + hl;
        f32x4 H[8];
#pragma unroll
        for (int t = 0; t < 8; ++t) H[t] = (f32x4){0.f, 0.f, 0.f, 0.f};
        for (int i = lane; i < 16 * 136 / 8; i += 64) *(LAS u32x4*)(Hb + p0 * 136 + i * 8) = (u32x4){0u, 0u, 0u, 0u};
        u32x4 pc[2], pb[2], px[2]; float pdt = 0.f, pda = 0.f;
#define SSD_PREFETCH(c_) do { _Pragma("unroll") for (int u_ = 0; u_ < 2; ++u_) { const int idx = tid + 512 * u_; \
            { const int j_ = idx >> 4, off_ = (idx & 15) * 8; const size_t row_ = (size_t)seq_row(b, d, (c_) * 64 + j_); pc[u_] = *(const u32x4*)(CMm + row_ * 256 + grp * 128 + off_); pb[u_] = *(const u32x4*)(BMm + row_ * 256 + grp * 128 + off_); } \
            { const int h2_ = idx >> 9, rem_ = idx & 511, j_ = rem_ >> 3, off_ = (rem_ & 7) * 8; const size_t row_ = (size_t)seq_row(b, d, (c_) * 64 + j_); px[u_] = *(const u32x4*)(XS + row_ * 512 + (grp * 4 + hp * 2 + h2_) * 64 + off_); } } \
            if (tid < 128) { const int h2_ = tid >> 6, j_ = tid & 63; const size_t row_ = (size_t)seq_row(b, d, (c_) * 64 + j_); pdt = DT[row_ * 16 + d * 8 + grp * 4 + hp * 2 + h2_]; pda = DA[row_ * 16 + d * 8 + grp * 4 + hp * 2 + h2_]; } } while (0)
        SSD_PREFETCH(0);
        for (int c = 0; c < 36; ++c) {
            LDS_BAR();
#pragma unroll
            for (int u_ = 0; u_ < 2; ++u_) { const int idx = tid + 512 * u_, j_ = idx >> 4, off_ = (idx & 15) * 8;
                *(LAS u32x4*)(Cl + j_ * 136 + off_) = pc[u_]; *(LAS u32x4*)(Bl + j_ * 136 + off_) = pb[u_]; }
            if (tid < 128) { const int h2_ = tid >> 6; const float acs = wave_scan(pda);
                const float al = __builtin_bit_cast(float, __builtin_amdgcn_readlane(__builtin_bit_cast(int, acs), 63));
                LAS float* sp = scal + h2_ * 256; sp[lane] = acs; sp[64 + lane] = __expf(acs); sp[128 + lane] = __expf(al - acs); sp[192 + lane] = pdt; if (lane == 0) scal[512 + h2_] = __expf(al); }
            LDS_BAR();
#pragma unroll
            for (int u_ = 0; u_ < 2; ++u_) { const int idx = tid + 512 * u_, h2_ = idx >> 9, rem_ = idx & 511, j_ = rem_ >> 3, off_ = (rem_ & 7) * 8; float xv[8]; unpack8(px[u_], xv);
                const float s1 = scal[h2_ * 256 + 192 + j_], s2 = s1 * scal[h2_ * 256 + 128 + j_]; LAS bf16_t* x1 = HD + h2_ * HDSZ; LAS bf16_t* x2 = x1 + 64 * 72; float x2v[8];
#pragma unroll
                for (int e = 0; e < 8; ++e) { x2v[e] = xv[e] * s2; xv[e] *= s1; }
                *(LAS u32x4*)(x1 + j_ * 72 + off_) = pack8(xv); *(LAS u32x4*)(x2 + j_ * 72 + off_) = pack8(x2v); }
            if (c + 1 < 36) SSD_PREFETCH(c + 1);
            { const LAS float* sp = scal + hl * 256; const int i0 = pt * 16, i = i0 + l15; const float ai = sp[i];
#pragma unroll 1
              for (int jt = 0; jt < 4; ++jt) { const int j0 = jt * 16 + 4 * q4; f32x4 g = (f32x4){0.f, 0.f, 0.f, 0.f};
                  if (jt <= pt) {
#pragma unroll
                      for (int k0 = 0; k0 < 128; k0 += 32) g = MFMA16(fragl(Bl, 136, jt * 16, k0, lane), fragl(Cl, 136, i0, k0, lane), g); }
                  float sv[4];
#pragma unroll
                  for (int jj = 0; jj < 4; ++jj) { const int j = j0 + jj; const float ex = __expf(fminf(ai - sp[j], 0.f)); sv[jj] = (j <= i) ? g[jj] * ex : 0.f; }
                  u32x2 w; w.x = cvt_pk_bf16(sv[0], sv[1]); w.y = cvt_pk_bf16(sv[2], sv[3]); *(LAS u32x2*)(Sc + i * 72 + j0) = w; } }
            LDS_BAR();
            { const LAS float* sp = scal + hl * 256; f32x4 y[4];
#pragma unroll
              for (int it = 0; it < 4; ++it) y[it] = (f32x4){0.f, 0.f, 0.f, 0.f};
#pragma unroll
              for (int n0 = 0; n0 < 128; n0 += 32) { const bf16x8 fh = fragl(Hb, 136, p0, n0, lane);
#pragma unroll
                  for (int it = 0; it < 4; ++it) y[it] = MFMA16(fh, fragl(Cl, 136, it * 16, n0, lane), y[it]); }
#pragma unroll
              for (int it = 0; it < 4; ++it) y[it] = y[it] * sp[64 + it * 16 + l15];
#pragma unroll
              for (int j0 = 0; j0 < 64; j0 += 32) { const bf16x8 fx = fragt(XT1, 72, j0, p0, lane);
#pragma unroll
                  for (int it = 0; it < 4; ++it) y[it] = MFMA16(fx, fragl(Sc, 72, it * 16, j0, lane), y[it]); }
#pragma unroll
              for (int it = 0; it < 4; it += 2) { u32x2 w0, w1; w0.x = cvt_pk_bf16(y[it][0], y[it][1]); w0.y = cvt_pk_bf16(y[it][2], y[it][3]); w1.x = cvt_pk_bf16(y[it + 1][0], y[it + 1][1]); w1.y = cvt_pk_bf16(y[it + 1][2], y[it + 1][3]);
                  const int od = q4 & 1; const size_t row = (size_t)seq_row(b, d, c * 64 + (it + od) * 16 + l15);
                  *(u32x4*)(OUT + ((size_t)d * TT + row) * 512 + head * 64 + p0 + 4 * (q4 - od)) = widen16(w0, w1); } }
            { const float gl = scal[512 + hl];
#pragma unroll
              for (int t = 0; t < 8; ++t) H[t] = H[t] * gl;
#pragma unroll
              for (int j0 = 0; j0 < 64; j0 += 32) { const bf16x8 fx = fragt(XT2, 72, j0, p0, lane);
#pragma unroll
                  for (int t = 0; t < 8; ++t) H[t] = MFMA16(fragt(Bl, 136, j0, t * 16, lane), fx, H[t]); }
#pragma unroll
              for (int t = 0; t < 8; ++t) { u32x2 w; w.x = cvt_pk_bf16(H[t][0], H[t][1]); w.y = cvt_pk_bf16(H[t][2], H[t][3]); *(LAS u32x2*)(Hb + (p0 + l15) * 136 + t * 16 + 4 * q4) = w; } }
        }
#undef SSD_PREFETCH
        __syncthreads();
    }
}

__device__ __forceinline__ void phase_merge(const PL& P) {
    const int lane = TID & 63, gw = BID * 8 + wave_id(), NGW = GDIM * 8;
    const bf16_t* OG = (const bf16_t*)(P.ws() + WS_OGDN); const bf16_t* OS = (const bf16_t*)(P.ws() + WS_OSSD); const bf16_t* Z = (const bf16_t*)(P.ws() + WS_Z); const bf16_t* XS = (const bf16_t*)(P.ws() + WS_XS);
    bf16_t* MIX = (bf16_t*)(P.ws() + WS_R2);
    float gw8[8], sw8[8]; { const float* a = P.in(IGNW) + (8 * lane) % 128; const float* s = P.in(ISNW) + 8 * lane;
#pragma unroll
        for (int j = 0; j < 8; ++j) { gw8[j] = a[j]; sw8[j] = s[j]; } }
    const float dsk = P.in(ISD)[lane >> 3];
    for (int r = gw; r < TT; r += NGW) {
        float of[8], orv[8], za[8], o[8];
        { int bb, sf, sr; if (r < TL) { bb = r >> 11; const int l = r & 2047; sf = 256 + l; sr = 256 + 2047 - l; } else { bb = (r - TL) >> 8; const int l = (r - TL) & 255; sf = l; sr = 255 - l; }
          const size_t chf = (size_t)((bb * 4 + (lane >> 4)) * 2);
          unpack8(*(const u32x4*)(OG + ((chf * 2304 + sf) * 128) + 8 * (lane & 15)), of); unpack8(*(const u32x4*)(OG + (((chf + 1) * 2304 + sr) * 128) + 8 * (lane & 15)), orv); }
        unpack8(*(const u32x4*)(Z + (size_t)r * 1024 + 8 * lane), za);
        float ss = 0.f;
#pragma unroll
        for (int j = 0; j < 8; ++j) { o[j] = of[j] + orv[j]; ss += o[j] * o[j]; }
        ss = row16_sum(ss);
        float rs = rsqrtf(ss * (1.0f / 128.0f) + RMS_EPS);
#pragma unroll
        for (int j = 0; j < 8; ++j) o[j] = o[j] * rs * gw8[j] * siluf(za[j]);
        u32x2 qm0; qm0.x = pack4_fp8(o[0], o[1], o[2], o[3]); qm0.y = pack4_fp8(o[4], o[5], o[6], o[7]);
        float yf[8], yr[8], xs[8], zb[8], y[8]; unpack8(*(const u32x4*)(OS + (size_t)r * 512 + 8 * lane), yf); unpack8(*(const u32x4*)(OS + ((size_t)TT + r) * 512 + 8 * lane), yr);
        unpack8(*(const u32x4*)(XS + (size_t)r * 512 + 8 * lane), xs); unpack8(*(const u32x4*)(Z + (size_t)r * 1024 + 512 + 8 * lane), zb);
        ss = 0.f;
#pragma unroll
        for (int j = 0; j < 8; ++j) { y[j] = (yf[j] + yr[j] + dsk * xs[j]) * siluf(zb[j]); ss += y[j] * y[j]; }
        ss = row16_sum(ss); ss += __shfl_xor(ss, 16);
        rs = rsqrtf(ss * (1.0f / 256.0f) + RMS_EPS);
#pragma unroll
        for (int j = 0; j < 8; ++j) y[j] = y[j] * rs * sw8[j];
        { u32x2 q; q.x = pack4_fp8(y[0], y[1], y[2], y[3]); q.y = pack4_fp8(y[4], y[5], y[6], y[7]); *(u32x4*)((unsigned char*)MIX + (size_t)r * 1024 + pair16_col(lane)) = pair16(qm0, q, (lane & 1) != 0); }
    }
}

__device__ __forceinline__ void phase_post2(const PL& P, LAS unsigned char* lds, int layer, const bf16_t* YM, int nrows, int CT) {
    const int tid = TID, lane = tid & 63, gw = BID * 8 + wave_id(), NGW = GDIM * 8;
    unsigned char* ws = P.ws(); const float* xin = P.in(IX); const float* cin = P.in(ICTX); const float* nwpost = P.in(IMNPOST) + layer * D; const float* nwpre = P.in(IFNPRE) + layer * D;
    LAS bf16_t* Wl = (LAS bf16_t*)lds;
    constexpr int P2_RPW = 40;
    LAS unsigned* cntL = (LAS unsigned*)(lds + 65536); LAS unsigned* baseL = cntL + NCH * 32; LAS unsigned* stash = baseL + NCH * 32;
    { const float* rw = P.in(IRW) + (size_t)layer * 1024 * 32; __syncthreads();
      if (tid < NCH * 32) cntL[tid] = 0u;
      for (int idx = tid; idx < 1024 * 32; idx += 512) { const int c = idx >> 5, e = idx & 31, l = (c & 511) >> 3, j = c >> 9, i = c & 7; Wl[(((e * 2 + j) * 64) + l) * 8 + i] = __builtin_bit_cast(unsigned short, (_Float16)rw[idx]); }
      __syncthreads(); }
    const float rbias = P.in(IRB)[layer * 32 + (lane >> 1)];
    int* RE = (int*)(ws + WS_RE); int* RP = RE + (size_t)TT * 4; float* RG = (float*)(RP + (size_t)TT * 4);
    int* TOK = (int*)(ws + WS_TOK); unsigned* CNT = (unsigned*)(ws + WS_CTL) + CW_CNT + layer * NCH * 32;
    float w[16], wp[16]; ld_row_f32(nwpost, lane, w); ld_row_f32(nwpre, lane, wp);
    const int rpw = (nrows + NGW - 1) / NGW, rbeg0 = gw * rpw, rend0 = (rbeg0 + rpw < nrows) ? rbeg0 + rpw : nrows, wv = wave_id();
    for (int blk0 = 0; blk0 < rpw; blk0 += P2_RPW) {
    const int rbeg = rbeg0 + blk0 < rend0 ? rbeg0 + blk0 : rend0, rend = rbeg + P2_RPW < rend0 ? rbeg + P2_RPW : rend0;
    float m2v[16], shv[16], scv[16]; int curb = -1;
    u32x4 yq0, yq1; f32x4 xq0, xq1, xq2, xq3;
#define P2_LOAD(rr) do { const bf16_t* yp_ = YM + (size_t)(rr) * D + 8 * lane; yq0 = *(const u32x4*)yp_; yq1 = *(const u32x4*)(yp_ + 512); \
        if (layer == 0) { const float* xp_ = xrow(xin, cin, (rr)) + 8 * lane; xq0 = *(const f32x4*)xp_; xq1 = *(const f32x4*)(xp_ + 4); xq2 = *(const f32x4*)(xp_ + 512); xq3 = *(const f32x4*)(xp_ + 516); } \
        else { const bf16_t* hp_ = hbrow(ws, (rr)) + 8 * lane; xq0 = __builtin_bit_cast(f32x4, *(const u32x4*)hp_); xq1 = __builtin_bit_cast(f32x4, *(const u32x4*)(hp_ + 512)); } } while (0)
    if (rbeg < rend) P2_LOAD(rbeg);
    for (int r = rbeg; r < rend; ++r) {
        float y[16], x[16]; unpack8(yq0, &y[0]); unpack8(yq1, &y[8]);
        if (layer == 0) { x[0] = xq0.x; x[1] = xq0.y; x[2] = xq0.z; x[3] = xq0.w; x[4] = xq1.x; x[5] = xq1.y; x[6] = xq1.z; x[7] = xq1.w; x[8] = xq2.x; x[9] = xq2.y; x[10] = xq2.z; x[11] = xq2.w; x[12] = xq3.x; x[13] = xq3.y; x[14] = xq3.z; x[15] = xq3.w; }
        else { unpack8(__builtin_bit_cast(u32x4, xq0), &x[0]); unpack8(__builtin_bit_cast(u32x4, xq1), &x[8]); }
        if (r + 1 < rend) P2_LOAD(r + 1);
        const int bb = r < TL ? (r >> 11) : 32;
        if (bb != curb) { curb = bb; ld_row_f32(modp(ws, layer, r, 2), lane, m2v); ld_row_f32(modp(ws, layer, r, 3), lane, shv); ld_row_f32(modp(ws, layer, r, 4), lane, scv); }
        float ss = 0.f;
#pragma unroll
        for (int i = 0; i < 16; ++i) ss += y[i] * y[i];
        float rs = rsqrtf(wave_sum(ss) * (1.0f / 1024.0f) + RMS_EPS);
#pragma unroll
        for (int i = 0; i < 16; ++i) x[i] += m2v[i] * (y[i] * rs * w[i]);
        st_row_bf16(hbrow(ws, r), lane, x);
        ss = 0.f;
#pragma unroll
        for (int i = 0; i < 16; ++i) ss += x[i] * x[i];
        rs = rsqrtf(wave_sum(ss) * (1.0f / 1024.0f) + RMS_EPS);
        float o[16];
#pragma unroll
        for (int i = 0; i < 16; ++i) o[i] = x[i] * rs * wp[i] * (1.0f + scv[i]) + shv[i];
        { unsigned char* dst8 = ws + WS_A2Q; u32x2 qa[2];
#pragma unroll
          for (int j = 0; j < 2; ++j) { qa[j].x = pack4_fp8(o[8 * j], o[8 * j + 1], o[8 * j + 2], o[8 * j + 3]); qa[j].y = pack4_fp8(o[8 * j + 4], o[8 * j + 5], o[8 * j + 6], o[8 * j + 7]); }
          *(u32x4*)(dst8 + blk_off8(r, pair16_col(lane))) = pair16(qa[0], qa[1], (lane & 1) != 0); }
        typedef _Float16 h2v __attribute__((ext_vector_type(2)));
        h2v op[8];
#pragma unroll
        for (int q = 0; q < 8; ++q) { op[q].x = (_Float16)o[2 * q]; op[q].y = (_Float16)o[2 * q + 1]; }
        float pl[32];
        { typedef unsigned short u16x8 __attribute__((ext_vector_type(8))); u32x4 wb[2][8];
#define P2_LDG(buf, g) do { _Pragma("unroll") for (int q = 0; q < 8; ++q) wb[buf][q] = __builtin_bit_cast(u32x4, *(const LAS u16x8*)(Wl + ((((4 * (g) + (q >> 1)) * 2 + (q & 1)) * 64) + lane) * 8)); } while (0)
          P2_LDG(0, 0);
#pragma unroll
          for (int g = 0; g < 8; ++g) { if (g < 7) P2_LDG((g + 1) & 1, g + 1);
#pragma unroll
              for (int ee = 0; ee < 4; ++ee) { float acc = 0.f;
#pragma unroll
                  for (int j = 0; j < 2; ++j) { const u32x4 wv = wb[g & 1][2 * ee + j]; const unsigned w0 = wv.x, w1 = wv.y, w2 = wv.z, w3 = wv.w;
                      acc = __builtin_amdgcn_fdot2(op[4 * j + 0], __builtin_bit_cast(h2v, w0), acc, false); acc = __builtin_amdgcn_fdot2(op[4 * j + 1], __builtin_bit_cast(h2v, w1), acc, false);
                      acc = __builtin_amdgcn_fdot2(op[4 * j + 2], __builtin_bit_cast(h2v, w2), acc, false); acc = __builtin_amdgcn_fdot2(op[4 * j + 3], __builtin_bit_cast(h2v, w3), acc, false); }
                  pl[4 * g + ee] = acc; }
              __builtin_amdgcn_sched_barrier(0); }
#undef P2_LDG
        }
#pragma unroll
        for (int n = 32, m = 32; n >= 2; n >>= 1, m >>= 1) { const bool up = (lane & m) != 0;
#pragma unroll
            for (int k = 0; k < n / 2; ++k) { const float a = pl[k], b = pl[k + n / 2]; const float snd = up ? a : b, keep = up ? b : a; pl[k] = keep + __shfl_xor(snd, m); } }
        float lg = pl[0] + __shfl_xor(pl[0], 1) + rbias;
        const int myexp = lane >> 1;
        const int lgb = __builtin_bit_cast(int, lg); int rank = 0;
#pragma unroll
        for (int e = 0; e < 32; ++e) { const float L = __builtin_bit_cast(float, __builtin_amdgcn_readlane(lgb, 2 * e)); rank += (L > lg || (L == lg && e < myexp)) ? 1 : 0; }
        int sel[4]; float sv[4];
#pragma unroll
        for (int k = 0; k < 4; ++k) { const unsigned long long m = __builtin_amdgcn_ballot_w64(rank == k); const int l = m ? (int)__builtin_ctzll(m) : 0; sel[k] = l >> 1; sv[k] = __builtin_bit_cast(float, __builtin_amdgcn_readlane(lgb, l)); }
        const float e1 = expf(sv[1] - sv[0]), e2 = expf(sv[2] - sv[0]), e3 = expf(sv[3] - sv[0]), inv = 1.0f / (1.0f + e1 + e2 + e3);
        if (lane < 4) { const int ek = lane == 0 ? sel[0] : (lane == 1 ? sel[1] : (lane == 2 ? sel[2] : sel[3])); const float gk = (lane == 0 ? 1.0f : (lane == 1 ? e1 : (lane == 2 ? e2 : e3))) * inv;
            const int ch = r / CT; const unsigned lpos = __hip_atomic_fetch_add(cntL + ch * 32 + ek, 1u, __ATOMIC_RELAXED, __HIP_MEMORY_SCOPE_WORKGROUP);
            stash[(wv * P2_RPW + (r - rbeg)) * 4 + lane] = ((unsigned)ch << 24) | ((unsigned)ek << 16) | lpos;
            RE[(size_t)r * 4 + lane] = ek; RG[(size_t)r * 4 + lane] = gk; }
    }
    __syncthreads();
    if (tid < NCH * 32) { const unsigned n = cntL[tid]; baseL[tid] = n ? atomicAdd(&CNT[tid], n) : 0u; cntL[tid] = 0u; }
    __syncthreads();
    for (int i = lane; i < (rend - rbeg) * 4; i += 64) { const unsigned v = stash[wv * P2_RPW * 4 + i]; const int ch = (int)(v >> 24), ek = (int)((v >> 16) & 255u), r = rbeg + (i >> 2); const int pos = (int)(baseL[ch * 32 + ek] + (v & 0xFFFFu));
        RP[(size_t)r * 4 + (i & 3)] = pos; TOK[((size_t)ch * 32 + ek) * CT + pos] = r; }
    __syncthreads();
    }
#undef P2_LOAD
}

__device__ __forceinline__ void moe_tables(const PL& P, LAS unsigned char* lds, int layer, int ch) {
    LAS int* cnt = (LAS int*)(lds + LDS_X + (ch & 1) * 512); LAS int* tp = cnt + 32;
    __syncthreads();
    if (TID == 0) { const unsigned* CNT = (const unsigned*)(P.ws() + WS_CTL) + CW_CNT + (layer * NCH + ch) * 32; int acc = 0;
        for (int e = 0; e < 32; ++e) { const int c = (int)__hip_atomic_load(CNT + e, __ATOMIC_RELAXED, __HIP_MEMORY_SCOPE_AGENT); cnt[e] = c; tp[e] = acc; acc += (c + 255) >> 8; } tp[32] = acc; }
    __syncthreads();
    { const int t = TID; LAS int* te = (LAS int*)(lds + LDS_X + 1024 + (ch & 1) * 2048); if (t < 32) { const int t1 = tp[t + 1]; for (int i = tp[t]; i < t1; ++i) te[i] = t; } }
    __syncthreads();
}
__device__ __forceinline__ void combine_acc(const u32x2 (&yq)[8], const u32x4 (&hq)[2], const float (&g)[4], float (&f)[16], float (&x)[16]) {
#pragma unroll
    for (int i = 0; i < 16; ++i) f[i] = 0.f;
#pragma unroll
    for (int k = 0; k < 4; ++k)
#pragma unroll
        for (int j = 0; j < 2; ++j) { const u32x2 w = yq[2 * k + j];
            const f32x2 a = __builtin_amdgcn_cvt_pk_f32_fp8((int)w.x, false), b = __builtin_amdgcn_cvt_pk_f32_fp8((int)w.x, true), c = __builtin_amdgcn_cvt_pk_f32_fp8((int)w.y, false), d = __builtin_amdgcn_cvt_pk_f32_fp8((int)w.y, true);
            f[8 * j] += g[k] * a.x; f[8 * j + 1] += g[k] * a.y; f[8 * j + 2] += g[k] * b.x; f[8 * j + 3] += g[k] * b.y; f[8 * j + 4] += g[k] * c.x; f[8 * j + 5] += g[k] * c.y; f[8 * j + 6] += g[k] * d.x; f[8 * j + 7] += g[k] * d.y; }
    unpack8(hq[0], &x[0]); unpack8(hq[1], &x[8]);
}
__device__ __forceinline__ void phase_combine(const PL& P, LAS unsigned char* lds, int layer, int ch, int CT) {
    const LAS int* tp = (const LAS int*)(lds + LDS_X + (ch & 1) * 512) + 32;
    const int lane = TID & 63, gw = BID * 8 + wave_id(), NGW = GDIM * 8;
    unsigned char* ws = P.ws(); float* outp = P.out(); const float* nwpost = P.in(IFNPOST) + layer * D; const float* nwpre1 = P.in(IMNPRE) + D;
    const int* RE = (const int*)(ws + WS_RE); const int* RP = RE + (size_t)TT * 4; const float* RG = (const float*)(RP + (size_t)TT * 4);
    const unsigned char* Y = ws + WS_Y + (size_t)(ch & 1) * (160 * MiB); unsigned char* A1 = ws + WS_A1;
    const int rpw = (CT + NGW - 1) / NGW, rlim = (ch + 1) * CT, rbeg = ch * CT + gw * rpw, rend = rbeg + rpw < rlim ? rbeg + rpw : rlim;
    float w[16], wv[16], m5[16], sh[16], sc[16]; ld_row_f32(nwpost, lane, w);
#pragma unroll
    for (int i = 0; i < 16; ++i) { wv[i] = 0.f; m5[i] = 0.f; sh[i] = 0.f; sc[i] = 0.f; }
    if (layer == 0) ld_row_f32(nwpre1, lane, wv);
    int curb = -1;
#define CB_LOAD(set, j) do { _Pragma("unroll") for (int k_ = 0; k_ < 4; ++k_) { const int slot_ = __builtin_amdgcn_readlane(slotL, 4 * (j) + k_); const unsigned char* yp_ = Y + (size_t)slot_ * D + 8 * lane; \
            yq[set][2 * k_] = *(const u32x2*)yp_; yq[set][2 * k_ + 1] = *(const u32x2*)(yp_ + 512); } \
        const bf16_t* hp_ = hbrow(ws, g0 + (j)) + 8 * lane; hq[set][0] = *(const u32x4*)hp_; hq[set][1] = *(const u32x4*)(hp_ + 512); } while (0)
#define CB_ROW(set, j) do { const int r = g0 + (j); float f[16], x[16], g_[4]; \
        _Pragma("unroll") for (int k_ = 0; k_ < 4; ++k_) g_[k_] = __builtin_bit_cast(float, __builtin_amdgcn_readlane(gLb, 4 * (j) + k_)); \
        combine_acc(yq[set], hq[set], g_, f, x); \
        if ((j) + 2 < gn) CB_LOAD(set, (j) + 2); \
        const int bb = r < TL ? (r >> 11) : 32; \
        if (bb != curb) { curb = bb; ld_row_f32(modp(ws, layer, r, 5), lane, m5); if (layer == 0) { ld_row_f32(modp(ws, 1, r, 0), lane, sh); ld_row_f32(modp(ws, 1, r, 1), lane, sc); } } \
        float ss = 0.f; \
        _Pragma("unroll") for (int i = 0; i < 16; ++i) ss += f[i] * f[i]; \
        const float rs = rsqrtf(wave_sum(ss) * (1.0f / 1024.0f) + RMS_EPS); \
        _Pragma("unroll") for (int i = 0; i < 16; ++i) x[i] += m5[i] * (f[i] * rs * w[i]); \
        if (layer == 0) { st_row_bf16(hbrow(ws, r), lane, x); norm_mod_pre(x, wv, sh, sc, nullptr, lane, A1 + (size_t)r * D); } else st_row_f32(outp + (size_t)r * D, lane, x); } while (0)
    for (int g0 = rbeg; g0 < rend; g0 += 16) {
        const int gn = rend - g0 < 16 ? rend - g0 : 16;
        int slotL = 0; float gL = 0.f;
        if (lane < 4 * gn) { const int e = RE[(size_t)g0 * 4 + lane], pos = RP[(size_t)g0 * 4 + lane]; gL = RG[(size_t)g0 * 4 + lane]; slotL = tp[e] * 256 + pos; }
        const int gLb = __builtin_bit_cast(int, gL);
        u32x2 yq[2][8]; u32x4 hq[2][2];
        CB_LOAD(0, 0); if (gn > 1) CB_LOAD(1, 1);
        for (int j = 0; j < gn; j += 2) { CB_ROW(0, j); if (j + 1 < gn) CB_ROW(1, j + 1); }
    }
#undef CB_LOAD
#undef CB_ROW
}

__device__ __forceinline__ void phase_s5_scan(const PL& P) {
    const float* S = (const float*)(P.ws() + WS_S5S); const float* LP = (const float*)(P.ws() + WS_LP); bf16_t* UL = (bf16_t*)(P.ws() + WS_UL);
    for (int idx = BID * 512 + TID; idx < 32 * 64 * 2 * 64; idx += GDIM * 512) { const int p = idx & 63, d = (idx >> 6) & 1, g = (idx >> 7) & 63, b = idx >> 13, dg = d * 64 + g;
        const float lr = LP[(((size_t)dg * 33 + 32) * 64 + p) * 2], li = LP[(((size_t)dg * 33 + 32) * 64 + p) * 2 + 1];
        const float* Sg = S + (size_t)g * S5ROWS * 256 + d * 128 + p; bf16_t* Ug = UL + (size_t)g * S5ROWS * S5K + 512 + d * 128 + p;
        float xr = 0.f, xi = 0.f;
        float s0[16], sa[32], sb[32];
#pragma unroll
        for (int c = 0; c < 8; ++c) { const int cc = d ? 7 - c : c, row = 2048 + b * 8 + cc; s0[2 * c] = Sg[(size_t)row * 256]; s0[2 * c + 1] = Sg[(size_t)row * 256 + 64]; }
#define S5_LD(dst, c0_) do { _Pragma("unroll") for (int q = 0; q < 16; ++q) { const int c_ = (c0_) + q, cc = d ? 63 - c_ : c_, row = b * 64 + cc; dst[2 * q] = Sg[(size_t)row * 256]; dst[2 * q + 1] = Sg[(size_t)row * 256 + 64]; } } while (0)
#define S5_RUN(src, c0_) do { _Pragma("unroll") for (int q = 0; q < 16; ++q) { const int c_ = (c0_) + q, cc = d ? 63 - c_ : c_, row = b * 64 + cc; \
            Ug[(size_t)row * S5K] = f2bf(xr); Ug[(size_t)row * S5K + 64] = f2bf(xi); \
            const float nr = lr * xr - li * xi + src[2 * q], ni = lr * xi + li * xr + src[2 * q + 1]; xr = nr; xi = ni; } } while (0)
        S5_LD(sa, 0);
#pragma unroll
        for (int c = 0; c < 8; ++c) { const float nr = lr * xr - li * xi + s0[2 * c], ni = lr * xi + li * xr + s0[2 * c + 1]; xr = nr; xi = ni; }
        S5_LD(sb, 16); S5_RUN(sa, 0);
        S5_LD(sa, 32); S5_RUN(sb, 16);
        S5_LD(sb, 48); S5_RUN(sa, 32);
        S5_RUN(sb, 48);
#undef S5_LD
#undef S5_RUN
    }
}

__global__ void __launch_bounds__(512, 2) hybrid_fwd(Params Pk) {
    extern __shared__ __attribute__((aligned(16))) unsigned char lds_raw[];
    LAS unsigned char* lds = (LAS unsigned char*)lds_raw;
    volatile LAS unsigned* MISC = (volatile LAS unsigned*)(lds + LDS_MISC);
    for (int u = threadIdx.x; u < 256; u += 512) MISC[u] = 0u;
    __syncthreads();
    if (threadIdx.x < (NIN + 2) * 2) ((LAS unsigned*)(lds + LDS_PARAMS))[threadIdx.x] = ((const unsigned*)&Pk)[threadIdx.x];
    __syncthreads();
    const int w0_ = __builtin_amdgcn_readfirstlane((int)threadIdx.x >> 6); const PL P0{lds, 0, w0_};
    (void)xcd_barrier_post((unsigned*)(P0.ws() + WS_CTL) + CW_BAR, MISC + 8);
#define GRID_BAR() do { SITE; xcd_barrier(P, MISC + 8); } while (0)
#define SITE const int z_ = opaque0(); const PL P{lds + z_, z_, w0_}

    { SITE; phase_mod(P, lds); __syncthreads(); phase_cvt_dense(P, lds); __syncthreads(); phase_s5_tables(P, lds); }
    GRID_BAR();
    { SITE; phase_pre0(P); }
    GRID_BAR();
    { SITE; unsigned char* ws = P.ws(); DenseSched S; S.init(ws + WS_R2, ws + WS_WIN, TT / 256, 5, 1024, 1024, P.z);
      EpiInProj E{(bf16_t*)(ws + WS_CONVA), (bf16_t*)(ws + WS_CONVB), (bf16_t*)(ws + WS_Z), (float*)(ws + WS_GATE), 0};
      pg8::gemm_phase<EpiInProj, DenseSched, false>(lds, 1024, 64, 64, S, E, TID, 256 * 128); }
    { SITE; unsigned char* ws = P.ws(); DenseSched S; S.init(ws + WS_A2Q, ws + WS_WIN8, TT / 256, 10, 1024, 1024, P.z, 1);
      EpiInProj E{(bf16_t*)(ws + WS_CONVA), (bf16_t*)(ws + WS_CONVB), (bf16_t*)(ws + WS_Z), (float*)(ws + WS_GATE), 1};
      pg8::gemm_phase<EpiInProj, DenseSched, false, true>(lds, 1024, 128, 128, S, E, TID, 256 * 128); }
    GRID_BAR();
    { SITE; phase_conv2(P, lds); }
    GRID_BAR();
    { SITE; phase_gdn1m(P, lds, WS_OGDN); }
    GRID_BAR();
    { SITE; phase_gdn2(P, lds, WS_OGDN); __syncthreads(); phase_ssd_chunked(P, lds, WS_OSSD); }
    GRID_BAR();
    { SITE; phase_merge(P); phase_cvt_moe(P, lds, 0); }
    GRID_BAR();
    { SITE; unsigned char* ws = P.ws(); DenseSched S; S.init(ws + WS_R2, ws + WS_WOUT, TT / 256, 4, 1024, 1024, P.z, 1);
      EpiBf16 E{(bf16_t*)(ws + WS_YMIX), 1024, nullptr, 0, 1.0f / W8_SCALE};
      pg8::gemm_phase<EpiBf16, DenseSched, false, true>(lds, 1024, 1024, 1024, S, E, TID);
      }
    GRID_BAR();

#pragma unroll 1
    for (int layer = 0; layer < 2; ++layer) {
        const int ntok = layer == 0 ? TT : TL, CT = ntok / NCH;
        if (layer == 1) {
            { SITE; phase_s5_mats(P); }
            { SITE; unsigned char* ws = P.ws(); DenseSched S; S.init(ws + WS_A1, ws + WS_WS5IN, TT / 256, 4, 1024, 1024, P.z, 1);
              EpiS5U E{(bf16_t*)(ws + WS_UL)};
              pg8::gemm_phase<EpiS5U, DenseSched, false, true>(lds, 1024, 1024, 1024, S, E, TID);
              }
            GRID_BAR();
            { SITE; unsigned char* ws = P.ws(); GroupSched S{(const char*)(ws + WS_UL), (const char*)(ws + WS_E), (size_t)S5ROWS * S5K * 2, (size_t)256 * 512 * 2, (size_t)256 * S5K * 2, 0, 64, S5ROWS / 256, 1, GDIM, BID};
              EpiS5S E{(float*)(ws + WS_S5S)};
              pg8::gemm_phase<EpiS5S, GroupSched, false>(lds, 512, S5K, 512, S, E, TID);
              }
            GRID_BAR();
            { SITE; phase_s5_scan(P); }
            GRID_BAR();
            { SITE; unsigned char* ws = P.ws(); GroupSched S{(const char*)(ws + WS_UL), (const char*)(ws + WS_MP), (size_t)S5ROWS * S5K * 2, (size_t)512 * S5K * 2, (size_t)256 * S5K * 2, (size_t)256 * S5K * 2, 64, 8, 2, GDIM, BID};
              EpiS5Y E{ws + WS_R2};
              pg8::gemm_phase<EpiS5Y, GroupSched, false>(lds, S5K, S5K, S5K, S, E, TID);
              }
            GRID_BAR();
            { SITE; unsigned char* ws = P.ws(); DenseSched S; S.init(ws + WS_R2, ws + WS_WGLU, TL / 256, 8, 1024, 1024, P.z, 1);
              EpiGLU E{(bf16_t*)(ws + WS_YMIX1)};
              pg8::gemm_phase<EpiGLU, DenseSched, false, true>(lds, 1024, 1024, 1024, S, E, TID);
              }
            GRID_BAR();
        }
        { SITE; phase_post2(P, lds, layer, (const bf16_t*)(P.ws() + (layer == 0 ? WS_YMIX : WS_YMIX1)), ntok, CT); }
        GRID_BAR();
#pragma unroll 1
        for (int k = 0; k < NCH + 2; ++k) {
            if (k >= 2) { SITE; phase_combine(P, lds, layer, k - 2, CT); if (layer == 0 && k == NCH + 1) phase_cvt_moe(P, lds, 1); }
            if (k < NCH) { SITE; moe_tables(P, lds, layer, k); }
            int xrot = 0;
            if (k >= 1 && k <= NCH) { SITE; const int ch = k - 1; const LAS int* cnt = (const LAS int*)(lds + LDS_X + (ch & 1) * 512); const LAS int* tp = cnt + 32; unsigned char* ws = P.ws();
              MoeSched S{tp, cnt, (const LAS int*)(lds + LDS_X + 1024 + (ch & 1) * 2048), 4, tp[32], false, (const char*)(ws + WS_H + (size_t)(ch & 1) * (80 * MiB)), (const char*)(ws + WS_WMOE) + (size_t)32 * 2048 * 1024, (size_t)1024 * 1024, nullptr, CT, GDIM, BID, 1024, 0};
              EpiFp8 E{ws + WS_Y + (size_t)(ch & 1) * (160 * MiB), 1024, P.in(IBD) + (size_t)layer * 32 * 1024, 1024, 1.0f / (W8_SCALE * H8_SCALE)};
              pg8::gemm_phase<EpiFp8, MoeSched, false, true>(lds, 1024, 128, 128, S, E, TID, 256 * 128);
              xrot = __builtin_amdgcn_readfirstlane(((tp[32] + 7) >> 3) & 7); }
            if (k < NCH) { SITE; const int ch = k; const LAS int* cnt = (const LAS int*)(lds + LDS_X + (ch & 1) * 512); const LAS int* tp = cnt + 32; unsigned char* ws = P.ws();
              MoeSched S{tp, cnt, (const LAS int*)(lds + LDS_X + 1024 + (ch & 1) * 2048), 8, tp[32], true, (const char*)(ws + WS_A2Q), (const char*)(ws + WS_WMOE), (size_t)2048 * 1024, (const int*)(ws + WS_TOK) + (size_t)ch * 32 * CT, CT, GDIM, BID, 1024, xrot};
              EpiSwiGLU E{ws + WS_H + (size_t)(ch & 1) * (80 * MiB), P.in(IBG) + (size_t)layer * 32 * 1024, P.in(IBU) + (size_t)layer * 32 * 1024};
              pg8::gemm_phase<EpiSwiGLU, MoeSched, true, true>(lds, 1024, 128, 128, S, E, TID, 256 * 128);
              }
            GRID_BAR();
        }
    }
#undef GRID_BAR
}

extern "C" void kernel_launch(void* const* d_in, const int* in_sizes, int n_in, void* d_out, int out_size, void* d_ws, size_t ws_size, hipStream_t stream) {
    static int grid = 0;
    if (grid == 0) {
        if (n_in != NIN || in_sizes[IX] != TL * D || out_size != TL * D || ws_size < WS_END) { fprintf(stderr, "kernel_launch: unexpected shapes (n_in %d, x %d, out %d, ws %zu < %zu); nothing launched\n", n_in, n_in > 0 ? in_sizes[0] : -1, out_size, ws_size, (size_t)WS_END); grid = -1; return; }
        int dev = 0, cus = 0, per_cu = 0;
        if (hipGetDevice(&dev) != hipSuccess || hipDeviceGetAttribute(&cus, hipDeviceAttributeMultiprocessorCount, dev) != hipSuccess) { grid = -1; return; }
        if (hipFuncSetAttribute((const void*)hybrid_fwd, hipFuncAttributeMaxDynamicSharedMemorySize, LDS_BYTES) != hipSuccess) { fprintf(stderr, "kernel_launch: hipFuncSetAttribute failed\n"); grid = -1; return; }
        if (hipOccupancyMaxActiveBlocksPerMultiprocessor(&per_cu, (const void*)hybrid_fwd, 512, LDS_BYTES) != hipSuccess || per_cu < 1) fprintf(stderr, "kernel_launch: occupancy query reports %d\n", per_cu);
        (void)hipGetLastError();
        grid = cus;
    }
    if (grid < 0) return;
    if (hipMemsetAsync((char*)d_ws + WS_CTL, 0, CTL_ZERO_BYTES, stream) != hipSuccess) return;
    Params p; memset(&p, 0, sizeof(p));
    for (int i = 0; i < NIN; ++i) p.in[i] = (const float*)d_in[i];
    p.out = (float*)d_out; p.ws = (unsigned char*)d_ws;
    hipLaunchKernelGGL(hybrid_fwd, dim3(grid), dim3(512), LDS_BYTES, stream, p);
}
```
